# Optimizing an MI355X kernel written in HIP

```python
import math
import jax, jax.numpy as jnp
from jax import lax
import numpy as np

D_MODEL = 1024
BATCH = 1
SEQ = 16384
DEPTH = 1

A_HEADS = 8
A_HEAD_DIM = 64
A_WIDTH = A_HEADS * A_HEAD_DIM
IDX_HEADS = 8
IDX_DIM = 64
TOPK_MAX = 256
B_HEADS = 4
B_QK_DIM = 64
B_V_DIM = 2 * B_QK_DIM
B_WIDTH = B_HEADS * B_V_DIM
N_BUCKETS = 32
MAX_DISTANCE = 128
N_BIAS_HEADS = A_HEADS + B_HEADS
PLE_DIM = 256
Q_BLOCK = 128
LN_EPS = 1e-5
RMS_EPS = 1e-5
DEEPNORM_ALPHA = (2 * DEPTH) ** 0.25
DEEPNORM_BETA = (8 * DEPTH) ** -0.25

IN_SIZES = (
    A_WIDTH, A_WIDTH, A_WIDTH, A_WIDTH,
    IDX_HEADS * IDX_DIM, IDX_DIM, IDX_HEADS,
    B_HEADS * 2 * B_QK_DIM, B_HEADS * 2 * B_QK_DIM,
    B_WIDTH, B_WIDTH,
    D_MODEL, D_MODEL,
)
IN_COLS = sum(IN_SIZES)

kernel_name = "hybrid_dsa_diffattn_postnorm_block"


def _split_points():
    pts, acc = [], 0
    for s in IN_SIZES[:-1]:
        acc += s
        pts.append(acc)
    return pts


def _layer_norm(x, g, b):
    xf = x.astype(jnp.float32)
    mu = jnp.mean(xf, axis=-1, keepdims=True)
    var = jnp.mean(jnp.square(xf - mu), axis=-1, keepdims=True)
    return ((xf - mu) * lax.rsqrt(var + LN_EPS) * g.astype(jnp.float32) + b.astype(jnp.float32)).astype(x.dtype)


def _rms_norm(x, g):
    xf = x.astype(jnp.float32)
    ms = jnp.mean(jnp.square(xf), axis=-1, keepdims=True)
    return (xf * lax.rsqrt(ms + RMS_EPS) * g.astype(jnp.float32)).astype(x.dtype)


def _rel_bucket(dist):
    n = jnp.maximum(dist, 0)
    max_exact = N_BUCKETS // 2
    nf = jnp.maximum(n, 1).astype(jnp.float32)
    large = max_exact + (jnp.log(nf / max_exact) / math.log(MAX_DISTANCE / max_exact)
                         * (N_BUCKETS - max_exact)).astype(jnp.int32)
    large = jnp.minimum(large, N_BUCKETS - 1)
    return jnp.where(n < max_exact, n, large)


def _blocks(a):
    b, s = a.shape[:2]
    return jnp.moveaxis(a.reshape((b, s // Q_BLOCK, Q_BLOCK) + a.shape[2:]), 1, 0)


def _unblocks(a):
    a = jnp.moveaxis(a, 0, 1)
    return a.reshape((a.shape[0], a.shape[1] * a.shape[2]) + a.shape[3:])


def _dsa_mixer(q, k, v, qi, ki, wi, bias_by_dist):
    L = q.shape[1]
    topk = min(TOPK_MAX, L // 4)
    key_pos = jnp.arange(L)
    t0s = jnp.arange(L // Q_BLOCK) * Q_BLOCK

    def block(args):
        qb, qib, wib, t0 = args
        tq = t0 + jnp.arange(Q_BLOCK)
        dots = jnp.einsum('bqhd,bsd->bqhs', qib, ki).astype(jnp.float32) * (IDX_DIM ** -0.5)
        score = jnp.einsum('bqh,bqhs->bqs', wib.astype(jnp.float32) * (IDX_HEADS ** -0.5), jax.nn.relu(dots))
        causal = key_pos[None, :] <= tq[:, None]
        score = jnp.where(causal[None], score, -jnp.inf)
        _, idx = lax.top_k(score, topk)
        k_sel = jax.vmap(lambda kk, ii: kk[ii])(k, idx)
        v_sel = jax.vmap(lambda vv, ii: vv[ii])(v, idx)
        dist = tq[None, :, None] - idx
        valid = dist >= 0
        bias = bias_by_dist[jnp.maximum(dist, 0)]
        logits = (jnp.einsum('bqhd,bqkhd->bqhk', qb, k_sel).astype(jnp.float32) * (A_HEAD_DIM ** -0.5)
                  + jnp.swapaxes(bias, -1, -2).astype(jnp.float32))
        logits = jnp.where(valid[:, :, None, :], logits, -jnp.inf)
        probs = jax.nn.softmax(logits, axis=-1)
        return jnp.einsum('bqhk,bqkhd->bqhd', probs.astype(v.dtype), v_sel)

    out = lax.map(block, (_blocks(q), _blocks(qi), _blocks(wi), t0s))
    return _unblocks(out)


def _diff_mixer(q, k, v, lam, bias_by_dist):
    L = q.shape[1]
    key_pos = jnp.arange(L)
    t0s = jnp.arange(L // Q_BLOCK) * Q_BLOCK

    def block(args):
        qb, t0 = args
        tq = t0 + jnp.arange(Q_BLOCK)
        dist = tq[:, None] - key_pos[None, :]
        bias = jnp.moveaxis(bias_by_dist[jnp.maximum(dist, 0)], -1, 0)
        logits = (jnp.einsum('bqhmd,bshmd->bhmqs', qb, k).astype(jnp.float32) * (B_QK_DIM ** -0.5)
                  + bias[None, :, None].astype(jnp.float32))
        logits = jnp.where(dist >= 0, logits, -jnp.inf)
        probs = jax.nn.softmax(logits, axis=-1)
        attn = probs[:, :, 0] - lam * probs[:, :, 1]
        return jnp.einsum('bhqs,bshe->bqhe', attn.astype(v.dtype), v)

    out = lax.map(block, (_blocks(q), t0s))
    return _unblocks(out)


def setup_inputs(seed: int = 0) -> dict:
    key = jax.random.key(seed)
    ks = jax.random.split(key, 14)
    f32 = jnp.float32
    x = jax.random.normal(ks[0], (BATCH, SEQ, D_MODEL), f32)
    p = jax.random.normal(ks[1], (DEPTH, BATCH, SEQ, PLE_DIM), f32)
    w_in = jax.random.normal(ks[2], (DEPTH, D_MODEL, IN_COLS), f32) * D_MODEL ** -0.5
    w_pa = jax.random.normal(ks[3], (DEPTH, A_WIDTH, D_MODEL), f32) * A_WIDTH ** -0.5
    w_pb = jax.random.normal(ks[4], (DEPTH, B_WIDTH, D_MODEL), f32) * B_WIDTH ** -0.5
    w_o = jax.random.normal(ks[5], (DEPTH, D_MODEL, D_MODEL), f32) * (D_MODEL ** -0.5 * DEEPNORM_BETA)
    lambda_qk = jax.random.normal(ks[6], (DEPTH, 4, B_QK_DIM), f32) * 0.1
    subln_w = 1.0 + 0.01 * jax.random.normal(ks[7], (DEPTH, B_V_DIM), f32)
    ln_g = 1.0 + 0.01 * jax.random.normal(ks[8], (DEPTH, D_MODEL), f32)
    ln_b = 0.01 * jax.random.normal(ks[9], (DEPTH, D_MODEL), f32)
    w_ple = jax.random.normal(ks[10], (DEPTH, PLE_DIM, D_MODEL), f32) * (PLE_DIM ** -0.5 * 0.5)
    w_ple_gate = jax.random.normal(ks[11], (DEPTH, D_MODEL, D_MODEL), f32) * D_MODEL ** -0.5
    rel_bias = jax.random.normal(ks[12], (N_BUCKETS, N_BIAS_HEADS), f32) * 0.5
    return {"x": x, "p": p, "w_in": w_in, "w_pa": w_pa, "w_pb": w_pb, "w_o": w_o,
            "lambda_qk": lambda_qk, "subln_w": subln_w, "ln_g": ln_g, "ln_b": ln_b,
            "w_ple": w_ple, "w_ple_gate": w_ple_gate, "rel_bias": rel_bias}


def reference(x, p, w_in, w_pa, w_pb, w_o, lambda_qk, subln_w, ln_g, ln_b, w_ple, w_ple_gate, rel_bias):
    b, L, _ = x.shape
    split_pts = _split_points()
    bias_by_dist = rel_bias[_rel_bucket(jnp.arange(L))]
    bias_a = bias_by_dist[:, :A_HEADS]
    bias_b = bias_by_dist[:, A_HEADS:]
    for i in range(DEPTH):
        h = x @ w_in[i]
        (a_q, a_k, a_v, a_z, i_q, i_k, i_w,
         b_q, b_k, b_v, b_z, g_a, g_b) = jnp.split(h, split_pts, axis=-1)

        o_a = _dsa_mixer(a_q.reshape(b, L, A_HEADS, A_HEAD_DIM),
                         a_k.reshape(b, L, A_HEADS, A_HEAD_DIM),
                         a_v.reshape(b, L, A_HEADS, A_HEAD_DIM),
                         i_q.reshape(b, L, IDX_HEADS, IDX_DIM), i_k, i_w, bias_a)
        y_a = o_a.reshape(b, L, A_WIDTH) * jax.nn.silu(a_z)

        lam_init = 0.8 - 0.6 * math.exp(-0.3 * i)
        lq = lambda_qk[i].astype(jnp.float32)
        lam = jnp.exp(jnp.sum(lq[0] * lq[1])) - jnp.exp(jnp.sum(lq[2] * lq[3])) + lam_init
        o_b = _diff_mixer(b_q.reshape(b, L, B_HEADS, 2, B_QK_DIM),
                          b_k.reshape(b, L, B_HEADS, 2, B_QK_DIM),
                          b_v.reshape(b, L, B_HEADS, B_V_DIM), lam, bias_b)
        o_b = _rms_norm(o_b, subln_w[i]) * (1.0 - lam_init)
        y_b = o_b.reshape(b, L, B_WIDTH) * jax.nn.silu(b_z)

        merged = jax.nn.sigmoid(g_a) * (y_a @ w_pa[i]) + jax.nn.sigmoid(g_b) * (y_b @ w_pb[i])
        mix = merged @ w_o[i]

        x = _layer_norm(DEEPNORM_ALPHA * x + mix, ln_g[i], ln_b[i])
        x = x + jax.nn.sigmoid(x @ w_ple_gate[i]) * (p[i] @ w_ple[i])
    return x
```

```cpp
#include <hip/hip_runtime.h>
#include <cstdint>
#include <cstdio>

typedef unsigned short bf16_t;
typedef unsigned u32x4 __attribute__((ext_vector_type(4)));
typedef unsigned u32x2 __attribute__((ext_vector_type(2)));

constexpr int L = 16384, DM = 1024, PLE = 256;
constexpr int IN_COLS = 6728;
constexpr int NTOK = 2816;
constexpr int C_AQ = 0, C_AK = 512, C_BQ = 1024, C_BK = 1536, C_IQ = 2048, C_IK = 2560, C_IW = 2624;
constexpr int WT_TOK = 0, WT_VT = 2816, WT_Z = 3840, WT_G = 4864, WT_ROWS = 6912;
constexpr float ALPHA = 1.18920711500272f;
constexpr float LAM_INIT = 0.2f;

constexpr size_t MiB = 1u << 20;
constexpr size_t WS_CTL = 0;
constexpr size_t WS_BT = 512 * 1024;
constexpr size_t WS_WIN = 1 * MiB;
constexpr size_t WS_WPA = 15 * MiB;
constexpr size_t WS_WPB = 16 * MiB;
constexpr size_t WS_WO = 17 * MiB;
constexpr size_t WS_WGT = 19 * MiB;
constexpr size_t WS_WPLE = 21 * MiB;
constexpr size_t WS_XBF = 22 * MiB;
constexpr size_t WS_PBF = 54 * MiB;
constexpr size_t WS_QK = 62 * MiB;
constexpr size_t WS_VT = 154 * MiB;
constexpr size_t WS_BMP = 186 * MiB;
constexpr size_t WS_OAB = 218 * MiB;
constexpr size_t WS_END = 250 * MiB;
constexpr size_t WS_PLEO = WS_XBF, WS_G = WS_QK, WS_MRG = WS_VT, WS_XLN = WS_BMP;

__device__ __forceinline__ float bf2f(bf16_t v) { return __uint_as_float(((unsigned)v) << 16); }
__device__ __forceinline__ bf16_t f2bf(float f) { unsigned u = __float_as_uint(f); return (bf16_t)((u + 0x7fffu + ((u >> 16) & 1u)) >> 16); }
__device__ __forceinline__ float sigmoidf_(float v) { return 1.f / (1.f + __expf(-v)); }
__device__ __forceinline__ float siluf_(float v) { return v / (1.f + __expf(-v)); }

__host__ __device__ __forceinline__ int win_src_col(int n) {
    if (n < WT_VT) {
        if (n < 512) return n;
        if (n < 1024) return n;
        if (n < 1536) return 2632 + (n - 1024);
        if (n < 2048) return 3144 + (n - 1536);
        if (n < 2560) return 2048 + (n - 2048);
        if (n < 2624) return 2560 + (n - 2560);
        if (n < 2632) return 2624 + (n - 2624);
        return -1;
    }
    if (n < WT_Z) { int r = n - WT_VT; return r < 512 ? 1024 + r : 3656 + (r - 512); }
    if (n < WT_G) { int r = n - WT_Z; return r < 512 ? 1536 + r : 4168 + (r - 512); }
    return 4680 + (n - WT_G);
}

template <int MODE>
__global__ void __launch_bounds__(256) k_transpose(const float* __restrict__ src, bf16_t* __restrict__ dst, int K, int ld, int N, int pad_) {
    __shared__ float tile[32][33];
    const int n0 = blockIdx.x * 32, k0 = blockIdx.y * 32, tx = threadIdx.x & 31, ty = threadIdx.x >> 5;
    const int n = n0 + tx; const int c = MODE == 0 ? n : win_src_col(n);
#pragma unroll
    for (int i = 0; i < 4; ++i) { const int k = k0 + ty + 8 * i; tile[ty + 8 * i][tx] = (c >= 0) ? src[(size_t)k * ld + c] : 0.f; }
    __syncthreads();
#pragma unroll
    for (int i = 0; i < 4; ++i) { const int nn = n0 + ty + 8 * i; dst[(size_t)nn * K + k0 + tx] = f2bf(tile[tx][ty + 8 * i]); }
}
__global__ void __launch_bounds__(256) k_cvt(const float* __restrict__ src, bf16_t* __restrict__ dst, size_t n4) {
    for (size_t i = (size_t)blockIdx.x * 256 + threadIdx.x; i < n4; i += (size_t)gridDim.x * 256) {
        const float4 v = ((const float4*)src)[i]; u32x2 o; o.x = f2bf(v.x) | ((unsigned)f2bf(v.y) << 16); o.y = f2bf(v.z) | ((unsigned)f2bf(v.w) << 16); ((u32x2*)dst)[i] = o; }
}
__device__ __forceinline__ int rel_bucket(int n) {
    if (n < 16) return n;
    int b = 16 + (int)(logf((float)n / 16.f) / logf(8.f) * 16.f);
    return b > 31 ? 31 : b;
}
__global__ void k_bias_table(const float* __restrict__ rel_bias, float* __restrict__ bt) {
    const int i = threadIdx.x + blockIdx.x * blockDim.x;
    if (i < 128 * 12) { const int n = i / 12, h = i % 12; bt[i] = rel_bias[rel_bucket(n) * 12 + h]; }
}

template <class Epi>
__global__ void __launch_bounds__(256) naive_gemm(const bf16_t* __restrict__ A, const bf16_t* __restrict__ Bt, int lda, int ldb, int K, int pad_, Epi E) {
    __shared__ float As[16][68], Bs[16][68];
    const int tid = threadIdx.x, bm = blockIdx.y * 64, bn = blockIdx.x * 64, tx = tid & 15, ty = tid >> 4;
    const int lr = tid >> 2, lk = (tid & 3) * 4;
    float acc[4][4];
#pragma unroll
    for (int i = 0; i < 4; ++i)
#pragma unroll
        for (int j = 0; j < 4; ++j) acc[i][j] = 0.f;
    for (int k0 = 0; k0 < K; k0 += 16) {
        const u32x2 av = *(const u32x2*)(A + (size_t)(bm + lr) * lda + k0 + lk);
        const u32x2 bv = *(const u32x2*)(Bt + (size_t)(bn + lr) * ldb + k0 + lk);
        As[lk + 0][lr] = __uint_as_float(av.x << 16); As[lk + 1][lr] = __uint_as_float(av.x & 0xffff0000u);
        As[lk + 2][lr] = __uint_as_float(av.y << 16); As[lk + 3][lr] = __uint_as_float(av.y & 0xffff0000u);
        Bs[lk + 0][lr] = __uint_as_float(bv.x << 16); Bs[lk + 1][lr] = __uint_as_float(bv.x & 0xffff0000u);
        Bs[lk + 2][lr] = __uint_as_float(bv.y << 16); Bs[lk + 3][lr] = __uint_as_float(bv.y & 0xffff0000u);
        __syncthreads();
#pragma unroll
        for (int k = 0; k < 16; ++k) {
            const float4 a = *(const float4*)&As[k][ty * 4]; const float4 b = *(const float4*)&Bs[k][tx * 4];
            acc[0][0] += a.x * b.x; acc[0][1] += a.x * b.y; acc[0][2] += a.x * b.z; acc[0][3] += a.x * b.w;
            acc[1][0] += a.y * b.x; acc[1][1] += a.y * b.y; acc[1][2] += a.y * b.z; acc[1][3] += a.y * b.w;
            acc[2][0] += a.z * b.x; acc[2][1] += a.z * b.y; acc[2][2] += a.z * b.z; acc[2][3] += a.z * b.w;
            acc[3][0] += a.w * b.x; acc[3][1] += a.w * b.y; acc[3][2] += a.w * b.z; acc[3][3] += a.w * b.w;
        }
        __syncthreads();
    }
#pragma unroll
    for (int i = 0; i < 4; ++i)
#pragma unroll
        for (int j = 0; j < 4; ++j) E(bm + ty * 4 + i, bn + tx * 4 + j, acc[i][j]);
}
struct EpStore { bf16_t* O; int ld; int pad; __device__ void operator()(int m, int n, float v) const { O[(size_t)m * ld + n] = f2bf(v); } };
struct EpVT { bf16_t* VT; bf16_t* VTOK; __device__ void operator()(int m, int n, float v) const { const bf16_t b = f2bf(v); VT[(size_t)m * L + n] = b; VTOK[(size_t)n * 1024 + m] = b; } };
struct EpZ { bf16_t* OAB; __device__ void operator()(int m, int n, float v) const { const size_t i = (size_t)m * 1024 + n; OAB[i] = f2bf(siluf_(v) * bf2f(OAB[i])); } };
struct EpG { bf16_t* G; __device__ void operator()(int m, int n, float v) const { G[(size_t)m * 2048 + n] = f2bf(sigmoidf_(v)); } };
struct EpPA { const bf16_t* G; bf16_t* MRG; __device__ void operator()(int m, int n, float v) const { MRG[(size_t)m * 1024 + n] = f2bf(bf2f(G[(size_t)m * 2048 + n]) * v); } };
struct EpPB { const bf16_t* G; bf16_t* MRG; __device__ void operator()(int m, int n, float v) const { const size_t i = (size_t)m * 1024 + n; MRG[i] = f2bf(bf2f(MRG[i]) + bf2f(G[(size_t)m * 2048 + 1024 + n]) * v); } };
struct EpO { const float* x; float* PRE; __device__ void operator()(int m, int n, float v) const { const size_t i = (size_t)m * 1024 + n; PRE[i] = ALPHA * x[i] + v; } };
struct EpGate { float* out; const bf16_t* PLEO; __device__ void operator()(int m, int n, float v) const { const size_t i = (size_t)m * 1024 + n; out[i] = out[i] + sigmoidf_(v) * bf2f(PLEO[i]); } };

__global__ void __launch_bounds__(256) k_ln(float* __restrict__ io, const float* __restrict__ g, const float* __restrict__ b, bf16_t* __restrict__ xln) {
    const int wave = threadIdx.x >> 6, lane = threadIdx.x & 63; const int row = blockIdx.x * 4 + wave;
    float4* r = (float4*)(io + (size_t)row * 1024) + lane; float4 v[4]; float s = 0.f;
#pragma unroll
    for (int j = 0; j < 4; ++j) { v[j] = r[64 * j]; s += (v[j].x + v[j].y) + (v[j].z + v[j].w); }
#pragma unroll
    for (int o = 1; o < 64; o <<= 1) s += __shfl_xor(s, o);
    const float mean = s * (1.f / 1024.f); float q = 0.f;
#pragma unroll
    for (int j = 0; j < 4; ++j) { v[j].x -= mean; v[j].y -= mean; v[j].z -= mean; v[j].w -= mean; q += (v[j].x * v[j].x + v[j].y * v[j].y) + (v[j].z * v[j].z + v[j].w * v[j].w); }
#pragma unroll
    for (int o = 1; o < 64; o <<= 1) q += __shfl_xor(q, o);
    const float rstd = rsqrtf(q * (1.f / 1024.f) + 1e-5f);
#pragma unroll
    for (int j = 0; j < 4; ++j) {
        const float4 gg = ((const float4*)g)[lane + 64 * j], bb = ((const float4*)b)[lane + 64 * j];
        float4 o; o.x = v[j].x * rstd * gg.x + bb.x; o.y = v[j].y * rstd * gg.y + bb.y; o.z = v[j].z * rstd * gg.z + bb.z; o.w = v[j].w * rstd * gg.w + bb.w;
        r[64 * j] = o; u32x2 w; w.x = f2bf(o.x) | ((unsigned)f2bf(o.y) << 16); w.y = f2bf(o.z) | ((unsigned)f2bf(o.w) << 16);
        ((u32x2*)(xln + (size_t)row * 1024))[lane + 64 * j] = w;
    }
}

__device__ __forceinline__ unsigned fkey(float f) { const unsigned u = __float_as_uint(f); return (u & 0x80000000u) ? ~u : (u | 0x80000000u); }
__device__ __forceinline__ int block_sum_256(int v, volatile int* red) {
#pragma unroll
    for (int o = 1; o < 64; o <<= 1) v += __shfl_xor(v, o);
    __syncthreads();
    if ((threadIdx.x & 63) == 0) red[threadIdx.x >> 6] = v;
    __syncthreads();
    return red[0] + red[1] + red[2] + red[3];
}
__global__ void __launch_bounds__(256) naive_index(const bf16_t* __restrict__ QK, unsigned* __restrict__ bitmap) {
    extern __shared__ float smem[];
    float* sc = smem;
    float* qf = smem + 16384;
    float* wv = qf + 512;
    int* red = (int*)(wv + 8);
    int* scan = red + 4;
    const int tid = threadIdx.x, t = L - 1 - (int)blockIdx.x;
    const bf16_t* qrow = QK + (size_t)t * NTOK;
    for (int j = tid; j < 512; j += 256) qf[j] = bf2f(qrow[C_IQ + j]);
    if (tid < 8) wv[tid] = bf2f(qrow[C_IW + tid]) * 0.35355339059327373f;
    __syncthreads();
    for (int s = tid; s <= t; s += 256) {
        const u32x4* kr = (const u32x4*)(QK + (size_t)s * NTOK + C_IK);
        float acc[8];
#pragma unroll
        for (int h = 0; h < 8; ++h) acc[h] = 0.f;
#pragma unroll
        for (int c = 0; c < 8; ++c) {
            const u32x4 kv = kr[c];
            const float k0 = __uint_as_float(kv.x << 16), k1 = __uint_as_float(kv.x & 0xffff0000u), k2 = __uint_as_float(kv.y << 16), k3 = __uint_as_float(kv.y & 0xffff0000u);
            const float k4 = __uint_as_float(kv.z << 16), k5 = __uint_as_float(kv.z & 0xffff0000u), k6 = __uint_as_float(kv.w << 16), k7 = __uint_as_float(kv.w & 0xffff0000u);
#pragma unroll
            for (int h = 0; h < 8; ++h) {
                const float4 qa = *(const float4*)&qf[h * 64 + c * 8], qb = *(const float4*)&qf[h * 64 + c * 8 + 4];
                acc[h] += qa.x * k0 + qa.y * k1 + qa.z * k2 + qa.w * k3 + qb.x * k4 + qb.y * k5 + qb.z * k6 + qb.w * k7;
            }
        }
        float score = 0.f;
#pragma unroll
        for (int h = 0; h < 8; ++h) score += wv[h] * fmaxf(acc[h] * 0.125f, 0.f);
        sc[s] = score;
    }
    __syncthreads();
    const int n = t + 1;
    unsigned w0 = 0u, w1 = 0u;
    const int base = tid * 64;
    if (n <= 256) {
#pragma unroll 1
        for (int j = 0; j < 64; ++j) { const int s = base + j; if (s <= t) { if (j < 32) w0 |= 1u << j; else w1 |= 1u << (j - 32); } }
    } else {
        unsigned prefix = 0u;
        for (int bit = 31; bit >= 0; --bit) {
            const unsigned cand = prefix | (1u << bit); int c = 0;
            for (int s = tid; s <= t; s += 256) c += (fkey(sc[s]) >= cand) ? 1 : 0;
            if (block_sum_256(c, red) >= 256) prefix = cand;
        }
        int cgt = 0, ceq = 0;
        for (int j = 0; j < 64; ++j) { const int s = base + j; if (s <= t) { const unsigned k = fkey(sc[s]); cgt += k > prefix; ceq += k == prefix; } }
        const int tot_gt = block_sum_256(cgt, red);
        const int need = 256 - tot_gt;
        scan[tid] = ceq; __syncthreads();
        int before = 0; for (int j = 0; j < tid; ++j) before += scan[j];
        for (int j = 0; j < 64; ++j) { const int s = base + j; if (s <= t) { const unsigned k = fkey(sc[s]); bool sel = k > prefix;
                if (k == prefix) { sel = before < need; ++before; }
                if (sel) { if (j < 32) w0 |= 1u << j; else w1 |= 1u << (j - 32); } } }
    }
    bitmap[(size_t)t * 512 + tid * 2] = w0; bitmap[(size_t)t * 512 + tid * 2 + 1] = w1;
}

__global__ void __launch_bounds__(256) naive_attn_a(const bf16_t* __restrict__ QK, const bf16_t* __restrict__ VTOK, const unsigned* __restrict__ bitmap,
                                                    const float* __restrict__ bt, bf16_t* __restrict__ OAB) {
    __shared__ float qf[512]; __shared__ int sel[256]; __shared__ int scan[256]; __shared__ float lg[8][256]; __shared__ float linv[8];
    const int tid = threadIdx.x, t = L - 1 - (int)blockIdx.x;
    const unsigned w0 = bitmap[(size_t)t * 512 + tid * 2], w1 = bitmap[(size_t)t * 512 + tid * 2 + 1];
    scan[tid] = __popc(w0) + __popc(w1);
    for (int j = tid; j < 512; j += 256) qf[j] = bf2f(QK[(size_t)t * NTOK + C_AQ + j]);
    __syncthreads();
    int pos = 0; for (int j = 0; j < tid; ++j) pos += scan[j];
    int cnt = 0; for (int j = 0; j < 256; ++j) cnt += scan[j];
    for (int j = 0; j < 32; ++j) { if (w0 >> j & 1u) { if (pos < 256) sel[pos] = tid * 64 + j; ++pos; } }
    for (int j = 0; j < 32; ++j) { if (w1 >> j & 1u) { if (pos < 256) sel[pos] = tid * 64 + 32 + j; ++pos; } }
    if (cnt > 256) cnt = 256;
    __syncthreads();
    if (tid < cnt) {
        const int s = sel[tid]; const int dist = t - s; const int db = dist < 127 ? dist : 127;
        const bf16_t* kr = QK + (size_t)s * NTOK + C_AK;
#pragma unroll 1
        for (int h = 0; h < 8; ++h) { float a = 0.f;
            for (int d = 0; d < 64; ++d) a += qf[h * 64 + d] * bf2f(kr[h * 64 + d]);
            lg[h][tid] = a * 0.125f + bt[db * 12 + h]; }
    }
    __syncthreads();
    { const int wave = tid >> 6, lane = tid & 63;
      for (int hh = 0; hh < 2; ++hh) { const int h = wave * 2 + hh; float m = -INFINITY;
          for (int j = lane; j < cnt; j += 64) m = fmaxf(m, lg[h][j]);
          for (int o = 1; o < 64; o <<= 1) m = fmaxf(m, __shfl_xor(m, o));
          float s = 0.f;
          for (int j = lane; j < cnt; j += 64) { const float p = __expf(lg[h][j] - m); lg[h][j] = p; s += p; }
          for (int o = 1; o < 64; o <<= 1) s += __shfl_xor(s, o);
          if (lane == 0) linv[h] = 1.f / s; } }
    __syncthreads();
    for (int hd = tid; hd < 512; hd += 256) { const int h = hd >> 6; float o = 0.f;
        for (int j = 0; j < cnt; ++j) o += lg[h][j] * bf2f(VTOK[(size_t)sel[j] * 1024 + hd]);
        OAB[(size_t)t * 1024 + hd] = f2bf(o * linv[h]); }
}

__global__ void __launch_bounds__(64) naive_attn_b(const bf16_t* __restrict__ QK, const bf16_t* __restrict__ VTOK, const float* __restrict__ bt, bf16_t* __restrict__ OB12) {
    const int g = blockIdx.x & 7, qb = (L / 64 - 1) - (int)(blockIdx.x >> 3), lane = threadIdx.x, t = qb * 64 + lane, h = g >> 1;
    float q[64], o[128];
#pragma unroll
    for (int d = 0; d < 64; ++d) q[d] = bf2f(QK[(size_t)t * NTOK + C_BQ + g * 64 + d]) * 0.125f;
#pragma unroll
    for (int e = 0; e < 128; ++e) o[e] = 0.f;
    float m = -INFINITY, l = 0.f;
    const int smax = qb * 64 + 63;
    for (int s = 0; s <= smax; ++s) {
        const u32x4* kr = (const u32x4*)(QK + (size_t)s * NTOK + C_BK + g * 64);
        float dot = 0.f;
#pragma unroll
        for (int c = 0; c < 8; ++c) { const u32x4 kv = kr[c];
            dot += q[c * 8 + 0] * __uint_as_float(kv.x << 16) + q[c * 8 + 1] * __uint_as_float(kv.x & 0xffff0000u) + q[c * 8 + 2] * __uint_as_float(kv.y << 16) + q[c * 8 + 3] * __uint_as_float(kv.y & 0xffff0000u)
                 + q[c * 8 + 4] * __uint_as_float(kv.z << 16) + q[c * 8 + 5] * __uint_as_float(kv.z & 0xffff0000u) + q[c * 8 + 6] * __uint_as_float(kv.w << 16) + q[c * 8 + 7] * __uint_as_float(kv.w & 0xffff0000u); }
        const int dist = t - s;
        if (dist >= 0) {
            const float lgt = dot + bt[(dist < 127 ? dist : 127) * 12 + 8 + h];
            if (lgt > m) { const float corr = __expf(m - lgt); l *= corr;
#pragma unroll
                for (int e = 0; e < 128; ++e) o[e] *= corr;
                m = lgt; }
            const float p = __expf(lgt - m); l += p;
            const u32x4* vr = (const u32x4*)(VTOK + (size_t)s * 1024 + 512 + h * 128);
#pragma unroll
            for (int c = 0; c < 16; ++c) { const u32x4 vv = vr[c];
                o[c * 8 + 0] += p * __uint_as_float(vv.x << 16); o[c * 8 + 1] += p * __uint_as_float(vv.x & 0xffff0000u);
                o[c * 8 + 2] += p * __uint_as_float(vv.y << 16); o[c * 8 + 3] += p * __uint_as_float(vv.y & 0xffff0000u);
                o[c * 8 + 4] += p * __uint_as_float(vv.z << 16); o[c * 8 + 5] += p * __uint_as_float(vv.z & 0xffff0000u);
                o[c * 8 + 6] += p * __uint_as_float(vv.w << 16); o[c * 8 + 7] += p * __uint_as_float(vv.w & 0xffff0000u); }
        }
    }
    const float inv = 1.f / l;
    bf16_t* op = OB12 + ((size_t)t * 8 + g) * 128;
#pragma unroll
    for (int e = 0; e < 128; e += 2) *(unsigned*)(op + e) = f2bf(o[e] * inv) | ((unsigned)f2bf(o[e + 1] * inv) << 16);
}
__global__ void __launch_bounds__(256) naive_combine_b(const bf16_t* __restrict__ OB12, const float* __restrict__ lqk, const float* __restrict__ subw, bf16_t* __restrict__ OAB) {
    const int wave = threadIdx.x >> 6, lane = threadIdx.x & 63; const int t = blockIdx.x, h = wave;
    float a = lqk[lane] * lqk[64 + lane], b = lqk[128 + lane] * lqk[192 + lane];
#pragma unroll
    for (int o = 1; o < 64; o <<= 1) { a += __shfl_xor(a, o); b += __shfl_xor(b, o); }
    const float lam = __expf(a) - __expf(b) + LAM_INIT;
    const bf16_t* o1 = OB12 + ((size_t)t * 8 + 2 * h) * 128; const bf16_t* o2 = o1 + 128;
    const float v0 = bf2f(o1[lane]) - lam * bf2f(o2[lane]), v1 = bf2f(o1[64 + lane]) - lam * bf2f(o2[64 + lane]);
    float ss = v0 * v0 + v1 * v1;
#pragma unroll
    for (int o = 1; o < 64; o <<= 1) ss += __shfl_xor(ss, o);
    const float r = rsqrtf(ss * (1.f / 128.f) + 1e-5f) * (1.f - LAM_INIT);
    OAB[(size_t)t * 1024 + 512 + h * 128 + lane] = f2bf(v0 * r * subw[lane]);
    OAB[(size_t)t * 1024 + 512 + h * 128 + 64 + lane] = f2bf(v1 * r * subw[64 + lane]);
}

extern "C" void kernel_launch(void* const* d_in, const int* in_sizes, int n_in, void* d_out, int out_size, void* d_ws, size_t ws_size, hipStream_t stream) {
    const float* x = (const float*)d_in[0]; const float* p = (const float*)d_in[1]; const float* w_in = (const float*)d_in[2];
    const float* w_pa = (const float*)d_in[3]; const float* w_pb = (const float*)d_in[4]; const float* w_o = (const float*)d_in[5];
    const float* lqk = (const float*)d_in[6]; const float* subw = (const float*)d_in[7]; const float* ln_g = (const float*)d_in[8]; const float* ln_b = (const float*)d_in[9];
    const float* w_ple = (const float*)d_in[10]; const float* w_gate = (const float*)d_in[11]; const float* rel_bias = (const float*)d_in[12];
    unsigned char* ws = (unsigned char*)d_ws; float* out = (float*)d_out;
    if (ws_size < WS_END) { fprintf(stderr, "workspace too small: %zu\n", ws_size); return; }
    bf16_t* WIN = (bf16_t*)(ws + WS_WIN); bf16_t* WPA = (bf16_t*)(ws + WS_WPA); bf16_t* WPB = (bf16_t*)(ws + WS_WPB); bf16_t* WO = (bf16_t*)(ws + WS_WO);
    bf16_t* WGT = (bf16_t*)(ws + WS_WGT); bf16_t* WPLE = (bf16_t*)(ws + WS_WPLE); bf16_t* XBF = (bf16_t*)(ws + WS_XBF); bf16_t* PBF = (bf16_t*)(ws + WS_PBF);
    bf16_t* QK = (bf16_t*)(ws + WS_QK); bf16_t* VT = (bf16_t*)(ws + WS_VT); unsigned* BMP = (unsigned*)(ws + WS_BMP); bf16_t* OAB = (bf16_t*)(ws + WS_OAB);
    bf16_t* PLEO = (bf16_t*)(ws + WS_PLEO); bf16_t* G = (bf16_t*)(ws + WS_G); bf16_t* MRG = (bf16_t*)(ws + WS_MRG); bf16_t* XLN = (bf16_t*)(ws + WS_XLN);
    float* BT = (float*)(ws + WS_BT);
    bf16_t* VTOK = (bf16_t*)d_out; bf16_t* OB12 = (bf16_t*)((unsigned char*)d_out + 32 * MiB);

    k_transpose<1><<<dim3(WT_ROWS / 32, 1024 / 32), 256, 0, stream>>>(w_in, WIN, 1024, IN_COLS, WT_ROWS, 0);
    k_transpose<0><<<dim3(1024 / 32, 512 / 32), 256, 0, stream>>>(w_pa, WPA, 512, 1024, 1024, 0);
    k_transpose<0><<<dim3(1024 / 32, 512 / 32), 256, 0, stream>>>(w_pb, WPB, 512, 1024, 1024, 0);
    k_transpose<0><<<dim3(1024 / 32, 1024 / 32), 256, 0, stream>>>(w_o, WO, 1024, 1024, 1024, 0);
    k_transpose<0><<<dim3(1024 / 32, 1024 / 32), 256, 0, stream>>>(w_gate, WGT, 1024, 1024, 1024, 0);
    k_transpose<0><<<dim3(1024 / 32, 256 / 32), 256, 0, stream>>>(w_ple, WPLE, 256, 1024, 1024, 0);
    k_cvt<<<2048, 256, 0, stream>>>(x, XBF, (size_t)L * 1024 / 4);
    k_cvt<<<1024, 256, 0, stream>>>(p, PBF, (size_t)L * 256 / 4);
    k_bias_table<<<6, 256, 0, stream>>>(rel_bias, BT);
    naive_gemm<EpStore><<<dim3(NTOK / 64, L / 64), 256, 0, stream>>>(XBF, WIN + (size_t)WT_TOK * 1024, 1024, 1024, 1024, 0, EpStore{QK, NTOK, 0});
    naive_gemm<EpVT><<<dim3(L / 64, 1024 / 64), 256, 0, stream>>>(WIN + (size_t)WT_VT * 1024, XBF, 1024, 1024, 1024, 0, EpVT{VT, VTOK});
    (void)hipFuncSetAttribute((const void*)naive_index, hipFuncAttributeMaxDynamicSharedMemorySize, 80 * 1024);
    naive_index<<<L, 256, (16384 + 512 + 8 + 4 + 256) * 4, stream>>>(QK, BMP);
    naive_attn_a<<<L, 256, 0, stream>>>(QK, VTOK, BMP, BT, OAB);
    naive_attn_b<<<(L / 64) * 8, 64, 0, stream>>>(QK, VTOK, BT, OB12);
    naive_combine_b<<<L, 256, 0, stream>>>(OB12, lqk, subw, OAB);
    naive_gemm<EpZ><<<dim3(1024 / 64, L / 64), 256, 0, stream>>>(XBF, WIN + (size_t)WT_Z * 1024, 1024, 1024, 1024, 0, EpZ{OAB});
    naive_gemm<EpG><<<dim3(2048 / 64, L / 64), 256, 0, stream>>>(XBF, WIN + (size_t)WT_G * 1024, 1024, 1024, 1024, 0, EpG{G});
    naive_gemm<EpPA><<<dim3(1024 / 64, L / 64), 256, 0, stream>>>(OAB, WPA, 1024, 512, 512, 0, EpPA{G, MRG});
    naive_gemm<EpPB><<<dim3(1024 / 64, L / 64), 256, 0, stream>>>(OAB + 512, WPB, 1024, 512, 512, 0, EpPB{G, MRG});
    naive_gemm<EpO><<<dim3(1024 / 64, L / 64), 256, 0, stream>>>(MRG, WO, 1024, 1024, 1024, 0, EpO{x, out});
    k_ln<<<L / 4, 256, 0, stream>>>(out, ln_g, ln_b, XLN);
    naive_gemm<EpStore><<<dim3(1024 / 64, L / 64), 256, 0, stream>>>(PBF, WPLE, 256, 256, 256, 0, EpStore{PLEO, 1024, 0});
    naive_gemm<EpGate><<<dim3(1024 / 64, L / 64), 256, 0, stream>>>(XLN, WGT, 1024, 1024, 1024, 0, EpGate{out, PLEO});
}
```

```cpp
#include <hip/hip_runtime.h>
#include <cstdint>
#include <cstdio>

typedef unsigned short bf16_t;
typedef unsigned u32x4 __attribute__((ext_vector_type(4)));
typedef unsigned u32x2 __attribute__((ext_vector_type(2)));

constexpr int L = 16384, DM = 1024, PLE = 256;
constexpr int IN_COLS = 6728;
constexpr int NTOK = 2816;
constexpr int C_AQ = 0, C_AK = 512, C_BQ = 1024, C_BK = 1536, C_IQ = 2048, C_IK = 2560, C_IW = 2624;
constexpr int WT_TOK = 0, WT_VT = 2816, WT_Z = 3840, WT_G = 4864, WT_ROWS = 6912;
constexpr float ALPHA = 1.18920711500272f;
constexpr float LAM_INIT = 0.2f;

constexpr size_t MiB = 1u << 20;
constexpr size_t WS_CTL = 0;
constexpr size_t WS_BT = 512 * 1024;
constexpr size_t WS_WIN = 1 * MiB;
constexpr size_t WS_WPA = 15 * MiB;
constexpr size_t WS_WPB = 16 * MiB;
constexpr size_t WS_WO = 17 * MiB;
constexpr size_t WS_WGT = 19 * MiB;
constexpr size_t WS_WPLE = 21 * MiB;
constexpr size_t WS_XBF = 22 * MiB;
constexpr size_t WS_PBF = 54 * MiB;
constexpr size_t WS_QK = 62 * MiB;
constexpr size_t WS_VT = 154 * MiB;
constexpr size_t WS_BMP = 186 * MiB;
constexpr size_t WS_OAB = 218 * MiB;
constexpr size_t WS_END = 250 * MiB;
constexpr size_t WS_PLEO = WS_XBF, WS_G = WS_QK, WS_MRG = WS_VT, WS_XLN = WS_BMP;

__device__ __forceinline__ float bf2f(bf16_t v) { return __uint_as_float(((unsigned)v) << 16); }
__device__ __forceinline__ bf16_t f2bf(float f) { unsigned u = __float_as_uint(f); return (bf16_t)((u + 0x7fffu + ((u >> 16) & 1u)) >> 16); }
__device__ __forceinline__ float sigmoidf_(float v) { return 1.f / (1.f + __expf(-v)); }
__device__ __forceinline__ float siluf_(float v) { return v / (1.f + __expf(-v)); }

__host__ __device__ __forceinline__ int win_src_col(int n) {
    if (n < WT_VT) {
        if (n < 512) return n;
        if (n < 1024) return n;
        if (n < 1536) return 2632 + (n - 1024);
        if (n < 2048) return 3144 + (n - 1536);
        if (n < 2560) return 2048 + (n - 2048);
        if (n < 2624) return 2560 + (n - 2560);
        if (n < 2632) return 2624 + (n - 2624);
        return -1;
    }
    if (n < WT_Z) { int r = n - WT_VT; return r < 512 ? 1024 + r : 3656 + (r - 512); }
    if (n < WT_G) { int r = n - WT_Z; return r < 512 ? 1536 + r : 4168 + (r - 512); }
    return 4680 + (n - WT_G);
}

template <int MODE>
__global__ void __launch_bounds__(256) k_transpose(const float* __restrict__ src, bf16_t* __restrict__ dst, int K, int ld, int N, int pad_) {
    __shared__ float tile[32][33];
    const int n0 = blockIdx.x * 32, k0 = blockIdx.y * 32, tx = threadIdx.x & 31, ty = threadIdx.x >> 5;
    const int n = n0 + tx; const int c = MODE == 0 ? n : win_src_col(n);
#pragma unroll
    for (int i = 0; i < 4; ++i) { const int k = k0 + ty + 8 * i; tile[ty + 8 * i][tx] = (c >= 0) ? src[(size_t)k * ld + c] : 0.f; }
    __syncthreads();
#pragma unroll
    for (int i = 0; i < 4; ++i) { const int nn = n0 + ty + 8 * i; dst[(size_t)nn * K + k0 + tx] = f2bf(tile[tx][ty + 8 * i]); }
}
__global__ void __launch_bounds__(256) k_cvt(const float* __restrict__ src, bf16_t* __restrict__ dst, size_t n4) {
    for (size_t i = (size_t)blockIdx.x * 256 + threadIdx.x; i < n4; i += (size_t)gridDim.x * 256) {
        const float4 v = ((const float4*)src)[i]; u32x2 o; o.x = f2bf(v.x) | ((unsigned)f2bf(v.y) << 16); o.y = f2bf(v.z) | ((unsigned)f2bf(v.w) << 16); ((u32x2*)dst)[i] = o; }
}
__device__ __forceinline__ int rel_bucket(int n) {
    if (n < 16) return n;
    int b = 16 + (int)(logf((float)n / 16.f) / logf(8.f) * 16.f);
    return b > 31 ? 31 : b;
}
__global__ void k_bias_table(const float* __restrict__ rel_bias, float* __restrict__ bt) {
    const int i = threadIdx.x + blockIdx.x * blockDim.x;
    if (i < 128 * 12) { const int n = i / 12, h = i % 12; bt[i] = rel_bias[rel_bucket(n) * 12 + h]; }
}

template <class Epi>
__global__ void __launch_bounds__(256) naive_gemm(const bf16_t* __restrict__ A, const bf16_t* __restrict__ Bt, int lda, int ldb, int K, int pad_, Epi E) {
    __shared__ float As[16][68], Bs[16][68];
    const int tid = threadIdx.x, bm = blockIdx.y * 64, bn = blockIdx.x * 64, tx = tid & 15, ty = tid >> 4;
    const int lr = tid >> 2, lk = (tid & 3) * 4;
    float acc[4][4];
#pragma unroll
    for (int i = 0; i < 4; ++i)
#pragma unroll
        for (int j = 0; j < 4; ++j) acc[i][j] = 0.f;
    for (int k0 = 0; k0 < K; k0 += 16) {
        const u32x2 av = *(const u32x2*)(A + (size_t)(bm + lr) * lda + k0 + lk);
        const u32x2 bv = *(const u32x2*)(Bt + (size_t)(bn + lr) * ldb + k0 + lk);
        As[lk + 0][lr] = __uint_as_float(av.x << 16); As[lk + 1][lr] = __uint_as_float(av.x & 0xffff0000u);
        As[lk + 2][lr] = __uint_as_float(av.y << 16); As[lk + 3][lr] = __uint_as_float(av.y & 0xffff0000u);
        Bs[lk + 0][lr] = __uint_as_float(bv.x << 16); Bs[lk + 1][lr] = __uint_as_float(bv.x & 0xffff0000u);
        Bs[lk + 2][lr] = __uint_as_float(bv.y << 16); Bs[lk + 3][lr] = __uint_as_float(bv.y & 0xffff0000u);
        __syncthreads();
#pragma unroll
        for (int k = 0; k < 16; ++k) {
            const float4 a = *(const float4*)&As[k][ty * 4]; const float4 b = *(const float4*)&Bs[k][tx * 4];
            acc[0][0] += a.x * b.x; acc[0][1] += a.x * b.y; acc[0][2] += a.x * b.z; acc[0][3] += a.x * b.w;
            acc[1][0] += a.y * b.x; acc[1][1] += a.y * b.y; acc[1][2] += a.y * b.z; acc[1][3] += a.y * b.w;
            acc[2][0] += a.z * b.x; acc[2][1] += a.z * b.y; acc[2][2] += a.z * b.z; acc[2][3] += a.z * b.w;
            acc[3][0] += a.w * b.x; acc[3][1] += a.w * b.y; acc[3][2] += a.w * b.z; acc[3][3] += a.w * b.w;
        }
        __syncthreads();
    }
#pragma unroll
    for (int i = 0; i < 4; ++i)
#pragma unroll
        for (int j = 0; j < 4; ++j) E(bm + ty * 4 + i, bn + tx * 4 + j, acc[i][j]);
}
struct EpStore { bf16_t* O; int ld; int pad; __device__ void operator()(int m, int n, float v) const { O[(size_t)m * ld + n] = f2bf(v); } };
struct EpVT { bf16_t* VT; bf16_t* VTOK; __device__ void operator()(int m, int n, float v) const { const bf16_t b = f2bf(v); VT[(size_t)m * L + n] = b; VTOK[(size_t)n * 1024 + m] = b; } };
struct EpZ { bf16_t* OAB; __device__ void operator()(int m, int n, float v) const { const size_t i = (size_t)m * 1024 + n; OAB[i] = f2bf(siluf_(v) * bf2f(OAB[i])); } };
struct EpG { bf16_t* G; __device__ void operator()(int m, int n, float v) const { G[(size_t)m * 2048 + n] = f2bf(sigmoidf_(v)); } };
struct EpPA { const bf16_t* G; bf16_t* MRG; __device__ void operator()(int m, int n, float v) const { MRG[(size_t)m * 1024 + n] = f2bf(bf2f(G[(size_t)m * 2048 + n]) * v); } };
struct EpPB { const bf16_t* G; bf16_t* MRG; __device__ void operator()(int m, int n, float v) const { const size_t i = (size_t)m * 1024 + n; MRG[i] = f2bf(bf2f(MRG[i]) + bf2f(G[(size_t)m * 2048 + 1024 + n]) * v); } };
struct EpO { const float* x; float* PRE; __device__ void operator()(int m, int n, float v) const { const size_t i = (size_t)m * 1024 + n; PRE[i] = ALPHA * x[i] + v; } };
struct EpGate { float* out; const bf16_t* PLEO; __device__ void operator()(int m, int n, float v) const { const size_t i = (size_t)m * 1024 + n; out[i] = out[i] + sigmoidf_(v) * bf2f(PLEO[i]); } };

__global__ void __launch_bounds__(256) k_ln(float* __restrict__ io, const float* __restrict__ g, const float* __restrict__ b, bf16_t* __restrict__ xln) {
    const int wave = threadIdx.x >> 6, lane = threadIdx.x & 63; const int row = blockIdx.x * 4 + wave;
    float4* r = (float4*)(io + (size_t)row * 1024) + lane; float4 v[4]; float s = 0.f;
#pragma unroll
    for (int j = 0; j < 4; ++j) { v[j] = r[64 * j]; s += (v[j].x + v[j].y) + (v[j].z + v[j].w); }
#pragma unroll
    for (int o = 1; o < 64; o <<= 1) s += __shfl_xor(s, o);
    const float mean = s * (1.f / 1024.f); float q = 0.f;
#pragma unroll
    for (int j = 0; j < 4; ++j) { v[j].x -= mean; v[j].y -= mean; v[j].z -= mean; v[j].w -= mean; q += (v[j].x * v[j].x + v[j].y * v[j].y) + (v[j].z * v[j].z + v[j].w * v[j].w); }
#pragma unroll
    for (int o = 1; o < 64; o <<= 1) q += __shfl_xor(q, o);
    const float rstd = rsqrtf(q * (1.f / 1024.f) + 1e-5f);
#pragma unroll
    for (int j = 0; j < 4; ++j) {
        const float4 gg = ((const float4*)g)[lane + 64 * j], bb = ((const float4*)b)[lane + 64 * j];
        float4 o; o.x = v[j].x * rstd * gg.x + bb.x; o.y = v[j].y * rstd * gg.y + bb.y; o.z = v[j].z * rstd * gg.z + bb.z; o.w = v[j].w * rstd * gg.w + bb.w;
        r[64 * j] = o; u32x2 w; w.x = f2bf(o.x) | ((unsigned)f2bf(o.y) << 16); w.y = f2bf(o.z) | ((unsigned)f2bf(o.w) << 16);
        ((u32x2*)(xln + (size_t)row * 1024))[lane + 64 * j] = w;
    }
}

__device__ __forceinline__ unsigned fkey(float f) { const unsigned u = __float_as_uint(f); return (u & 0x80000000u) ? ~u : (u | 0x80000000u); }
__device__ __forceinline__ int block_sum_256(int v, volatile int* red) {
#pragma unroll
    for (int o = 1; o < 64; o <<= 1) v += __shfl_xor(v, o);
    __syncthreads();
    if ((threadIdx.x & 63) == 0) red[threadIdx.x >> 6] = v;
    __syncthreads();
    return red[0] + red[1] + red[2] + red[3];
}
__global__ void __launch_bounds__(256) naive_index(const bf16_t* __restrict__ QK, unsigned* __restrict__ bitmap) {
    extern __shared__ float smem[];
    float* sc = smem;
    float* qf = smem + 16384;
    float* wv = qf + 512;
    int* red = (int*)(wv + 8);
    int* scan = red + 4;
    const int tid = threadIdx.x, t = L - 1 - (int)blockIdx.x;
    const bf16_t* qrow = QK + (size_t)t * NTOK;
    for (int j = tid; j < 512; j += 256) qf[j] = bf2f(qrow[C_IQ + j]);
    if (tid < 8) wv[tid] = bf2f(qrow[C_IW + tid]) * 0.35355339059327373f;
    __syncthreads();
    for (int s = tid; s <= t; s += 256) {
        const u32x4* kr = (const u32x4*)(QK + (size_t)s * NTOK + C_IK);
        float acc[8];
#pragma unroll
        for (int h = 0; h < 8; ++h) acc[h] = 0.f;
#pragma unroll
        for (int c = 0; c < 8; ++c) {
            const u32x4 kv = kr[c];
            const float k0 = __uint_as_float(kv.x << 16), k1 = __uint_as_float(kv.x & 0xffff0000u), k2 = __uint_as_float(kv.y << 16), k3 = __uint_as_float(kv.y & 0xffff0000u);
            const float k4 = __uint_as_float(kv.z << 16), k5 = __uint_as_float(kv.z & 0xffff0000u), k6 = __uint_as_float(kv.w << 16), k7 = __uint_as_float(kv.w & 0xffff0000u);
#pragma unroll
            for (int h = 0; h < 8; ++h) {
                const float4 qa = *(const float4*)&qf[h * 64 + c * 8], qb = *(const float4*)&qf[h * 64 + c * 8 + 4];
                acc[h] += qa.x * k0 + qa.y * k1 + qa.z * k2 + qa.w * k3 + qb.x * k4 + qb.y * k5 + qb.z * k6 + qb.w * k7;
            }
        }
        float score = 0.f;
#pragma unroll
        for (int h = 0; h < 8; ++h) score += wv[h] * fmaxf(acc[h] * 0.125f, 0.f);
        sc[s] = score;
    }
    __syncthreads();
    const int n = t + 1;
    unsigned w0 = 0u, w1 = 0u;
    const int base = tid * 64;
    if (n <= 256) {
#pragma unroll 1
        for (int j = 0; j < 64; ++j) { const int s = base + j; if (s <= t) { if (j < 32) w0 |= 1u << j; else w1 |= 1u << (j - 32); } }
    } else {
        unsigned prefix = 0u;
        for (int bit = 31; bit >= 0; --bit) {
            const unsigned cand = prefix | (1u << bit); int c = 0;
            for (int s = tid; s <= t; s += 256) c += (fkey(sc[s]) >= cand) ? 1 : 0;
            if (block_sum_256(c, red) >= 256) prefix = cand;
        }
        int cgt = 0, ceq = 0;
        for (int j = 0; j < 64; ++j) { const int s = base + j; if (s <= t) { const unsigned k = fkey(sc[s]); cgt += k > prefix; ceq += k == prefix; } }
        const int tot_gt = block_sum_256(cgt, red);
        const int need = 256 - tot_gt;
        scan[tid] = ceq; __syncthreads();
        int before = 0; for (int j = 0; j < tid; ++j) before += scan[j];
        for (int j = 0; j < 64; ++j) { const int s = base + j; if (s <= t) { const unsigned k = fkey(sc[s]); bool sel = k > prefix;
                if (k == prefix) { sel = before < need; ++before; }
                if (sel) { if (j < 32) w0 |= 1u << j; else w1 |= 1u << (j - 32); } } }
    }
    bitmap[(size_t)t * 512 + tid * 2] = w0; bitmap[(size_t)t * 512 + tid * 2 + 1] = w1;
}

__global__ void __launch_bounds__(256) naive_attn_a(const bf16_t* __restrict__ QK, const bf16_t* __restrict__ VTOK, const unsigned* __restrict__ bitmap,
                                                    const float* __restrict__ bt, bf16_t* __restrict__ OAB) {
    __shared__ float qf[512]; __shared__ int sel[256]; __shared__ int scan[256]; __shared__ float lg[8][256]; __shared__ float linv[8];
    const int tid = threadIdx.x, t = L - 1 - (int)blockIdx.x;
    const unsigned w0 = bitmap[(size_t)t * 512 + tid * 2], w1 = bitmap[(size_t)t * 512 + tid * 2 + 1];
    scan[tid] = __popc(w0) + __popc(w1);
    for (int j = tid; j < 512; j += 256) qf[j] = bf2f(QK[(size_t)t * NTOK + C_AQ + j]);
    __syncthreads();
    int pos = 0; for (int j = 0; j < tid; ++j) pos += scan[j];
    int cnt = 0; for (int j = 0; j < 256; ++j) cnt += scan[j];
    for (int j = 0; j < 32; ++j) { if (w0 >> j & 1u) { if (pos < 256) sel[pos] = tid * 64 + j; ++pos; } }
    for (int j = 0; j < 32; ++j) { if (w1 >> j & 1u) { if (pos < 256) sel[pos] = tid * 64 + 32 + j; ++pos; } }
    if (cnt > 256) cnt = 256;
    __syncthreads();
    if (tid < cnt) {
        const int s = sel[tid]; const int dist = t - s; const int db = dist < 127 ? dist : 127;
        const bf16_t* kr = QK + (size_t)s * NTOK + C_AK;
#pragma unroll 1
        for (int h = 0; h < 8; ++h) { float a = 0.f;
            for (int d = 0; d < 64; ++d) a += qf[h * 64 + d] * bf2f(kr[h * 64 + d]);
            lg[h][tid] = a * 0.125f + bt[db * 12 + h]; }
    }
    __syncthreads();
    { const int wave = tid >> 6, lane = tid & 63;
      for (int hh = 0; hh < 2; ++hh) { const int h = wave * 2 + hh; float m = -INFINITY;
          for (int j = lane; j < cnt; j += 64) m = fmaxf(m, lg[h][j]);
          for (int o = 1; o < 64; o <<= 1) m = fmaxf(m, __shfl_xor(m, o));
          float s = 0.f;
          for (int j = lane; j < cnt; j += 64) { const float p = __expf(lg[h][j] - m); lg[h][j] = p; s += p; }
          for (int o = 1; o < 64; o <<= 1) s += __shfl_xor(s, o);
          if (lane == 0) linv[h] = 1.f / s; } }
    __syncthreads();
    for (int hd = tid; hd < 512; hd += 256) { const int h = hd >> 6; float o = 0.f;
        for (int j = 0; j < cnt; ++j) o += lg[h][j] * bf2f(VTOK[(size_t)sel[j] * 1024 + hd]);
        OAB[(size_t)t * 1024 + hd] = f2bf(o * linv[h]); }
}

__global__ void __launch_bounds__(64) naive_attn_b(const bf16_t* __restrict__ QK, const bf16_t* __restrict__ VTOK, const float* __restrict__ bt, bf16_t* __restrict__ OB12) {
    const int g = blockIdx.x & 7, qb = (L / 64 - 1) - (int)(blockIdx.x >> 3), lane = threadIdx.x, t = qb * 64 + lane, h = g >> 1;
    float q[64], o[128];
#pragma unroll
    for (int d = 0; d < 64; ++d) q[d] = bf2f(QK[(size_t)t * NTOK + C_BQ + g * 64 + d]) * 0.125f;
#pragma unroll
    for (int e = 0; e < 128; ++e) o[e] = 0.f;
    float m = -INFINITY, l = 0.f;
    const int smax = qb * 64 + 63;
    for (int s = 0; s <= smax; ++s) {
        const u32x4* kr = (const u32x4*)(QK + (size_t)s * NTOK + C_BK + g * 64);
        float dot = 0.f;
#pragma unroll
        for (int c = 0; c < 8; ++c) { const u32x4 kv = kr[c];
            dot += q[c * 8 + 0] * __uint_as_float(kv.x << 16) + q[c * 8 + 1] * __uint_as_float(kv.x & 0xffff0000u) + q[c * 8 + 2] * __uint_as_float(kv.y << 16) + q[c * 8 + 3] * __uint_as_float(kv.y & 0xffff0000u)
                 + q[c * 8 + 4] * __uint_as_float(kv.z << 16) + q[c * 8 + 5] * __uint_as_float(kv.z & 0xffff0000u) + q[c * 8 + 6] * __uint_as_float(kv.w << 16) + q[c * 8 + 7] * __uint_as_float(kv.w & 0xffff0000u); }
        const int dist = t - s;
        if (dist >= 0) {
            const float lgt = dot + bt[(dist < 127 ? dist : 127) * 12 + 8 + h];
            if (lgt > m) { const float corr = __expf(m - lgt); l *= corr;
#pragma unroll
                for (int e = 0; e < 128; ++e) o[e] *= corr;
                m = lgt; }
            const float p = __expf(lgt - m); l += p;
            const u32x4* vr = (const u32x4*)(VTOK + (size_t)s * 1024 + 512 + h * 128);
#pragma unroll
            for (int c = 0; c < 16; ++c) { const u32x4 vv = vr[c];
                o[c * 8 + 0] += p * __uint_as_float(vv.x << 16); o[c * 8 + 1] += p * __uint_as_float(vv.x & 0xffff0000u);
                o[c * 8 + 2] += p * __uint_as_float(vv.y << 16); o[c * 8 + 3] += p * __uint_as_float(vv.y & 0xffff0000u);
                o[c * 8 + 4] += p * __uint_as_float(vv.z << 16); o[c * 8 + 5] += p * __uint_as_float(vv.z & 0xffff0000u);
                o[c * 8 + 6] += p * __uint_as_float(vv.w << 16); o[c * 8 + 7] += p * __uint_as_float(vv.w & 0xffff0000u); }
        }
    }
    const float inv = 1.f / l;
    bf16_t* op = OB12 + ((size_t)t * 8 + g) * 128;
#pragma unroll
    for (int e = 0; e < 128; e += 2) *(unsigned*)(op + e) = f2bf(o[e] * inv) | ((unsigned)f2bf(o[e + 1] * inv) << 16);
}
__global__ void __launch_bounds__(256) naive_combine_b(const bf16_t* __restrict__ OB12, const float* __restrict__ lqk, const float* __restrict__ subw, bf16_t* __restrict__ OAB) {
    const int wave = threadIdx.x >> 6, lane = threadIdx.x & 63; const int t = blockIdx.x, h = wave;
    float a = lqk[lane] * lqk[64 + lane], b = lqk[128 + lane] * lqk[192 + lane];
#pragma unroll
    for (int o = 1; o < 64; o <<= 1) { a += __shfl_xor(a, o); b += __shfl_xor(b, o); }
    const float lam = __expf(a) - __expf(b) + LAM_INIT;
    const bf16_t* o1 = OB12 + ((size_t)t * 8 + 2 * h) * 128; const bf16_t* o2 = o1 + 128;
    const float v0 = bf2f(o1[lane]) - lam * bf2f(o2[lane]), v1 = bf2f(o1[64 + lane]) - lam * bf2f(o2[64 + lane]);
    float ss = v0 * v0 + v1 * v1;
#pragma unroll
    for (int o = 1; o < 64; o <<= 1) ss += __shfl_xor(ss, o);
    const float r = rsqrtf(ss * (1.f / 128.f) + 1e-5f) * (1.f - LAM_INIT);
    OAB[(size_t)t * 1024 + 512 + h * 128 + lane] = f2bf(v0 * r * subw[lane]);
    OAB[(size_t)t * 1024 + 512 + h * 128 + 64 + lane] = f2bf(v1 * r * subw[64 + lane]);
}

namespace pg8 {
#define PG8_LAS __attribute__((address_space(3)))
typedef unsigned short bf16_t;
typedef short bf16x8 __attribute__((ext_vector_type(8)));
typedef float f32x4 __attribute__((ext_vector_type(4)));
typedef unsigned u32x4 __attribute__((ext_vector_type(4)));
constexpr int BM = 256, BK = 64, HALF = 128, HTB = HALF * BK * 2  , STAGE_BYTES = 8 * HTB, NXCD = 8, WGM = 8;

__host__ __device__ __forceinline__ int lds_byte(int r, int c) { const int st = (r >> 4) * 2 + (c >> 5), rr = r & 15, cc = c & 31, ob = rr * 64 + cc * 2; return st * 1024 + (ob ^ (((ob >> 9) & 1) << 5)); }
__host__ __device__ __forceinline__ void stage_rc(int b, int& R, int& C) { const int st = b / 1024, sb = b % 1024, swz = sb ^ (((sb >> 9) & 1) << 5); R = (st >> 1) * 16 + swz / 64; C = (st & 1) * 32 + (swz % 64) / 2; }
__host__ __device__ __forceinline__ int perm32(int rho) { const int n = rho >> 4, i = rho & 15; return 8 * (i >> 2) + 4 * n + (i & 3); }

struct Unit { int pm, pn; };
struct Gemm { const bf16_t* A; const bf16_t* Bt; int M, N, K, lda, ldb; };

struct StaticOrder {
    int nM, nN, nwg, G, c;
    __host__ __device__ void init(int M, int N, int G_, int c_) { nM = M / BM; nN = N / BM; nwg = nM * nN; G = G_; c = c_; }
    __host__ __device__ bool next(int i, Unit& u) const {
        const long L = (long)i * G + c; if (L >= nwg) return false;
        int wgid = (int)L; { const int q = nwg / NXCD, r = nwg % NXCD, xcd = wgid % NXCD, off = wgid / NXCD; wgid = (xcd < r ? xcd * (q + 1) : r * (q + 1) + (xcd - r) * q) + off; }
        const int nig = WGM * nN, gid = wgid / nig, fm = gid * WGM, gsz = (nM - fm) < WGM ? (nM - fm) : WGM;
        u.pm = fm + ((wgid % nig) % gsz); u.pn = (wgid % nig) / gsz; return true;
    }
    __device__ __forceinline__ void a_ready(const Unit&) const {}
    __device__ __forceinline__ void done(const Unit&) const {}
};


typedef float f32x2_t __attribute__((ext_vector_type(2))); typedef __bf16 bf16x2_t __attribute__((ext_vector_type(2)));
__device__ __forceinline__ unsigned cvt_pk_bf16(float lo, float hi) { f32x2_t v = {lo, hi}; bf16x2_t b = __builtin_convertvector(v, bf16x2_t); return __builtin_bit_cast(unsigned, b); }
__device__ __forceinline__ u32x4 pack8(const f32x4 a, const f32x4 b) { u32x4 w; w.x = cvt_pk_bf16(a[0], a[1]); w.y = cvt_pk_bf16(a[2], a[3]); w.z = cvt_pk_bf16(b[0], b[1]); w.w = cvt_pk_bf16(b[2], b[3]); return w; }
__device__ __forceinline__ void unpack8(const u32x4 w, f32x4& a, f32x4& b) {
    a[0] = __uint_as_float(w.x << 16); a[1] = __uint_as_float(w.x & 0xffff0000u); a[2] = __uint_as_float(w.y << 16); a[3] = __uint_as_float(w.y & 0xffff0000u);
    b[0] = __uint_as_float(w.z << 16); b[1] = __uint_as_float(w.z & 0xffff0000u); b[2] = __uint_as_float(w.w << 16); b[3] = __uint_as_float(w.w & 0xffff0000u); }
__device__ __forceinline__ float fsig(float v) { return __builtin_amdgcn_rcpf(1.f + __expf(-v)); }
__device__ __forceinline__ f32x4 sig4(const f32x4 v) { f32x4 r; r[0] = fsig(v[0]); r[1] = fsig(v[1]); r[2] = fsig(v[2]); r[3] = fsig(v[3]); return r; }
#define PG8_EPI_LOOP(...) \
    _Pragma("unroll") for (int ai = 0; ai < 2; ++ai) _Pragma("unroll") for (int m = 0; m < 4; ++m) { const size_t row = (size_t)(u.pm * BM + ai * HALF + wr * 64 + m * 16 + fr); \
    _Pragma("unroll") for (int bj = 0; bj < 2; ++bj) { const int col = u.pn * BM + bj * HALF + wc * 32 + 8 * fq; f32x4 v0 = acc[ai][bj][m][0], v1 = acc[ai][bj][m][1]; __VA_ARGS__ } }
#define PG8_EPI_SIG const f32x4 (&acc)[2][2][4][2], const Unit& u, int wr, int wc, int fr, int fq
struct EpiStoreBf { static constexpr bool PERM = true, AFTER_DRAIN = false; bf16_t* O; int ldc, pad;
    __device__ __forceinline__ void operator()(PG8_EPI_SIG) const { PG8_EPI_LOOP( *(u32x4*)(O + row * ldc + col) = pack8(v0, v1); ) } };
struct EpiVTdual { static constexpr bool PERM = true, AFTER_DRAIN = false; bf16_t* VT; bf16_t* VTOK;
    __device__ __forceinline__ void operator()(PG8_EPI_SIG) const { PG8_EPI_LOOP( const u32x4 w = pack8(v0, v1); *(u32x4*)(VT + row * 16384 + col) = w;
        if (VTOK) { VTOK[(size_t)(col + 0) * 1024 + row] = (bf16_t)(w.x & 0xffff); VTOK[(size_t)(col + 1) * 1024 + row] = (bf16_t)(w.x >> 16); VTOK[(size_t)(col + 2) * 1024 + row] = (bf16_t)(w.y & 0xffff); VTOK[(size_t)(col + 3) * 1024 + row] = (bf16_t)(w.y >> 16);
                    VTOK[(size_t)(col + 4) * 1024 + row] = (bf16_t)(w.z & 0xffff); VTOK[(size_t)(col + 5) * 1024 + row] = (bf16_t)(w.z >> 16); VTOK[(size_t)(col + 6) * 1024 + row] = (bf16_t)(w.w & 0xffff); VTOK[(size_t)(col + 7) * 1024 + row] = (bf16_t)(w.w >> 16); } ) } };
struct EpiZ { static constexpr bool PERM = true, AFTER_DRAIN = false; bf16_t* OAB;
    __device__ __forceinline__ void operator()(PG8_EPI_SIG) const { PG8_EPI_LOOP( u32x4* p = (u32x4*)(OAB + row * 1024 + col); f32x4 o0, o1; unpack8(*p, o0, o1);
        *p = pack8(v0 * sig4(v0) * o0, v1 * sig4(v1) * o1); ) } };
struct EpiG { static constexpr bool PERM = true, AFTER_DRAIN = false; bf16_t* G;
    __device__ __forceinline__ void operator()(PG8_EPI_SIG) const { PG8_EPI_LOOP( *(u32x4*)(G + row * 2048 + col) = pack8(sig4(v0), sig4(v1)); ) } };
struct EpiPA { static constexpr bool PERM = true, AFTER_DRAIN = false; const bf16_t* G; bf16_t* MRG;
    __device__ __forceinline__ void operator()(PG8_EPI_SIG) const { PG8_EPI_LOOP( f32x4 g0, g1; unpack8(*(const u32x4*)(G + row * 2048 + col), g0, g1);
        *(u32x4*)(MRG + row * 1024 + col) = pack8(g0 * v0, g1 * v1); ) } };
struct EpiPB { static constexpr bool PERM = true, AFTER_DRAIN = false; const bf16_t* G; bf16_t* MRG;
    __device__ __forceinline__ void operator()(PG8_EPI_SIG) const { PG8_EPI_LOOP( f32x4 g0, g1, m0, m1; unpack8(*(const u32x4*)(G + row * 2048 + 1024 + col), g0, g1);
        u32x4* p = (u32x4*)(MRG + row * 1024 + col); unpack8(*p, m0, m1); *p = pack8(m0 + g0 * v0, m1 + g1 * v1); ) } };
struct EpiO { static constexpr bool PERM = true, AFTER_DRAIN = false; const float* x; float* PRE;
    __device__ __forceinline__ void operator()(PG8_EPI_SIG) const { PG8_EPI_LOOP( const f32x4 x0 = *(const f32x4*)(x + row * 1024 + col), x1 = *(const f32x4*)(x + row * 1024 + col + 4);
        *(f32x4*)(PRE + row * 1024 + col) = x0 * 1.18920711500272f + v0; *(f32x4*)(PRE + row * 1024 + col + 4) = x1 * 1.18920711500272f + v1; ) } };
struct EpiGate { static constexpr bool PERM = true, AFTER_DRAIN = false; float* out; const bf16_t* PLEO;
    __device__ __forceinline__ void operator()(PG8_EPI_SIG) const { PG8_EPI_LOOP( f32x4 p0, p1; unpack8(*(const u32x4*)(PLEO + row * 1024 + col), p0, p1);
        f32x4* o = (f32x4*)(out + row * 1024 + col); const f32x4 a0 = o[0], a1 = o[1]; o[0] = a0 + sig4(v0) * p0; o[1] = a1 + sig4(v1) * p1; ) } };

template <class Epi, class Sched, bool ALIGN_EPI = false, bool SP2 = false>
__device__ __forceinline__ void gemm_phase(PG8_LAS unsigned char* lds, const Gemm g, const Sched& S, const Epi& E) {
    const int tid = threadIdx.x, wid = __builtin_amdgcn_readfirstlane(tid >> 6), lane = tid & 63, wr = wid >> 2, wc = wid & 3, fr = lane & 15, fq = lane >> 4;
    const int K = g.K, nt = K / BK;
    unsigned voffA[2], voffB[2];
#pragma unroll
    for (int i = 0; i < 2; ++i) { int R, C; stage_rc(tid * 16 + i * 8192, R, C); const int Rb = Epi::PERM ? ((R & ~31) + perm32(R & 31)) : R;
        voffA[i] = (unsigned)(R * g.lda + C) * 2u; voffB[i] = (unsigned)(Rb * g.ldb + C) * 2u; }
    const size_t kstep = (size_t)(BK * 2);
    const size_t hstepA = (size_t)HALF * g.lda * 2, hstepB = (size_t)HALF * g.ldb * 2;
    const size_t tstepA = 2 * hstepA, tstepB = 2 * hstepB;
    const unsigned ldsw = (unsigned)wid * 1024u;
    const int aoff = lds_byte(wr * 64 + fr, fq * 8), boff = lds_byte(wc * 32 + fr, fq * 8);
#define PG8_SA(b, h) (((b) * 2 + (h)) * HTB)
#define PG8_SB(b, h) ((4 + (b) * 2 + (h)) * HTB)
#define PG8_STAGE(bufoff, gbase, voff) do { _Pragma("unroll") for (int _i = 0; _i < 2; ++_i) \
        __builtin_amdgcn_global_load_lds((const unsigned*)((const char*)(gbase) + (voff)[_i]), (PG8_LAS unsigned*)(lds + (bufoff) + ldsw + _i * 8192), 16, 0, 0); } while (0)
#define PG8_LDA(dst, b, h) do { _Pragma("unroll") for (int m = 0; m < 4; ++m) _Pragma("unroll") for (int k = 0; k < 2; ++k) dst[m][k] = *(const PG8_LAS bf16x8*)(lds + PG8_SA(b, h) + aoff + m * 2048 + k * 1024); } while (0)
#define PG8_LDB(dst, b, h) do { _Pragma("unroll") for (int n = 0; n < 2; ++n) _Pragma("unroll") for (int k = 0; k < 2; ++k) dst[n][k] = *(const PG8_LAS bf16x8*)(lds + PG8_SB(b, h) + boff + n * 2048 + k * 1024); } while (0)
#define PG8_MMA(ai, bj, At, Bt) do { __builtin_amdgcn_s_setprio(1); _Pragma("unroll") for (int m = 0; m < 4; ++m) _Pragma("unroll") for (int n = 0; n < 2; ++n) _Pragma("unroll") for (int k = 0; k < 2; ++k) \
        acc[ai][bj][m][n] = __builtin_amdgcn_mfma_f32_16x16x32_bf16(Bt[n][k], At[m][k], acc[ai][bj][m][n], 0, 0, 0); __builtin_amdgcn_s_setprio(0); } while (0)
#define PG8_WAIT_V(n) asm volatile("s_waitcnt vmcnt(" #n ")" ::: "memory")
#define PG8_WAIT_L(n) asm volatile("s_waitcnt lgkmcnt(" #n ")" ::: "memory")
#define PG8_BAR __builtin_amdgcn_s_barrier()
#define PG8_SCHED __builtin_amdgcn_sched_barrier(0)
    Unit cur, nxt; int ui = 0;
    if (!S.next(0, cur)) return;
    f32x4 acc[2][2][4][2];
#pragma unroll
    for (int a = 0; a < 2; ++a)
#pragma unroll
        for (int b = 0; b < 2; ++b)
#pragma unroll
            for (int m = 0; m < 4; ++m)
#pragma unroll
                for (int n = 0; n < 2; ++n) acc[a][b][m][n] = (f32x4){0.f, 0.f, 0.f, 0.f};
    bf16x8 At[4][2], B0[2][2], B1[2][2];
    const char* cA = (const char*)g.A + (size_t)cur.pm * tstepA; const char* cB = (const char*)g.Bt + (size_t)cur.pn * tstepB;
    S.a_ready(cur);
    if constexpr (SP2) {
        PG8_STAGE(PG8_SB(0, 0), cB, voffB); PG8_STAGE(PG8_SB(0, 1), cB + hstepB, voffB); PG8_STAGE(PG8_SA(0, 0), cA, voffA); PG8_STAGE(PG8_SA(0, 1), cA + hstepA, voffA);
        if (wr == 1) PG8_BAR;
        PG8_WAIT_V(2); PG8_BAR;
        PG8_STAGE(PG8_SB(1, 0), cB + kstep, voffB); PG8_STAGE(PG8_SA(1, 0), cA + kstep, voffA); PG8_STAGE(PG8_SB(1, 1), cB + hstepB + kstep, voffB);
        PG8_WAIT_V(6); PG8_BAR;
    } else {
        PG8_STAGE(PG8_SB(0, 0), cB, voffB); PG8_STAGE(PG8_SA(0, 0), cA, voffA); PG8_STAGE(PG8_SB(0, 1), cB + hstepB, voffB); PG8_STAGE(PG8_SA(0, 1), cA + hstepA, voffA);
        if (wr == 1) PG8_BAR;
        PG8_WAIT_V(4); PG8_BAR;
        PG8_STAGE(PG8_SB(1, 0), cB + kstep, voffB); PG8_STAGE(PG8_SA(1, 0), cA + kstep, voffA); PG8_STAGE(PG8_SB(1, 1), cB + hstepB + kstep, voffB);
        PG8_WAIT_V(6); PG8_BAR;
    }
    for (;;) {
        const bool has_next = S.next(ui + 1, nxt);
        const char* nA = has_next ? (const char*)g.A + (size_t)nxt.pm * tstepA : cA; const char* nB = has_next ? (const char*)g.Bt + (size_t)nxt.pn * tstepB : cB;
        for (int t = 0; t < nt; t += 2) {
            const bool last = (t == nt - 2);
            const char* a1 = cA + (size_t)(t + 1) * kstep;
            const char* a2 = last ? nA : cA + (size_t)(t + 2) * kstep; const char* b2 = last ? nB : cB + (size_t)(t + 2) * kstep;
            const char* a3 = a2 + kstep; const char* b3 = b2 + kstep;
            if (last && has_next) S.a_ready(nxt);
            if constexpr (SP2) {
            PG8_LDB(B0, 0, 0); PG8_LDB(B1, 0, 1); PG8_SCHED; PG8_LDA(At, 0, 0); PG8_STAGE(PG8_SA(1, 1), a1 + hstepA, voffA);
            PG8_WAIT_V(8); PG8_WAIT_L(0); PG8_BAR; PG8_MMA(0, 0, At, B0); PG8_MMA(0, 1, At, B1); PG8_BAR; PG8_SCHED;
            PG8_LDA(At, 0, 1); PG8_STAGE(PG8_SB(0, 0), b2, voffB); PG8_STAGE(PG8_SB(0, 1), b2 + hstepB, voffB); PG8_STAGE(PG8_SA(0, 0), a2, voffA);
            PG8_WAIT_V(8); PG8_WAIT_L(0); PG8_BAR; PG8_MMA(1, 0, At, B0); PG8_MMA(1, 1, At, B1); PG8_BAR; PG8_SCHED;
            PG8_LDB(B0, 1, 0); PG8_LDB(B1, 1, 1); PG8_SCHED; PG8_LDA(At, 1, 0); PG8_STAGE(PG8_SA(0, 1), a2 + hstepA, voffA);
            PG8_WAIT_V(8); PG8_WAIT_L(0); PG8_BAR; PG8_MMA(0, 0, At, B0); PG8_MMA(0, 1, At, B1); PG8_BAR; PG8_SCHED;
            PG8_LDA(At, 1, 1); PG8_STAGE(PG8_SB(1, 0), b3, voffB); PG8_STAGE(PG8_SB(1, 1), b3 + hstepB, voffB); PG8_STAGE(PG8_SA(1, 0), a3, voffA);
            PG8_WAIT_V(8); PG8_WAIT_L(0); PG8_BAR; PG8_MMA(1, 0, At, B0); PG8_MMA(1, 1, At, B1); PG8_BAR; PG8_SCHED;
            } else {
            PG8_LDB(B0, 0, 0); PG8_SCHED; PG8_LDA(At, 0, 0); PG8_STAGE(PG8_SA(1, 1), a1 + hstepA, voffA);
            PG8_WAIT_L(8); PG8_BAR; PG8_WAIT_L(0); PG8_MMA(0, 0, At, B0); PG8_BAR; PG8_SCHED;
            PG8_LDB(B1, 0, 1); PG8_STAGE(PG8_SB(0, 0), b2, voffB);
            PG8_BAR; PG8_WAIT_L(0); PG8_MMA(0, 1, At, B1); PG8_BAR;
            PG8_LDA(At, 0, 1); PG8_STAGE(PG8_SA(0, 0), a2, voffA);
            PG8_BAR; PG8_WAIT_L(0); PG8_MMA(1, 0, At, B0); PG8_BAR; PG8_SCHED;
            PG8_STAGE(PG8_SB(0, 1), b2 + hstepB, voffB);
            PG8_WAIT_V(6); PG8_BAR; PG8_MMA(1, 1, At, B1); PG8_BAR;
            PG8_LDB(B0, 1, 0); PG8_SCHED; PG8_LDA(At, 1, 0); PG8_STAGE(PG8_SA(0, 1), a2 + hstepA, voffA);
            PG8_WAIT_L(8); PG8_BAR; PG8_WAIT_L(0); PG8_MMA(0, 0, At, B0); PG8_BAR; PG8_SCHED;
            PG8_LDB(B1, 1, 1); PG8_STAGE(PG8_SB(1, 0), b3, voffB);
            PG8_BAR; PG8_WAIT_L(0); PG8_MMA(0, 1, At, B1); PG8_BAR;
            PG8_LDA(At, 1, 1); PG8_STAGE(PG8_SA(1, 0), a3, voffA);
            PG8_BAR; PG8_WAIT_L(0); PG8_MMA(1, 0, At, B0); PG8_BAR; PG8_SCHED;
            PG8_STAGE(PG8_SB(1, 1), b3 + hstepB, voffB);
            PG8_WAIT_V(6); PG8_BAR; PG8_MMA(1, 1, At, B1); PG8_BAR;
            }
        }
        if constexpr (ALIGN_EPI) { if (wr == 0) PG8_BAR; }
        if constexpr (!Epi::AFTER_DRAIN) { E(acc, cur, wr, wc, fr, fq); S.done(cur); }
        if (!has_next) break;
#pragma unroll
        for (int a = 0; a < 2; ++a)
#pragma unroll
            for (int b = 0; b < 2; ++b)
#pragma unroll
                for (int m = 0; m < 4; ++m)
#pragma unroll
                    for (int n = 0; n < 2; ++n) acc[a][b][m][n] = (f32x4){0.f, 0.f, 0.f, 0.f};
        cur = nxt; cA = nA; cB = nB; ++ui;
        if constexpr (ALIGN_EPI) { if (wr == 1) PG8_BAR; }
    }
    PG8_WAIT_V(0);
    if constexpr (!ALIGN_EPI) { if (wr == 0) PG8_BAR; }
    PG8_BAR;
    if constexpr (Epi::AFTER_DRAIN) { E.fused(acc, cur, wr, wc, fr, fq, lds, wid, lane); S.done(cur); }
#undef PG8_SA
#undef PG8_SB
#undef PG8_STAGE
#undef PG8_LDA
#undef PG8_LDB
#undef PG8_MMA
#undef PG8_WAIT_V
#undef PG8_WAIT_L
#undef PG8_BAR
#undef PG8_SCHED
}
}

#define LAS __attribute__((address_space(3)))
namespace att {
typedef short bf16x8 __attribute__((ext_vector_type(8)));
typedef float f32x16 __attribute__((ext_vector_type(16)));
typedef float f32x2_t __attribute__((ext_vector_type(2))); typedef __bf16 bf16x2_t __attribute__((ext_vector_type(2)));
__device__ __forceinline__ unsigned cvtpk(float lo, float hi) { f32x2_t v = {lo, hi}; bf16x2_t b = __builtin_convertvector(v, bf16x2_t); return __builtin_bit_cast(unsigned, b); }
constexpr int KP = 144;
constexpr float LOG2E = 1.4426950408889634f, CSC = 0.125f * LOG2E, THR = 6.0f;
__device__ __forceinline__ int crow(int r, int hi) { return (r & 3) + 8 * (r >> 2) + 4 * hi; }

template <int MODE>
__device__ __forceinline__ void attn_unit(LAS unsigned char* lds, int h, int qb, const bf16_t* __restrict__ QK, const bf16_t* __restrict__ VT, const unsigned* __restrict__ BMP,
                                          const float* __restrict__ BT, const float* __restrict__ subw, float lam, bf16_t* __restrict__ OAB) {
    constexpr int DV = MODE ? 128 : 64, QB = MODE ? 128 : 256, NDT = DV / 32, NKT = MODE ? 2 : 1;
    constexpr int KBYTES = 64 * KP, VBYTES = DV * KP, BUFB = NKT * KBYTES + VBYTES;
    constexpr int OFF_BIAS = 2 * BUFB;
    const int tid = threadIdx.x, lane = tid & 63, wave = __builtin_amdgcn_readfirstlane(tid >> 6), ql = lane & 31, hi = lane >> 5;
    const int qw = MODE ? (wave & 3) : wave, map = MODE ? (wave >> 2) : 0;
    const int q0 = qb * QB, qw0 = q0 + 32 * qw, t = qw0 + ql;
    const int qcol = MODE ? C_BQ + (2 * h + map) * 64 : C_AQ + h * 64;
    const int kcol0 = MODE ? C_BK + (2 * h) * 64 : C_AK + h * 64;
    const int vrow0 = MODE ? 512 + h * 128 : h * 64;
    const int hb = MODE ? 8 + h : h;
    LAS float* bias2 = (LAS float*)(lds + OFF_BIAS);
    if (tid < 128) bias2[tid] = BT[tid * 12 + hb] * LOG2E;
    bf16x8 qf[4];
#pragma unroll
    for (int ks = 0; ks < 4; ++ks) qf[ks] = *(const bf16x8*)(QK + (size_t)t * NTOK + qcol + 16 * ks + 8 * hi);
    const int pr = tid >> 3, pc = tid & 7;
    u32x4 sk[NKT], sv[NKT];
    const int NT = (q0 + QB) / 64;
    auto gload = [&](int kt) {
        const int k0 = kt * 64;
#pragma unroll
        for (int i = 0; i < NKT; ++i) {
            sk[i] = *(const u32x4*)(QK + (size_t)(k0 + pr) * NTOK + kcol0 + i * 64 + pc * 8);
            sv[i] = *(const u32x4*)(VT + (size_t)(vrow0 + pr + 64 * i) * L + k0 + pc * 8);
        }
    };
    auto lstore = [&](int buf) {
        LAS unsigned char* b = lds + buf * BUFB;
#pragma unroll
        for (int i = 0; i < NKT; ++i) {
            *(LAS u32x4*)(b + i * KBYTES + pr * KP + pc * 16) = sk[i];
            *(LAS u32x4*)(b + NKT * KBYTES + (pr + 64 * i) * KP + pc * 16) = sv[i];
        }
    };
    f32x16 O[NDT];
#pragma unroll
    for (int d = 0; d < NDT; ++d)
#pragma unroll
        for (int r = 0; r < 16; ++r) O[d][r] = 0.f;
    float m_run = -INFINITY, l_run = 0.f;
    const int kperm = (ql & 0x13) | ((ql & 4) << 1) | ((ql & 8) >> 1);
    gload(0); lstore(0);
    __syncthreads();
    const float b31 = bias2[127];
    u32x2 mw = {0u, 0u};
    if (MODE == 0) mw = *(const u32x2*)(BMP + (size_t)t * 512);
    for (int kt = 0; kt < NT; ++kt) {
        const int cur = kt & 1, k0 = kt * 64;
        const bool more = kt + 1 < NT;
        if (more) gload(kt + 1);
        u32x2 mwn = {0u, 0u};
        if (MODE == 0 && more) mwn = *(const u32x2*)(BMP + (size_t)t * 512 + 2 * (kt + 1));
        if (k0 <= qw0 + 31) {
            const LAS unsigned char* kb = lds + cur * BUFB + (MODE ? map * KBYTES : 0);
            const LAS unsigned char* vb = lds + cur * BUFB + NKT * KBYTES;
            f32x16 S[2];
#pragma unroll
            for (int j = 0; j < 2; ++j) {
#pragma unroll
                for (int r = 0; r < 16; ++r) S[j][r] = 0.f;
#pragma unroll
                for (int ks = 0; ks < 4; ++ks) {
                    const bf16x8 kf = *(const LAS bf16x8*)(kb + (32 * j + kperm) * KP + (16 * ks + 8 * hi) * 2);
                    S[j] = __builtin_amdgcn_mfma_f32_32x32x16_bf16(kf, qf[ks], S[j], 0, 0, 0);
                }
            }
            const bool nearb = (qw0 - (k0 + 63)) < 113;
            float mx = -INFINITY;
            if (nearb) {
#pragma unroll
                for (int j = 0; j < 2; ++j)
#pragma unroll
                    for (int r = 0; r < 16; ++r) {
                        const int key = k0 + 32 * j + 16 * (r >> 3) + 8 * hi + (r & 7); const int dist = t - key;
                        const float bb = bias2[dist < 0 ? 0 : (dist > 127 ? 127 : dist)];
                        const float e = dist < 0 ? -INFINITY : fmaf(S[j][r], CSC, bb);
                        S[j][r] = e; mx = fmaxf(mx, e);
                    }
            } else {
#pragma unroll
                for (int j = 0; j < 2; ++j)
#pragma unroll
                    for (int r = 0; r < 16; ++r) mx = fmaxf(mx, S[j][r]);
                mx = fmaf(mx, CSC, b31);
            }
            mx = fmaxf(mx, __shfl_xor(mx, 32));
            const bool need = mx > m_run + THR;
            if (__any(need)) {
                const float m_new = need ? mx : m_run;
                const float alpha = (m_new == m_run) ? 1.f : exp2f(m_run - m_new);
                l_run *= alpha;
#pragma unroll
                for (int d = 0; d < NDT; ++d)
#pragma unroll
                    for (int r = 0; r < 16; ++r) O[d][r] *= alpha;
                m_run = m_new;
            }
            if (nearb) {
#pragma unroll
                for (int j = 0; j < 2; ++j)
#pragma unroll
                    for (int r = 0; r < 16; ++r) S[j][r] = exp2f(S[j][r] - m_run);
            } else {
                const float nb = b31 - m_run;
#pragma unroll
                for (int j = 0; j < 2; ++j)
#pragma unroll
                    for (int r = 0; r < 16; ++r) S[j][r] = exp2f(fmaf(S[j][r], CSC, nb));
            }
            if (MODE == 0) {
#pragma unroll
                for (int j = 0; j < 2; ++j) { const unsigned w = (j ? mw.y : mw.x) >> (8 * hi);
#pragma unroll
                    for (int r = 0; r < 16; ++r) S[j][r] = (w & (1u << (16 * (r >> 3) + (r & 7)))) ? S[j][r] : 0.f; }
            }
            float ls = 0.f;
#pragma unroll
            for (int j = 0; j < 2; ++j)
#pragma unroll
                for (int r = 0; r < 16; ++r) ls += S[j][r];
            l_run += ls;
            bf16x8 pb[4];
#pragma unroll
            for (int s = 0; s < 4; ++s) { const int j = s >> 1, o = 8 * (s & 1); u32x4 w;
                w.x = cvtpk(S[j][o + 0], S[j][o + 1]); w.y = cvtpk(S[j][o + 2], S[j][o + 3]); w.z = cvtpk(S[j][o + 4], S[j][o + 5]); w.w = cvtpk(S[j][o + 6], S[j][o + 7]);
                pb[s] = __builtin_bit_cast(bf16x8, w); }
#pragma unroll
            for (int d = 0; d < NDT; ++d)
#pragma unroll
                for (int s = 0; s < 4; ++s) {
                    const bf16x8 vf = *(const LAS bf16x8*)(vb + (32 * d + ql) * KP + (16 * s + 8 * hi) * 2);
                    O[d] = __builtin_amdgcn_mfma_f32_32x32x16_bf16(vf, pb[s], O[d], 0, 0, 0);
                }
        }
        if (more) lstore(cur ^ 1);
        mw = mwn;
        __syncthreads();
    }
    const float l_tot = l_run + __shfl_xor(l_run, 32);
    const float inv = 1.f / l_tot;
    if (MODE == 0) {
#pragma unroll
        for (int d = 0; d < NDT; ++d)
#pragma unroll
            for (int g = 0; g < 4; ++g) { u32x2 w; w.x = cvtpk(O[d][4 * g] * inv, O[d][4 * g + 1] * inv); w.y = cvtpk(O[d][4 * g + 2] * inv, O[d][4 * g + 3] * inv);
                *(u32x2*)(OAB + (size_t)t * 1024 + h * 64 + 32 * d + 8 * g + 4 * hi) = w; }
    } else {
        LAS float* X = (LAS float*)lds;
        if (map == 1) {
#pragma unroll
            for (int d = 0; d < NDT; ++d)
#pragma unroll
                for (int r = 0; r < 16; ++r) X[(d * 16 + r) * 256 + qw * 64 + lane] = O[d][r] * inv;
        }
        __syncthreads();
        if (map == 0) {
            float ss = 0.f;
#pragma unroll
            for (int d = 0; d < NDT; ++d)
#pragma unroll
                for (int r = 0; r < 16; ++r) { const float v = O[d][r] * inv - lam * X[(d * 16 + r) * 256 + qw * 64 + lane]; O[d][r] = v; ss += v * v; }
            ss += __shfl_xor(ss, 32);
            const float rn = rsqrtf(ss * (1.f / 128.f) + 1e-5f) * (1.f - LAM_INIT);
#pragma unroll
            for (int d = 0; d < NDT; ++d)
#pragma unroll
                for (int g = 0; g < 4; ++g) { const int e0 = 32 * d + 8 * g + 4 * hi; const float4 sw = *(const float4*)(subw + e0);
                    u32x2 w; w.x = cvtpk(O[d][4 * g] * rn * sw.x, O[d][4 * g + 1] * rn * sw.y); w.y = cvtpk(O[d][4 * g + 2] * rn * sw.z, O[d][4 * g + 3] * rn * sw.w);
                    *(u32x2*)(OAB + (size_t)t * 1024 + 512 + h * 128 + e0) = w; }
        }
        __syncthreads();
    }
}
}

constexpr int NWAVES = 8, NTHREADS = 512;
constexpr int LDS_BYTES = 147456;
enum Phase { PH_PRO = 0, PH_G1 = 1, PH_IDX = 2, PH_ATB = 3, PH_ATA = 4, PH_T1 = 5, PH_T2 = 6, PH_T3 = 7, PH_T4 = 8, PH_T5 = 9, PH_N = 10 };

struct Args {
    const float* x; const float* p; const float* w_in; const float* w_pa; const float* w_pb; const float* w_o; const float* lqk; const float* subw;
    const float* ln_g; const float* ln_b; const float* w_ple; const float* w_gate; const float* rel_bias;
    float* out; unsigned char* ws; int ph_lo, ph_hi;
};

template <int MODE>
__device__ __forceinline__ void p0_transpose_item(const float* __restrict__ W, int K, int ld, int N, bf16_t* __restrict__ WT, LAS float* scr, int item, int lane) {
    const int nblk = N / 32, kb = item / nblk, nb = item % nblk, k0 = 64 * kb, n0 = 32 * nb;
    const int n = n0 + (lane & 31); const int c = MODE == 0 ? n : win_src_col(n);
#pragma unroll 8
    for (int i = 0; i < 32; ++i) { const int kk = 2 * i + (lane >> 5); scr[kk * 33 + (lane & 31)] = (c >= 0) ? W[(size_t)(k0 + kk) * ld + c] : 0.f; }
    asm volatile("s_waitcnt lgkmcnt(0)" ::: "memory");
    const int cc = lane & 7;
#pragma unroll
    for (int j = 0; j < 4; ++j) { const int nn = (lane >> 3) + 8 * j; const LAS float* s = scr + (8 * cc) * 33 + nn;
        u32x4 o; o.x = f2bf(s[0 * 33]) | ((unsigned)f2bf(s[1 * 33]) << 16); o.y = f2bf(s[2 * 33]) | ((unsigned)f2bf(s[3 * 33]) << 16);
        o.z = f2bf(s[4 * 33]) | ((unsigned)f2bf(s[5 * 33]) << 16); o.w = f2bf(s[6 * 33]) | ((unsigned)f2bf(s[7 * 33]) << 16);
        *(u32x4*)(WT + (size_t)(n0 + nn) * K + k0 + 8 * cc) = o; }
    asm volatile("s_waitcnt lgkmcnt(0)" ::: "memory");
}
__device__ __forceinline__ void cvt_rows(const float* __restrict__ src, bf16_t* __restrict__ dst, size_t n4, size_t gtid, size_t gthreads) {
    for (size_t i = gtid; i < n4; i += gthreads) { const float4 v = ((const float4*)src)[i]; u32x2 o; o.x = f2bf(v.x) | ((unsigned)f2bf(v.y) << 16); o.y = f2bf(v.z) | ((unsigned)f2bf(v.w) << 16); ((u32x2*)dst)[i] = o; }
}
__device__ __forceinline__ void ln_row(float* __restrict__ io, const float* __restrict__ g, const float* __restrict__ b, bf16_t* __restrict__ xln, int lane) {
    float4* r = (float4*)io + lane; float4 v[4]; float s = 0.f;
#pragma unroll
    for (int j = 0; j < 4; ++j) { v[j] = r[64 * j]; s += (v[j].x + v[j].y) + (v[j].z + v[j].w); }
#pragma unroll
    for (int o = 1; o < 64; o <<= 1) s += __shfl_xor(s, o);
    const float mean = s * (1.f / 1024.f); float q = 0.f;
#pragma unroll
    for (int j = 0; j < 4; ++j) { v[j].x -= mean; v[j].y -= mean; v[j].z -= mean; v[j].w -= mean; q += (v[j].x * v[j].x + v[j].y * v[j].y) + (v[j].z * v[j].z + v[j].w * v[j].w); }
#pragma unroll
    for (int o = 1; o < 64; o <<= 1) q += __shfl_xor(q, o);
    const float rstd = rsqrtf(q * (1.f / 1024.f) + 1e-5f);
#pragma unroll
    for (int j = 0; j < 4; ++j) {
        const float4 gg = ((const float4*)g)[lane + 64 * j], bb = ((const float4*)b)[lane + 64 * j];
        float4 o; o.x = v[j].x * rstd * gg.x + bb.x; o.y = v[j].y * rstd * gg.y + bb.y; o.z = v[j].z * rstd * gg.z + bb.z; o.w = v[j].w * rstd * gg.w + bb.w;
        r[64 * j] = o; u32x2 w; w.x = f2bf(o.x) | ((unsigned)f2bf(o.y) << 16); w.y = f2bf(o.z) | ((unsigned)f2bf(o.w) << 16);
        ((u32x2*)xln)[lane + 64 * j] = w;
    }
}

__global__ void __launch_bounds__(NTHREADS, 2) mega(Args a) {
    extern __shared__ __attribute__((aligned(16))) unsigned char lds_raw[];
    LAS unsigned char* lds = (LAS unsigned char*)lds_raw;
    const int tid = threadIdx.x, lane = tid & 63, wave = __builtin_amdgcn_readfirstlane(tid >> 6);
    const int G = gridDim.x, bx = blockIdx.x;
    unsigned char* ws = a.ws;
    bf16_t* WIN = (bf16_t*)(ws + WS_WIN); bf16_t* WPA = (bf16_t*)(ws + WS_WPA); bf16_t* WPB = (bf16_t*)(ws + WS_WPB); bf16_t* WO = (bf16_t*)(ws + WS_WO);
    bf16_t* WGT = (bf16_t*)(ws + WS_WGT); bf16_t* WPLE = (bf16_t*)(ws + WS_WPLE); bf16_t* XBF = (bf16_t*)(ws + WS_XBF); bf16_t* PBF = (bf16_t*)(ws + WS_PBF);
    bf16_t* QK = (bf16_t*)(ws + WS_QK); bf16_t* VT = (bf16_t*)(ws + WS_VT); bf16_t* OAB = (bf16_t*)(ws + WS_OAB);
    bf16_t* PLEO = (bf16_t*)(ws + WS_PLEO); bf16_t* Gb = (bf16_t*)(ws + WS_G); bf16_t* MRG = (bf16_t*)(ws + WS_MRG); bf16_t* XLN = (bf16_t*)(ws + WS_XLN);
    float* BT = (float*)(ws + WS_BT);
    const int lo = a.ph_lo, hi = a.ph_hi;
#define IN(k) (lo <= (k) && (k) < hi)

    if (IN(PH_PRO)) {
        LAS float* scr = (LAS float*)(lds + wave * 16384);
        const int gw = bx * NWAVES + wave, NGW = G * NWAVES;
        constexpr int I_IN = (WT_ROWS / 32) * (1024 / 64), I_PA = 32 * 8, I_O = 32 * 16, I_PLE = 32 * 4;
        constexpr int NITEMS = I_IN + 2 * I_PA + 2 * I_O + I_PLE;
        for (int it = gw; it < NITEMS; it += NGW) {
            int r = it;
            if (r < I_IN) { p0_transpose_item<1>(a.w_in, 1024, IN_COLS, WT_ROWS, WIN, scr, r, lane); continue; } r -= I_IN;
            if (r < I_PA) { p0_transpose_item<0>(a.w_pa, 512, 1024, 1024, WPA, scr, r, lane); continue; } r -= I_PA;
            if (r < I_PA) { p0_transpose_item<0>(a.w_pb, 512, 1024, 1024, WPB, scr, r, lane); continue; } r -= I_PA;
            if (r < I_O) { p0_transpose_item<0>(a.w_o, 1024, 1024, 1024, WO, scr, r, lane); continue; } r -= I_O;
            if (r < I_O) { p0_transpose_item<0>(a.w_gate, 1024, 1024, 1024, WGT, scr, r, lane); continue; } r -= I_O;
            p0_transpose_item<0>(a.w_ple, 256, 1024, 1024, WPLE, scr, r, lane);
        }
        const size_t gtid = (size_t)bx * NTHREADS + tid, gth = (size_t)G * NTHREADS;
        cvt_rows(a.x, XBF, (size_t)L * 1024 / 4, gtid, gth);
        cvt_rows(a.p, PBF, (size_t)L * 256 / 4, gtid, gth);
        if (gtid < 128 * 12) { const int n = (int)gtid / 12, h = (int)gtid % 12; BT[gtid] = a.rel_bias[rel_bucket(n) * 12 + h]; }
    }
    if (IN(PH_G1)) {
        { pg8::Gemm g{XBF, WIN + (size_t)WT_TOK * 1024, L, NTOK, 1024, 1024, 1024}; pg8::StaticOrder S; S.init(L, NTOK, G, bx);
          pg8::EpiStoreBf E{QK, NTOK, 0}; pg8::gemm_phase<pg8::EpiStoreBf, pg8::StaticOrder, true, true>(lds, g, S, E); }
        { pg8::Gemm g{WIN + (size_t)WT_VT * 1024, XBF, 1024, L, 1024, 1024, 1024}; pg8::StaticOrder S; S.init(1024, L, G, bx);
          pg8::EpiVTdual E{VT, (bf16_t*)a.out}; pg8::gemm_phase<pg8::EpiVTdual, pg8::StaticOrder, true, true>(lds, g, S, E); }
    }
    if (IN(PH_ATB) || IN(PH_ATA)) {
        const int vcu = (G % 8 == 0) ? (bx % 8) * (G / 8) + bx / 8 : bx;
        const unsigned* BMP = (const unsigned*)(ws + WS_BMP);
        if (IN(PH_ATB)) {
            float la = a.lqk[lane] * a.lqk[64 + lane], lb = a.lqk[128 + lane] * a.lqk[192 + lane];
#pragma unroll
            for (int o = 1; o < 64; o <<= 1) { la += __shfl_xor(la, o); lb += __shfl_xor(lb, o); }
            const float lam = __expf(la) - __expf(lb) + LAM_INIT;
            for (int p = vcu; p < 256; p += G) { const int h = p >> 6, xq = p & 63;
                att::attn_unit<1>(lds, h, 127 - xq, QK, VT, BMP, BT, a.subw, lam, OAB);
                att::attn_unit<1>(lds, h, xq, QK, VT, BMP, BT, a.subw, lam, OAB); }
        }
        if (IN(PH_ATA)) {
            for (int p = vcu; p < 256; p += G) { const int h = p >> 5, xq = p & 31;
                att::attn_unit<0>(lds, h, 63 - xq, QK, VT, BMP, BT, a.subw, 0.f, OAB);
                att::attn_unit<0>(lds, h, xq, QK, VT, BMP, BT, a.subw, 0.f, OAB); }
        }
    }
    if (IN(PH_T1)) {
        { pg8::Gemm g{XBF, WIN + (size_t)WT_Z * 1024, L, 1024, 1024, 1024, 1024}; pg8::StaticOrder S; S.init(L, 1024, G, bx);
          pg8::EpiZ E{OAB}; pg8::gemm_phase<pg8::EpiZ, pg8::StaticOrder, true, true>(lds, g, S, E); }
        { pg8::Gemm g{XBF, WIN + (size_t)WT_G * 1024, L, 2048, 1024, 1024, 1024}; pg8::StaticOrder S; S.init(L, 2048, G, bx);
          pg8::EpiG E{Gb}; pg8::gemm_phase<pg8::EpiG, pg8::StaticOrder, true, true>(lds, g, S, E); }
    }
    if (IN(PH_T2)) {
        { pg8::Gemm g{OAB, WPA, L, 1024, 512, 1024, 512}; pg8::StaticOrder S; S.init(L, 1024, G, bx);
          pg8::EpiPA E{Gb, MRG}; pg8::gemm_phase<pg8::EpiPA, pg8::StaticOrder, true, true>(lds, g, S, E); }
        { pg8::Gemm g{OAB + 512, WPB, L, 1024, 512, 1024, 512}; pg8::StaticOrder S; S.init(L, 1024, G, bx);
          pg8::EpiPB E{Gb, MRG}; pg8::gemm_phase<pg8::EpiPB, pg8::StaticOrder, true, true>(lds, g, S, E); }
        { pg8::Gemm g{PBF, WPLE, L, 1024, 256, 256, 256}; pg8::StaticOrder S; S.init(L, 1024, G, bx);
          pg8::EpiStoreBf E{PLEO, 1024, 0}; pg8::gemm_phase<pg8::EpiStoreBf, pg8::StaticOrder, true, true>(lds, g, S, E); }
    }
    if (IN(PH_T3)) {
        pg8::Gemm g{MRG, WO, L, 1024, 1024, 1024, 1024}; pg8::StaticOrder S; S.init(L, 1024, G, bx);
        pg8::EpiO E{a.x, a.out}; pg8::gemm_phase<pg8::EpiO, pg8::StaticOrder, true, true>(lds, g, S, E);
    }
    if (IN(PH_T4)) {
        const int gw = bx * NWAVES + wave, NGW = G * NWAVES;
        for (int m = gw; m < L; m += NGW) ln_row(a.out + (size_t)m * 1024, a.ln_g, a.ln_b, XLN + (size_t)m * 1024, lane);
    }
    if (IN(PH_T5)) {
        pg8::Gemm g{XLN, WGT, L, 1024, 1024, 1024, 1024}; pg8::StaticOrder S; S.init(L, 1024, G, bx);
        pg8::EpiGate E{a.out, PLEO}; pg8::gemm_phase<pg8::EpiGate, pg8::StaticOrder, true, true>(lds, g, S, E);
    }
#undef IN
}

extern "C" void kernel_launch(void* const* d_in, const int* in_sizes, int n_in, void* d_out, int out_size, void* d_ws, size_t ws_size, hipStream_t stream) {
    static int grid = 0;
    if (grid == 0) {
        if (ws_size < WS_END) { fprintf(stderr, "workspace too small: %zu\n", ws_size); grid = -1; return; }
        (void)hipFuncSetAttribute((const void*)mega, hipFuncAttributeMaxDynamicSharedMemorySize, LDS_BYTES);
        (void)hipFuncSetAttribute((const void*)naive_index, hipFuncAttributeMaxDynamicSharedMemorySize, 80 * 1024);
        int dev = 0, cus = 0; (void)hipGetDevice(&dev); (void)hipDeviceGetAttribute(&cus, hipDeviceAttributeMultiprocessorCount, dev);
        grid = cus > 0 ? cus : 256;
    }
    if (grid < 0) return;
    Args a{};
    a.x = (const float*)d_in[0]; a.p = (const float*)d_in[1]; a.w_in = (const float*)d_in[2]; a.w_pa = (const float*)d_in[3]; a.w_pb = (const float*)d_in[4]; a.w_o = (const float*)d_in[5];
    a.lqk = (const float*)d_in[6]; a.subw = (const float*)d_in[7]; a.ln_g = (const float*)d_in[8]; a.ln_b = (const float*)d_in[9];
    a.w_ple = (const float*)d_in[10]; a.w_gate = (const float*)d_in[11]; a.rel_bias = (const float*)d_in[12];
    a.out = (float*)d_out; a.ws = (unsigned char*)d_ws;
    unsigned char* ws = (unsigned char*)d_ws;
    bf16_t* QK = (bf16_t*)(ws + WS_QK); unsigned* BMP = (unsigned*)(ws + WS_BMP); bf16_t* OAB = (bf16_t*)(ws + WS_OAB); float* BT = (float*)(ws + WS_BT);
    bf16_t* VTOK = (bf16_t*)d_out; bf16_t* OB12 = (bf16_t*)((unsigned char*)d_out + 32 * MiB);
    auto run = [&](int lo, int hi) { a.ph_lo = lo; a.ph_hi = hi; hipLaunchKernelGGL(mega, dim3(grid), dim3(NTHREADS), LDS_BYTES, stream, a); };
    run(PH_PRO, PH_PRO + 1);
    run(PH_G1, PH_G1 + 1);
    naive_index<<<L, 256, (16384 + 512 + 8 + 4 + 256) * 4, stream>>>(QK, BMP);
    run(PH_ATB, PH_ATB + 1);
    run(PH_ATA, PH_ATA + 1);
    run(PH_T1, PH_T1 + 1);
    run(PH_T2, PH_T2 + 1);
    run(PH_T3, PH_T3 + 1);
    run(PH_T4, PH_T4 + 1);
    run(PH_T5, PH_T5 + 1);
}
```

```cpp
#include <hip/hip_runtime.h>
#include <cstdint>
#include <cstdio>

typedef unsigned short bf16_t;
typedef unsigned u32x4 __attribute__((ext_vector_type(4)));
typedef unsigned u32x2 __attribute__((ext_vector_type(2)));

constexpr int L = 16384, DM = 1024, PLE = 256;
constexpr int IN_COLS = 6728;
constexpr int NTOK = 2816;
constexpr int C_AQ = 0, C_AK = 512, C_BQ = 1024, C_BK = 1536, C_IQ = 2048, C_IK = 2560, C_IW = 2624;
constexpr int WT_TOK = 0, WT_VT = 2816, WT_Z = 3840, WT_G = 4864, WT_ROWS = 6912;
constexpr float ALPHA = 1.18920711500272f;
constexpr float LAM_INIT = 0.2f;

constexpr size_t MiB = 1u << 20;
constexpr size_t WS_CTL = 0;
constexpr size_t WS_BT = 512 * 1024;
constexpr size_t WS_WIN = 1 * MiB;
constexpr size_t WS_WPA = 15 * MiB;
constexpr size_t WS_WPB = 16 * MiB;
constexpr size_t WS_WO = 17 * MiB;
constexpr size_t WS_WGT = 19 * MiB;
constexpr size_t WS_WPLE = 21 * MiB;
constexpr size_t WS_XBF = 22 * MiB;
constexpr size_t WS_PBF = 54 * MiB;
constexpr size_t WS_QK = 62 * MiB;
constexpr size_t WS_VT = 154 * MiB;
constexpr size_t WS_BMP = 186 * MiB;
constexpr size_t WS_OAB = 218 * MiB;
constexpr size_t WS_END = 250 * MiB;
constexpr size_t WS_PLEO = WS_XBF, WS_G = WS_QK, WS_MRG = WS_VT, WS_XLN = WS_BMP;

__device__ __forceinline__ float bf2f(bf16_t v) { return __uint_as_float(((unsigned)v) << 16); }
__device__ __forceinline__ bf16_t f2bf(float f) { unsigned u = __float_as_uint(f); return (bf16_t)((u + 0x7fffu + ((u >> 16) & 1u)) >> 16); }
__device__ __forceinline__ float sigmoidf_(float v) { return 1.f / (1.f + __expf(-v)); }
__device__ __forceinline__ float siluf_(float v) { return v / (1.f + __expf(-v)); }

__host__ __device__ __forceinline__ int win_src_col(int n) {
    if (n < WT_VT) {
        if (n < 512) return n;
        if (n < 1024) return n;
        if (n < 1536) return 2632 + (n - 1024);
        if (n < 2048) return 3144 + (n - 1536);
        if (n < 2560) return 2048 + (n - 2048);
        if (n < 2624) return 2560 + (n - 2560);
        if (n < 2632) return 2624 + (n - 2624);
        return -1;
    }
    if (n < WT_Z) { int r = n - WT_VT; return r < 512 ? 1024 + r : 3656 + (r - 512); }
    if (n < WT_G) { int r = n - WT_Z; return r < 512 ? 1536 + r : 4168 + (r - 512); }
    return 4680 + (n - WT_G);
}

template <int MODE>
__global__ void __launch_bounds__(256) k_transpose(const float* __restrict__ src, bf16_t* __restrict__ dst, int K, int ld, int N, int pad_) {
    __shared__ float tile[32][33];
    const int n0 = blockIdx.x * 32, k0 = blockIdx.y * 32, tx = threadIdx.x & 31, ty = threadIdx.x >> 5;
    const int n = n0 + tx; const int c = MODE == 0 ? n : win_src_col(n);
#pragma unroll
    for (int i = 0; i < 4; ++i) { const int k = k0 + ty + 8 * i; tile[ty + 8 * i][tx] = (c >= 0) ? src[(size_t)k * ld + c] : 0.f; }
    __syncthreads();
#pragma unroll
    for (int i = 0; i < 4; ++i) { const int nn = n0 + ty + 8 * i; dst[(size_t)nn * K + k0 + tx] = f2bf(tile[tx][ty + 8 * i]); }
}
__global__ void __launch_bounds__(256) k_cvt(const float* __restrict__ src, bf16_t* __restrict__ dst, size_t n4) {
    for (size_t i = (size_t)blockIdx.x * 256 + threadIdx.x; i < n4; i += (size_t)gridDim.x * 256) {
        const float4 v = ((const float4*)src)[i]; u32x2 o; o.x = f2bf(v.x) | ((unsigned)f2bf(v.y) << 16); o.y = f2bf(v.z) | ((unsigned)f2bf(v.w) << 16); ((u32x2*)dst)[i] = o; }
}
__device__ __forceinline__ int rel_bucket(int n) {
    if (n < 16) return n;
    int b = 16 + (int)(logf((float)n / 16.f) / logf(8.f) * 16.f);
    return b > 31 ? 31 : b;
}
__global__ void k_bias_table(const float* __restrict__ rel_bias, float* __restrict__ bt) {
    const int i = threadIdx.x + blockIdx.x * blockDim.x;
    if (i < 128 * 12) { const int n = i / 12, h = i % 12; bt[i] = rel_bias[rel_bucket(n) * 12 + h]; }
}

template <class Epi>
__global__ void __launch_bounds__(256) naive_gemm(const bf16_t* __restrict__ A, const bf16_t* __restrict__ Bt, int lda, int ldb, int K, int pad_, Epi E) {
    __shared__ float As[16][68], Bs[16][68];
    const int tid = threadIdx.x, bm = blockIdx.y * 64, bn = blockIdx.x * 64, tx = tid & 15, ty = tid >> 4;
    const int lr = tid >> 2, lk = (tid & 3) * 4;
    float acc[4][4];
#pragma unroll
    for (int i = 0; i < 4; ++i)
#pragma unroll
        for (int j = 0; j < 4; ++j) acc[i][j] = 0.f;
    for (int k0 = 0; k0 < K; k0 += 16) {
        const u32x2 av = *(const u32x2*)(A + (size_t)(bm + lr) * lda + k0 + lk);
        const u32x2 bv = *(const u32x2*)(Bt + (size_t)(bn + lr) * ldb + k0 + lk);
        As[lk + 0][lr] = __uint_as_float(av.x << 16); As[lk + 1][lr] = __uint_as_float(av.x & 0xffff0000u);
        As[lk + 2][lr] = __uint_as_float(av.y << 16); As[lk + 3][lr] = __uint_as_float(av.y & 0xffff0000u);
        Bs[lk + 0][lr] = __uint_as_float(bv.x << 16); Bs[lk + 1][lr] = __uint_as_float(bv.x & 0xffff0000u);
        Bs[lk + 2][lr] = __uint_as_float(bv.y << 16); Bs[lk + 3][lr] = __uint_as_float(bv.y & 0xffff0000u);
        __syncthreads();
#pragma unroll
        for (int k = 0; k < 16; ++k) {
            const float4 a = *(const float4*)&As[k][ty * 4]; const float4 b = *(const float4*)&Bs[k][tx * 4];
            acc[0][0] += a.x * b.x; acc[0][1] += a.x * b.y; acc[0][2] += a.x * b.z; acc[0][3] += a.x * b.w;
            acc[1][0] += a.y * b.x; acc[1][1] += a.y * b.y; acc[1][2] += a.y * b.z; acc[1][3] += a.y * b.w;
            acc[2][0] += a.z * b.x; acc[2][1] += a.z * b.y; acc[2][2] += a.z * b.z; acc[2][3] += a.z * b.w;
            acc[3][0] += a.w * b.x; acc[3][1] += a.w * b.y; acc[3][2] += a.w * b.z; acc[3][3] += a.w * b.w;
        }
        __syncthreads();
    }
#pragma unroll
    for (int i = 0; i < 4; ++i)
#pragma unroll
        for (int j = 0; j < 4; ++j) E(bm + ty * 4 + i, bn + tx * 4 + j, acc[i][j]);
}
struct EpStore { bf16_t* O; int ld; int pad; __device__ void operator()(int m, int n, float v) const { O[(size_t)m * ld + n] = f2bf(v); } };
struct EpVT { bf16_t* VT; bf16_t* VTOK; __device__ void operator()(int m, int n, float v) const { const bf16_t b = f2bf(v); VT[(size_t)m * L + n] = b; VTOK[(size_t)n * 1024 + m] = b; } };
struct EpZ { bf16_t* OAB; __device__ void operator()(int m, int n, float v) const { const size_t i = (size_t)m * 1024 + n; OAB[i] = f2bf(siluf_(v) * bf2f(OAB[i])); } };
struct EpG { bf16_t* G; __device__ void operator()(int m, int n, float v) const { G[(size_t)m * 2048 + n] = f2bf(sigmoidf_(v)); } };
struct EpPA { const bf16_t* G; bf16_t* MRG; __device__ void operator()(int m, int n, float v) const { MRG[(size_t)m * 1024 + n] = f2bf(bf2f(G[(size_t)m * 2048 + n]) * v); } };
struct EpPB { const bf16_t* G; bf16_t* MRG; __device__ void operator()(int m, int n, float v) const { const size_t i = (size_t)m * 1024 + n; MRG[i] = f2bf(bf2f(MRG[i]) + bf2f(G[(size_t)m * 2048 + 1024 + n]) * v); } };
struct EpO { const float* x; float* PRE; __device__ void operator()(int m, int n, float v) const { const size_t i = (size_t)m * 1024 + n; PRE[i] = ALPHA * x[i] + v; } };
struct EpGate { float* out; const bf16_t* PLEO; __device__ void operator()(int m, int n, float v) const { const size_t i = (size_t)m * 1024 + n; out[i] = out[i] + sigmoidf_(v) * bf2f(PLEO[i]); } };

__global__ void __launch_bounds__(256) k_ln(float* __restrict__ io, const float* __restrict__ g, const float* __restrict__ b, bf16_t* __restrict__ xln) {
    const int wave = threadIdx.x >> 6, lane = threadIdx.x & 63; const int row = blockIdx.x * 4 + wave;
    float4* r = (float4*)(io + (size_t)row * 1024) + lane; float4 v[4]; float s = 0.f;
#pragma unroll
    for (int j = 0; j < 4; ++j) { v[j] = r[64 * j]; s += (v[j].x + v[j].y) + (v[j].z + v[j].w); }
#pragma unroll
    for (int o = 1; o < 64; o <<= 1) s += __shfl_xor(s, o);
    const float mean = s * (1.f / 1024.f); float q = 0.f;
#pragma unroll
    for (int j = 0; j < 4; ++j) { v[j].x -= mean; v[j].y -= mean; v[j].z -= mean; v[j].w -= mean; q += (v[j].x * v[j].x + v[j].y * v[j].y) + (v[j].z * v[j].z + v[j].w * v[j].w); }
#pragma unroll
    for (int o = 1; o < 64; o <<= 1) q += __shfl_xor(q, o);
    const float rstd = rsqrtf(q * (1.f / 1024.f) + 1e-5f);
#pragma unroll
    for (int j = 0; j < 4; ++j) {
        const float4 gg = ((const float4*)g)[lane + 64 * j], bb = ((const float4*)b)[lane + 64 * j];
        float4 o; o.x = v[j].x * rstd * gg.x + bb.x; o.y = v[j].y * rstd * gg.y + bb.y; o.z = v[j].z * rstd * gg.z + bb.z; o.w = v[j].w * rstd * gg.w + bb.w;
        r[64 * j] = o; u32x2 w; w.x = f2bf(o.x) | ((unsigned)f2bf(o.y) << 16); w.y = f2bf(o.z) | ((unsigned)f2bf(o.w) << 16);
        ((u32x2*)(xln + (size_t)row * 1024))[lane + 64 * j] = w;
    }
}

__device__ __forceinline__ unsigned fkey(float f) { const unsigned u = __float_as_uint(f); return (u & 0x80000000u) ? ~u : (u | 0x80000000u); }
__device__ __forceinline__ int block_sum_256(int v, volatile int* red) {
#pragma unroll
    for (int o = 1; o < 64; o <<= 1) v += __shfl_xor(v, o);
    __syncthreads();
    if ((threadIdx.x & 63) == 0) red[threadIdx.x >> 6] = v;
    __syncthreads();
    return red[0] + red[1] + red[2] + red[3];
}
__global__ void __launch_bounds__(256) naive_index(const bf16_t* __restrict__ QK, unsigned* __restrict__ bitmap) {
    extern __shared__ float smem[];
    float* sc = smem;
    float* qf = smem + 16384;
    float* wv = qf + 512;
    int* red = (int*)(wv + 8);
    int* scan = red + 4;
    const int tid = threadIdx.x, t = L - 1 - (int)blockIdx.x;
    const bf16_t* qrow = QK + (size_t)t * NTOK;
    for (int j = tid; j < 512; j += 256) qf[j] = bf2f(qrow[C_IQ + j]);
    if (tid < 8) wv[tid] = bf2f(qrow[C_IW + tid]) * 0.35355339059327373f;
    __syncthreads();
    for (int s = tid; s <= t; s += 256) {
        const u32x4* kr = (const u32x4*)(QK + (size_t)s * NTOK + C_IK);
        float acc[8];
#pragma unroll
        for (int h = 0; h < 8; ++h) acc[h] = 0.f;
#pragma unroll
        for (int c = 0; c < 8; ++c) {
            const u32x4 kv = kr[c];
            const float k0 = __uint_as_float(kv.x << 16), k1 = __uint_as_float(kv.x & 0xffff0000u), k2 = __uint_as_float(kv.y << 16), k3 = __uint_as_float(kv.y & 0xffff0000u);
            const float k4 = __uint_as_float(kv.z << 16), k5 = __uint_as_float(kv.z & 0xffff0000u), k6 = __uint_as_float(kv.w << 16), k7 = __uint_as_float(kv.w & 0xffff0000u);
#pragma unroll
            for (int h = 0; h < 8; ++h) {
                const float4 qa = *(const float4*)&qf[h * 64 + c * 8], qb = *(const float4*)&qf[h * 64 + c * 8 + 4];
                acc[h] += qa.x * k0 + qa.y * k1 + qa.z * k2 + qa.w * k3 + qb.x * k4 + qb.y * k5 + qb.z * k6 + qb.w * k7;
            }
        }
        float score = 0.f;
#pragma unroll
        for (int h = 0; h < 8; ++h) score += wv[h] * fmaxf(acc[h] * 0.125f, 0.f);
        sc[s] = score;
    }
    __syncthreads();
    const int n = t + 1;
    unsigned w0 = 0u, w1 = 0u;
    const int base = tid * 64;
    if (n <= 256) {
#pragma unroll 1
        for (int j = 0; j < 64; ++j) { const int s = base + j; if (s <= t) { if (j < 32) w0 |= 1u << j; else w1 |= 1u << (j - 32); } }
    } else {
        unsigned prefix = 0u;
        for (int bit = 31; bit >= 0; --bit) {
            const unsigned cand = prefix | (1u << bit); int c = 0;
            for (int s = tid; s <= t; s += 256) c += (fkey(sc[s]) >= cand) ? 1 : 0;
            if (block_sum_256(c, red) >= 256) prefix = cand;
        }
        int cgt = 0, ceq = 0;
        for (int j = 0; j < 64; ++j) { const int s = base + j; if (s <= t) { const unsigned k = fkey(sc[s]); cgt += k > prefix; ceq += k == prefix; } }
        const int tot_gt = block_sum_256(cgt, red);
        const int need = 256 - tot_gt;
        scan[tid] = ceq; __syncthreads();
        int before = 0; for (int j = 0; j < tid; ++j) before += scan[j];
        for (int j = 0; j < 64; ++j) { const int s = base + j; if (s <= t) { const unsigned k = fkey(sc[s]); bool sel = k > prefix;
                if (k == prefix) { sel = before < need; ++before; }
                if (sel) { if (j < 32) w0 |= 1u << j; else w1 |= 1u << (j - 32); } } }
    }
    bitmap[(size_t)t * 512 + tid * 2] = w0; bitmap[(size_t)t * 512 + tid * 2 + 1] = w1;
}

__global__ void __launch_bounds__(256) naive_attn_a(const bf16_t* __restrict__ QK, const bf16_t* __restrict__ VTOK, const unsigned* __restrict__ bitmap,
                                                    const float* __restrict__ bt, bf16_t* __restrict__ OAB) {
    __shared__ float qf[512]; __shared__ int sel[256]; __shared__ int scan[256]; __shared__ float lg[8][256]; __shared__ float linv[8];
    const int tid = threadIdx.x, t = L - 1 - (int)blockIdx.x;
    const unsigned w0 = bitmap[(size_t)t * 512 + tid * 2], w1 = bitmap[(size_t)t * 512 + tid * 2 + 1];
    scan[tid] = __popc(w0) + __popc(w1);
    for (int j = tid; j < 512; j += 256) qf[j] = bf2f(QK[(size_t)t * NTOK + C_AQ + j]);
    __syncthreads();
    int pos = 0; for (int j = 0; j < tid; ++j) pos += scan[j];
    int cnt = 0; for (int j = 0; j < 256; ++j) cnt += scan[j];
    for (int j = 0; j < 32; ++j) { if (w0 >> j & 1u) { if (pos < 256) sel[pos] = tid * 64 + j; ++pos; } }
    for (int j = 0; j < 32; ++j) { if (w1 >> j & 1u) { if (pos < 256) sel[pos] = tid * 64 + 32 + j; ++pos; } }
    if (cnt > 256) cnt = 256;
    __syncthreads();
    if (tid < cnt) {
        const int s = sel[tid]; const int dist = t - s; const int db = dist < 127 ? dist : 127;
        const bf16_t* kr = QK + (size_t)s * NTOK + C_AK;
#pragma unroll 1
        for (int h = 0; h < 8; ++h) { float a = 0.f;
            for (int d = 0; d < 64; ++d) a += qf[h * 64 + d] * bf2f(kr[h * 64 + d]);
            lg[h][tid] = a * 0.125f + bt[db * 12 + h]; }
    }
    __syncthreads();
    { const int wave = tid >> 6, lane = tid & 63;
      for (int hh = 0; hh < 2; ++hh) { const int h = wave * 2 + hh; float m = -INFINITY;
          for (int j = lane; j < cnt; j += 64) m = fmaxf(m, lg[h][j]);
          for (int o = 1; o < 64; o <<= 1) m = fmaxf(m, __shfl_xor(m, o));
          float s = 0.f;
          for (int j = lane; j < cnt; j += 64) { const float p = __expf(lg[h][j] - m); lg[h][j] = p; s += p; }
          for (int o = 1; o < 64; o <<= 1) s += __shfl_xor(s, o);
          if (lane == 0) linv[h] = 1.f / s; } }
    __syncthreads();
    for (int hd = tid; hd < 512; hd += 256) { const int h = hd >> 6; float o = 0.f;
        for (int j = 0; j < cnt; ++j) o += lg[h][j] * bf2f(VTOK[(size_t)sel[j] * 1024 + hd]);
        OAB[(size_t)t * 1024 + hd] = f2bf(o * linv[h]); }
}

__global__ void __launch_bounds__(64) naive_attn_b(const bf16_t* __restrict__ QK, const bf16_t* __restrict__ VTOK, const float* __restrict__ bt, bf16_t* __restrict__ OB12) {
    const int g = blockIdx.x & 7, qb = (L / 64 - 1) - (int)(blockIdx.x >> 3), lane = threadIdx.x, t = qb * 64 + lane, h = g >> 1;
    float q[64], o[128];
#pragma unroll
    for (int d = 0; d < 64; ++d) q[d] = bf2f(QK[(size_t)t * NTOK + C_BQ + g * 64 + d]) * 0.125f;
#pragma unroll
    for (int e = 0; e < 128; ++e) o[e] = 0.f;
    float m = -INFINITY, l = 0.f;
    const int smax = qb * 64 + 63;
    for (int s = 0; s <= smax; ++s) {
        const u32x4* kr = (const u32x4*)(QK + (size_t)s * NTOK + C_BK + g * 64);
        float dot = 0.f;
#pragma unroll
        for (int c = 0; c < 8; ++c) { const u32x4 kv = kr[c];
            dot += q[c * 8 + 0] * __uint_as_float(kv.x << 16) + q[c * 8 + 1] * __uint_as_float(kv.x & 0xffff0000u) + q[c * 8 + 2] * __uint_as_float(kv.y << 16) + q[c * 8 + 3] * __uint_as_float(kv.y & 0xffff0000u)
                 + q[c * 8 + 4] * __uint_as_float(kv.z << 16) + q[c * 8 + 5] * __uint_as_float(kv.z & 0xffff0000u) + q[c * 8 + 6] * __uint_as_float(kv.w << 16) + q[c * 8 + 7] * __uint_as_float(kv.w & 0xffff0000u); }
        const int dist = t - s;
        if (dist >= 0) {
            const float lgt = dot + bt[(dist < 127 ? dist : 127) * 12 + 8 + h];
            if (lgt > m) { const float corr = __expf(m - lgt); l *= corr;
#pragma unroll
                for (int e = 0; e < 128; ++e) o[e] *= corr;
                m = lgt; }
            const float p = __expf(lgt - m); l += p;
            const u32x4* vr = (const u32x4*)(VTOK + (size_t)s * 1024 + 512 + h * 128);
#pragma unroll
            for (int c = 0; c < 16; ++c) { const u32x4 vv = vr[c];
                o[c * 8 + 0] += p * __uint_as_float(vv.x << 16); o[c * 8 + 1] += p * __uint_as_float(vv.x & 0xffff0000u);
                o[c * 8 + 2] += p * __uint_as_float(vv.y << 16); o[c * 8 + 3] += p * __uint_as_float(vv.y & 0xffff0000u);
                o[c * 8 + 4] += p * __uint_as_float(vv.z << 16); o[c * 8 + 5] += p * __uint_as_float(vv.z & 0xffff0000u);
                o[c * 8 + 6] += p * __uint_as_float(vv.w << 16); o[c * 8 + 7] += p * __uint_as_float(vv.w & 0xffff0000u); }
        }
    }
    const float inv = 1.f / l;
    bf16_t* op = OB12 + ((size_t)t * 8 + g) * 128;
#pragma unroll
    for (int e = 0; e < 128; e += 2) *(unsigned*)(op + e) = f2bf(o[e] * inv) | ((unsigned)f2bf(o[e + 1] * inv) << 16);
}
__global__ void __launch_bounds__(256) naive_combine_b(const bf16_t* __restrict__ OB12, const float* __restrict__ lqk, const float* __restrict__ subw, bf16_t* __restrict__ OAB) {
    const int wave = threadIdx.x >> 6, lane = threadIdx.x & 63; const int t = blockIdx.x, h = wave;
    float a = lqk[lane] * lqk[64 + lane], b = lqk[128 + lane] * lqk[192 + lane];
#pragma unroll
    for (int o = 1; o < 64; o <<= 1) { a += __shfl_xor(a, o); b += __shfl_xor(b, o); }
    const float lam = __expf(a) - __expf(b) + LAM_INIT;
    const bf16_t* o1 = OB12 + ((size_t)t * 8 + 2 * h) * 128; const bf16_t* o2 = o1 + 128;
    const float v0 = bf2f(o1[lane]) - lam * bf2f(o2[lane]), v1 = bf2f(o1[64 + lane]) - lam * bf2f(o2[64 + lane]);
    float ss = v0 * v0 + v1 * v1;
#pragma unroll
    for (int o = 1; o < 64; o <<= 1) ss += __shfl_xor(ss, o);
    const float r = rsqrtf(ss * (1.f / 128.f) + 1e-5f) * (1.f - LAM_INIT);
    OAB[(size_t)t * 1024 + 512 + h * 128 + lane] = f2bf(v0 * r * subw[lane]);
    OAB[(size_t)t * 1024 + 512 + h * 128 + 64 + lane] = f2bf(v1 * r * subw[64 + lane]);
}

namespace pg8 {
#define PG8_LAS __attribute__((address_space(3)))
typedef unsigned short bf16_t;
typedef short bf16x8 __attribute__((ext_vector_type(8)));
typedef float f32x4 __attribute__((ext_vector_type(4)));
typedef unsigned u32x4 __attribute__((ext_vector_type(4)));
constexpr int BM = 256, BK = 64, HALF = 128, HTB = HALF * BK * 2  , STAGE_BYTES = 8 * HTB, NXCD = 8, WGM = 8;

__host__ __device__ __forceinline__ int lds_byte(int r, int c) { const int st = (r >> 4) * 2 + (c >> 5), rr = r & 15, cc = c & 31, ob = rr * 64 + cc * 2; return st * 1024 + (ob ^ (((ob >> 9) & 1) << 5)); }
__host__ __device__ __forceinline__ void stage_rc(int b, int& R, int& C) { const int st = b / 1024, sb = b % 1024, swz = sb ^ (((sb >> 9) & 1) << 5); R = (st >> 1) * 16 + swz / 64; C = (st & 1) * 32 + (swz % 64) / 2; }
__host__ __device__ __forceinline__ int perm32(int rho) { const int n = rho >> 4, i = rho & 15; return 8 * (i >> 2) + 4 * n + (i & 3); }

struct Unit { int pm, pn; };
struct Gemm { const bf16_t* A; const bf16_t* Bt; int M, N, K, lda, ldb; };

struct StaticOrder {
    int nM, nN, nwg, G, c;
    __host__ __device__ void init(int M, int N, int G_, int c_) { nM = M / BM; nN = N / BM; nwg = nM * nN; G = G_; c = c_; }
    __host__ __device__ bool next(int i, Unit& u) const {
        const long L = (long)i * G + c; if (L >= nwg) return false;
        int wgid = (int)L; { const int q = nwg / NXCD, r = nwg % NXCD, xcd = wgid % NXCD, off = wgid / NXCD; wgid = (xcd < r ? xcd * (q + 1) : r * (q + 1) + (xcd - r) * q) + off; }
        const int nig = WGM * nN, gid = wgid / nig, fm = gid * WGM, gsz = (nM - fm) < WGM ? (nM - fm) : WGM;
        u.pm = fm + ((wgid % nig) % gsz); u.pn = (wgid % nig) / gsz; return true;
    }
    __device__ __forceinline__ void a_ready(const Unit&) const {}
    __device__ __forceinline__ void done(const Unit&) const {}
};


typedef float f32x2_t __attribute__((ext_vector_type(2))); typedef __bf16 bf16x2_t __attribute__((ext_vector_type(2)));
__device__ __forceinline__ unsigned cvt_pk_bf16(float lo, float hi) { f32x2_t v = {lo, hi}; bf16x2_t b = __builtin_convertvector(v, bf16x2_t); return __builtin_bit_cast(unsigned, b); }
__device__ __forceinline__ u32x4 pack8(const f32x4 a, const f32x4 b) { u32x4 w; w.x = cvt_pk_bf16(a[0], a[1]); w.y = cvt_pk_bf16(a[2], a[3]); w.z = cvt_pk_bf16(b[0], b[1]); w.w = cvt_pk_bf16(b[2], b[3]); return w; }
__device__ __forceinline__ void unpack8(const u32x4 w, f32x4& a, f32x4& b) {
    a[0] = __uint_as_float(w.x << 16); a[1] = __uint_as_float(w.x & 0xffff0000u); a[2] = __uint_as_float(w.y << 16); a[3] = __uint_as_float(w.y & 0xffff0000u);
    b[0] = __uint_as_float(w.z << 16); b[1] = __uint_as_float(w.z & 0xffff0000u); b[2] = __uint_as_float(w.w << 16); b[3] = __uint_as_float(w.w & 0xffff0000u); }
__device__ __forceinline__ float fsig(float v) { return __builtin_amdgcn_rcpf(1.f + __expf(-v)); }
__device__ __forceinline__ f32x4 sig4(const f32x4 v) { f32x4 r; r[0] = fsig(v[0]); r[1] = fsig(v[1]); r[2] = fsig(v[2]); r[3] = fsig(v[3]); return r; }
#define PG8_EPI_LOOP(...) \
    _Pragma("unroll") for (int ai = 0; ai < 2; ++ai) _Pragma("unroll") for (int m = 0; m < 4; ++m) { const size_t row = (size_t)(u.pm * BM + ai * HALF + wr * 64 + m * 16 + fr); \
    _Pragma("unroll") for (int bj = 0; bj < 2; ++bj) { const int col = u.pn * BM + bj * HALF + wc * 32 + 8 * fq; f32x4 v0 = acc[ai][bj][m][0], v1 = acc[ai][bj][m][1]; __VA_ARGS__ } }
#define PG8_EPI_SIG const f32x4 (&acc)[2][2][4][2], const Unit& u, int wr, int wc, int fr, int fq
struct EpiStoreBf { static constexpr bool PERM = true, AFTER_DRAIN = false; bf16_t* O; int ldc, pad;
    __device__ __forceinline__ void operator()(PG8_EPI_SIG) const { PG8_EPI_LOOP( *(u32x4*)(O + row * ldc + col) = pack8(v0, v1); ) } };
struct EpiVTdual { static constexpr bool PERM = true, AFTER_DRAIN = false; bf16_t* VT; bf16_t* VTOK;
    __device__ __forceinline__ void operator()(PG8_EPI_SIG) const { PG8_EPI_LOOP( const u32x4 w = pack8(v0, v1); *(u32x4*)(VT + row * 16384 + col) = w;
        if (VTOK) { VTOK[(size_t)(col + 0) * 1024 + row] = (bf16_t)(w.x & 0xffff); VTOK[(size_t)(col + 1) * 1024 + row] = (bf16_t)(w.x >> 16); VTOK[(size_t)(col + 2) * 1024 + row] = (bf16_t)(w.y & 0xffff); VTOK[(size_t)(col + 3) * 1024 + row] = (bf16_t)(w.y >> 16);
                    VTOK[(size_t)(col + 4) * 1024 + row] = (bf16_t)(w.z & 0xffff); VTOK[(size_t)(col + 5) * 1024 + row] = (bf16_t)(w.z >> 16); VTOK[(size_t)(col + 6) * 1024 + row] = (bf16_t)(w.w & 0xffff); VTOK[(size_t)(col + 7) * 1024 + row] = (bf16_t)(w.w >> 16); } ) } };
struct EpiZ { static constexpr bool PERM = true, AFTER_DRAIN = false; bf16_t* OAB;
    __device__ __forceinline__ void operator()(PG8_EPI_SIG) const { PG8_EPI_LOOP( u32x4* p = (u32x4*)(OAB + row * 1024 + col); f32x4 o0, o1; unpack8(*p, o0, o1);
        *p = pack8(v0 * sig4(v0) * o0, v1 * sig4(v1) * o1); ) } };
struct EpiG { static constexpr bool PERM = true, AFTER_DRAIN = false; bf16_t* G;
    __device__ __forceinline__ void operator()(PG8_EPI_SIG) const { PG8_EPI_LOOP( *(u32x4*)(G + row * 2048 + col) = pack8(sig4(v0), sig4(v1)); ) } };
struct EpiPA { static constexpr bool PERM = true, AFTER_DRAIN = false; const bf16_t* G; bf16_t* MRG;
    __device__ __forceinline__ void operator()(PG8_EPI_SIG) const { PG8_EPI_LOOP( f32x4 g0, g1; unpack8(*(const u32x4*)(G + row * 2048 + col), g0, g1);
        *(u32x4*)(MRG + row * 1024 + col) = pack8(g0 * v0, g1 * v1); ) } };
struct EpiPB { static constexpr bool PERM = true, AFTER_DRAIN = false; const bf16_t* G; bf16_t* MRG;
    __device__ __forceinline__ void operator()(PG8_EPI_SIG) const { PG8_EPI_LOOP( f32x4 g0, g1, m0, m1; unpack8(*(const u32x4*)(G + row * 2048 + 1024 + col), g0, g1);
        u32x4* p = (u32x4*)(MRG + row * 1024 + col); unpack8(*p, m0, m1); *p = pack8(m0 + g0 * v0, m1 + g1 * v1); ) } };
struct EpiO { static constexpr bool PERM = true, AFTER_DRAIN = false; const float* x; float* PRE;
    __device__ __forceinline__ void operator()(PG8_EPI_SIG) const { PG8_EPI_LOOP( const f32x4 x0 = *(const f32x4*)(x + row * 1024 + col), x1 = *(const f32x4*)(x + row * 1024 + col + 4);
        *(f32x4*)(PRE + row * 1024 + col) = x0 * 1.18920711500272f + v0; *(f32x4*)(PRE + row * 1024 + col + 4) = x1 * 1.18920711500272f + v1; ) } };
struct EpiGate { static constexpr bool PERM = true, AFTER_DRAIN = false; float* out; const bf16_t* PLEO;
    __device__ __forceinline__ void operator()(PG8_EPI_SIG) const { PG8_EPI_LOOP( f32x4 p0, p1; unpack8(*(const u32x4*)(PLEO + row * 1024 + col), p0, p1);
        f32x4* o = (f32x4*)(out + row * 1024 + col); const f32x4 a0 = o[0], a1 = o[1]; o[0] = a0 + sig4(v0) * p0; o[1] = a1 + sig4(v1) * p1; ) } };

template <class Epi, class Sched, bool ALIGN_EPI = false, bool SP2 = false>
__device__ __forceinline__ void gemm_phase(PG8_LAS unsigned char* lds, const Gemm g, const Sched& S, const Epi& E) {
    const int tid = threadIdx.x, wid = __builtin_amdgcn_readfirstlane(tid >> 6), lane = tid & 63, wr = wid >> 2, wc = wid & 3, fr = lane & 15, fq = lane >> 4;
    const int K = g.K, nt = K / BK;
    unsigned voffA[2], voffB[2];
#pragma unroll
    for (int i = 0; i < 2; ++i) { int R, C; stage_rc(tid * 16 + i * 8192, R, C); const int Rb = Epi::PERM ? ((R & ~31) + perm32(R & 31)) : R;
        voffA[i] = (unsigned)(R * g.lda + C) * 2u; voffB[i] = (unsigned)(Rb * g.ldb + C) * 2u; }
    const size_t kstep = (size_t)(BK * 2);
    const size_t hstepA = (size_t)HALF * g.lda * 2, hstepB = (size_t)HALF * g.ldb * 2;
    const size_t tstepA = 2 * hstepA, tstepB = 2 * hstepB;
    const unsigned ldsw = (unsigned)wid * 1024u;
    const int aoff = lds_byte(wr * 64 + fr, fq * 8), boff = lds_byte(wc * 32 + fr, fq * 8);
#define PG8_SA(b, h) (((b) * 2 + (h)) * HTB)
#define PG8_SB(b, h) ((4 + (b) * 2 + (h)) * HTB)
#define PG8_STAGE(bufoff, gbase, voff) do { _Pragma("unroll") for (int _i = 0; _i < 2; ++_i) \
        __builtin_amdgcn_global_load_lds((const unsigned*)((const char*)(gbase) + (voff)[_i]), (PG8_LAS unsigned*)(lds + (bufoff) + ldsw + _i * 8192), 16, 0, 0); } while (0)
#define PG8_LDA(dst, b, h) do { _Pragma("unroll") for (int m = 0; m < 4; ++m) _Pragma("unroll") for (int k = 0; k < 2; ++k) dst[m][k] = *(const PG8_LAS bf16x8*)(lds + PG8_SA(b, h) + aoff + m * 2048 + k * 1024); } while (0)
#define PG8_LDB(dst, b, h) do { _Pragma("unroll") for (int n = 0; n < 2; ++n) _Pragma("unroll") for (int k = 0; k < 2; ++k) dst[n][k] = *(const PG8_LAS bf16x8*)(lds + PG8_SB(b, h) + boff + n * 2048 + k * 1024); } while (0)
#define PG8_MMA(ai, bj, At, Bt) do { __builtin_amdgcn_s_setprio(1); _Pragma("unroll") for (int m = 0; m < 4; ++m) _Pragma("unroll") for (int n = 0; n < 2; ++n) _Pragma("unroll") for (int k = 0; k < 2; ++k) \
        acc[ai][bj][m][n] = __builtin_amdgcn_mfma_f32_16x16x32_bf16(Bt[n][k], At[m][k], acc[ai][bj][m][n], 0, 0, 0); __builtin_amdgcn_s_setprio(0); } while (0)
#define PG8_WAIT_V(n) asm volatile("s_waitcnt vmcnt(" #n ")" ::: "memory")
#define PG8_WAIT_L(n) asm volatile("s_waitcnt lgkmcnt(" #n ")" ::: "memory")
#define PG8_BAR __builtin_amdgcn_s_barrier()
#define PG8_SCHED __builtin_amdgcn_sched_barrier(0)
    Unit cur, nxt; int ui = 0;
    if (!S.next(0, cur)) return;
    f32x4 acc[2][2][4][2];
#pragma unroll
    for (int a = 0; a < 2; ++a)
#pragma unroll
        for (int b = 0; b < 2; ++b)
#pragma unroll
            for (int m = 0; m < 4; ++m)
#pragma unroll
                for (int n = 0; n < 2; ++n) acc[a][b][m][n] = (f32x4){0.f, 0.f, 0.f, 0.f};
    bf16x8 At[4][2], B0[2][2], B1[2][2];
    const char* cA = (const char*)g.A + (size_t)cur.pm * tstepA; const char* cB = (const char*)g.Bt + (size_t)cur.pn * tstepB;
    S.a_ready(cur);
    if constexpr (SP2) {
        PG8_STAGE(PG8_SB(0, 0), cB, voffB); PG8_STAGE(PG8_SB(0, 1), cB + hstepB, voffB); PG8_STAGE(PG8_SA(0, 0), cA, voffA); PG8_STAGE(PG8_SA(0, 1), cA + hstepA, voffA);
        if (wr == 1) PG8_BAR;
        PG8_WAIT_V(2); PG8_BAR;
        PG8_STAGE(PG8_SB(1, 0), cB + kstep, voffB); PG8_STAGE(PG8_SA(1, 0), cA + kstep, voffA); PG8_STAGE(PG8_SB(1, 1), cB + hstepB + kstep, voffB);
        PG8_WAIT_V(6); PG8_BAR;
    } else {
        PG8_STAGE(PG8_SB(0, 0), cB, voffB); PG8_STAGE(PG8_SA(0, 0), cA, voffA); PG8_STAGE(PG8_SB(0, 1), cB + hstepB, voffB); PG8_STAGE(PG8_SA(0, 1), cA + hstepA, voffA);
        if (wr == 1) PG8_BAR;
        PG8_WAIT_V(4); PG8_BAR;
        PG8_STAGE(PG8_SB(1, 0), cB + kstep, voffB); PG8_STAGE(PG8_SA(1, 0), cA + kstep, voffA); PG8_STAGE(PG8_SB(1, 1), cB + hstepB + kstep, voffB);
        PG8_WAIT_V(6); PG8_BAR;
    }
    for (;;) {
        const bool has_next = S.next(ui + 1, nxt);
        const char* nA = has_next ? (const char*)g.A + (size_t)nxt.pm * tstepA : cA; const char* nB = has_next ? (const char*)g.Bt + (size_t)nxt.pn * tstepB : cB;
        for (int t = 0; t < nt; t += 2) {
            const bool last = (t == nt - 2);
            const char* a1 = cA + (size_t)(t + 1) * kstep;
            const char* a2 = last ? nA : cA + (size_t)(t + 2) * kstep; const char* b2 = last ? nB : cB + (size_t)(t + 2) * kstep;
            const char* a3 = a2 + kstep; const char* b3 = b2 + kstep;
            if (last && has_next) S.a_ready(nxt);
            if constexpr (SP2) {
            PG8_LDB(B0, 0, 0); PG8_LDB(B1, 0, 1); PG8_SCHED; PG8_LDA(At, 0, 0); PG8_STAGE(PG8_SA(1, 1), a1 + hstepA, voffA);
            PG8_WAIT_V(8); PG8_WAIT_L(0); PG8_BAR; PG8_MMA(0, 0, At, B0); PG8_MMA(0, 1, At, B1); PG8_BAR; PG8_SCHED;
            PG8_LDA(At, 0, 1); PG8_STAGE(PG8_SB(0, 0), b2, voffB); PG8_STAGE(PG8_SB(0, 1), b2 + hstepB, voffB); PG8_STAGE(PG8_SA(0, 0), a2, voffA);
            PG8_WAIT_V(8); PG8_WAIT_L(0); PG8_BAR; PG8_MMA(1, 0, At, B0); PG8_MMA(1, 1, At, B1); PG8_BAR; PG8_SCHED;
            PG8_LDB(B0, 1, 0); PG8_LDB(B1, 1, 1); PG8_SCHED; PG8_LDA(At, 1, 0); PG8_STAGE(PG8_SA(0, 1), a2 + hstepA, voffA);
            PG8_WAIT_V(8); PG8_WAIT_L(0); PG8_BAR; PG8_MMA(0, 0, At, B0); PG8_MMA(0, 1, At, B1); PG8_BAR; PG8_SCHED;
            PG8_LDA(At, 1, 1); PG8_STAGE(PG8_SB(1, 0), b3, voffB); PG8_STAGE(PG8_SB(1, 1), b3 + hstepB, voffB); PG8_STAGE(PG8_SA(1, 0), a3, voffA);
            PG8_WAIT_V(8); PG8_WAIT_L(0); PG8_BAR; PG8_MMA(1, 0, At, B0); PG8_MMA(1, 1, At, B1); PG8_BAR; PG8_SCHED;
            } else {
            PG8_LDB(B0, 0, 0); PG8_SCHED; PG8_LDA(At, 0, 0); PG8_STAGE(PG8_SA(1, 1), a1 + hstepA, voffA);
            PG8_WAIT_L(8); PG8_BAR; PG8_WAIT_L(0); PG8_MMA(0, 0, At, B0); PG8_BAR; PG8_SCHED;
            PG8_LDB(B1, 0, 1); PG8_STAGE(PG8_SB(0, 0), b2, voffB);
            PG8_BAR; PG8_WAIT_L(0); PG8_MMA(0, 1, At, B1); PG8_BAR;
            PG8_LDA(At, 0, 1); PG8_STAGE(PG8_SA(0, 0), a2, voffA);
            PG8_BAR; PG8_WAIT_L(0); PG8_MMA(1, 0, At, B0); PG8_BAR; PG8_SCHED;
            PG8_STAGE(PG8_SB(0, 1), b2 + hstepB, voffB);
            PG8_WAIT_V(6); PG8_BAR; PG8_MMA(1, 1, At, B1); PG8_BAR;
            PG8_LDB(B0, 1, 0); PG8_SCHED; PG8_LDA(At, 1, 0); PG8_STAGE(PG8_SA(0, 1), a2 + hstepA, voffA);
            PG8_WAIT_L(8); PG8_BAR; PG8_WAIT_L(0); PG8_MMA(0, 0, At, B0); PG8_BAR; PG8_SCHED;
            PG8_LDB(B1, 1, 1); PG8_STAGE(PG8_SB(1, 0), b3, voffB);
            PG8_BAR; PG8_WAIT_L(0); PG8_MMA(0, 1, At, B1); PG8_BAR;
            PG8_LDA(At, 1, 1); PG8_STAGE(PG8_SA(1, 0), a3, voffA);
            PG8_BAR; PG8_WAIT_L(0); PG8_MMA(1, 0, At, B0); PG8_BAR; PG8_SCHED;
            PG8_STAGE(PG8_SB(1, 1), b3 + hstepB, voffB);
            PG8_WAIT_V(6); PG8_BAR; PG8_MMA(1, 1, At, B1); PG8_BAR;
            }
        }
        if constexpr (ALIGN_EPI) { if (wr == 0) PG8_BAR; }
        if constexpr (!Epi::AFTER_DRAIN) { E(acc, cur, wr, wc, fr, fq); S.done(cur); }
        if (!has_next) break;
#pragma unroll
        for (int a = 0; a < 2; ++a)
#pragma unroll
            for (int b = 0; b < 2; ++b)
#pragma unroll
                for (int m = 0; m < 4; ++m)
#pragma unroll
                    for (int n = 0; n < 2; ++n) acc[a][b][m][n] = (f32x4){0.f, 0.f, 0.f, 0.f};
        cur = nxt; cA = nA; cB = nB; ++ui;
        if constexpr (ALIGN_EPI) { if (wr == 1) PG8_BAR; }
    }
    PG8_WAIT_V(0);
    if constexpr (!ALIGN_EPI) { if (wr == 0) PG8_BAR; }
    PG8_BAR;
    if constexpr (Epi::AFTER_DRAIN) { E.fused(acc, cur, wr, wc, fr, fq, lds, wid, lane); S.done(cur); }
#undef PG8_SA
#undef PG8_SB
#undef PG8_STAGE
#undef PG8_LDA
#undef PG8_LDB
#undef PG8_MMA
#undef PG8_WAIT_V
#undef PG8_WAIT_L
#undef PG8_BAR
#undef PG8_SCHED
}
}

#define LAS __attribute__((address_space(3)))
namespace att {
typedef short bf16x8 __attribute__((ext_vector_type(8)));
typedef float f32x16 __attribute__((ext_vector_type(16)));
typedef float f32x2_t __attribute__((ext_vector_type(2))); typedef __bf16 bf16x2_t __attribute__((ext_vector_type(2)));
__device__ __forceinline__ unsigned cvtpk(float lo, float hi) { f32x2_t v = {lo, hi}; bf16x2_t b = __builtin_convertvector(v, bf16x2_t); return __builtin_bit_cast(unsigned, b); }
constexpr int KP = 144;
constexpr float LOG2E = 1.4426950408889634f, CSC = 0.125f * LOG2E, THR = 6.0f;
__device__ __forceinline__ int crow(int r, int hi) { return (r & 3) + 8 * (r >> 2) + 4 * hi; }

template <int MODE>
__device__ __forceinline__ void attn_unit(LAS unsigned char* lds, int h, int qb, const bf16_t* __restrict__ QK, const bf16_t* __restrict__ VT, const unsigned* __restrict__ BMP,
                                          const float* __restrict__ BT, const float* __restrict__ subw, float lam, bf16_t* __restrict__ OAB) {
    constexpr int DV = MODE ? 128 : 64, QB = MODE ? 128 : 256, NDT = DV / 32, NKT = MODE ? 2 : 1;
    constexpr int KBYTES = 64 * KP, VBYTES = DV * KP, BUFB = NKT * KBYTES + VBYTES;
    constexpr int OFF_BIAS = 2 * BUFB;
    const int tid = threadIdx.x, lane = tid & 63, wave = __builtin_amdgcn_readfirstlane(tid >> 6), ql = lane & 31, hi = lane >> 5;
    const int qw = MODE ? (wave & 3) : wave, map = MODE ? (wave >> 2) : 0;
    const int q0 = qb * QB, qw0 = q0 + 32 * qw, t = qw0 + ql;
    const int qcol = MODE ? C_BQ + (2 * h + map) * 64 : C_AQ + h * 64;
    const int kcol0 = MODE ? C_BK + (2 * h) * 64 : C_AK + h * 64;
    const int vrow0 = MODE ? 512 + h * 128 : h * 64;
    const int hb = MODE ? 8 + h : h;
    LAS float* bias2 = (LAS float*)(lds + OFF_BIAS);
    if (tid < 128) bias2[tid] = BT[tid * 12 + hb] * LOG2E;
    bf16x8 qf[4];
#pragma unroll
    for (int ks = 0; ks < 4; ++ks) qf[ks] = *(const bf16x8*)(QK + (size_t)t * NTOK + qcol + 16 * ks + 8 * hi);
    const int pr = tid >> 3, pc = tid & 7;
    u32x4 sk[NKT], sv[NKT];
    const int NT = (q0 + QB) / 64;
    auto gload = [&](int kt) {
        const int k0 = kt * 64;
#pragma unroll
        for (int i = 0; i < NKT; ++i) {
            sk[i] = *(const u32x4*)(QK + (size_t)(k0 + pr) * NTOK + kcol0 + i * 64 + pc * 8);
            sv[i] = *(const u32x4*)(VT + (size_t)(vrow0 + pr + 64 * i) * L + k0 + pc * 8);
        }
    };
    auto lstore = [&](int buf) {
        LAS unsigned char* b = lds + buf * BUFB;
#pragma unroll
        for (int i = 0; i < NKT; ++i) {
            *(LAS u32x4*)(b + i * KBYTES + pr * KP + pc * 16) = sk[i];
            *(LAS u32x4*)(b + NKT * KBYTES + (pr + 64 * i) * KP + pc * 16) = sv[i];
        }
    };
    f32x16 O[NDT];
#pragma unroll
    for (int d = 0; d < NDT; ++d)
#pragma unroll
        for (int r = 0; r < 16; ++r) O[d][r] = 0.f;
    float m_run = -INFINITY, l_run = 0.f;
    const int kperm = (ql & 0x13) | ((ql & 4) << 1) | ((ql & 8) >> 1);
    gload(0); lstore(0);
    __syncthreads();
    const float b31 = bias2[127];
    u32x2 mw = {0u, 0u};
    if (MODE == 0) mw = *(const u32x2*)(BMP + (size_t)t * 512);
    for (int kt = 0; kt < NT; ++kt) {
        const int cur = kt & 1, k0 = kt * 64;
        const bool more = kt + 1 < NT;
        if (more) gload(kt + 1);
        u32x2 mwn = {0u, 0u};
        if (MODE == 0 && more) mwn = *(const u32x2*)(BMP + (size_t)t * 512 + 2 * (kt + 1));
        if (k0 <= qw0 + 31) {
            const LAS unsigned char* kb = lds + cur * BUFB + (MODE ? map * KBYTES : 0);
            const LAS unsigned char* vb = lds + cur * BUFB + NKT * KBYTES;
            f32x16 S[2];
#pragma unroll
            for (int j = 0; j < 2; ++j) {
#pragma unroll
                for (int r = 0; r < 16; ++r) S[j][r] = 0.f;
#pragma unroll
                for (int ks = 0; ks < 4; ++ks) {
                    const bf16x8 kf = *(const LAS bf16x8*)(kb + (32 * j + kperm) * KP + (16 * ks + 8 * hi) * 2);
                    S[j] = __builtin_amdgcn_mfma_f32_32x32x16_bf16(kf, qf[ks], S[j], 0, 0, 0);
                }
            }
            const bool nearb = (qw0 - (k0 + 63)) < 113;
            float mx = -INFINITY;
            if (nearb) {
#pragma unroll
                for (int j = 0; j < 2; ++j)
#pragma unroll
                    for (int r = 0; r < 16; ++r) {
                        const int key = k0 + 32 * j + 16 * (r >> 3) + 8 * hi + (r & 7); const int dist = t - key;
                        const float bb = bias2[dist < 0 ? 0 : (dist > 127 ? 127 : dist)];
                        const float e = dist < 0 ? -INFINITY : fmaf(S[j][r], CSC, bb);
                        S[j][r] = e; mx = fmaxf(mx, e);
                    }
            } else {
#pragma unroll
                for (int j = 0; j < 2; ++j)
#pragma unroll
                    for (int r = 0; r < 16; ++r) mx = fmaxf(mx, S[j][r]);
                mx = fmaf(mx, CSC, b31);
            }
            mx = fmaxf(mx, __shfl_xor(mx, 32));
            const bool need = mx > m_run + THR;
            if (__any(need)) {
                const float m_new = need ? mx : m_run;
                const float alpha = (m_new == m_run) ? 1.f : exp2f(m_run - m_new);
                l_run *= alpha;
#pragma unroll
                for (int d = 0; d < NDT; ++d)
#pragma unroll
                    for (int r = 0; r < 16; ++r) O[d][r] *= alpha;
                m_run = m_new;
            }
            if (nearb) {
#pragma unroll
                for (int j = 0; j < 2; ++j)
#pragma unroll
                    for (int r = 0; r < 16; ++r) S[j][r] = exp2f(S[j][r] - m_run);
            } else {
                const float nb = b31 - m_run;
#pragma unroll
                for (int j = 0; j < 2; ++j)
#pragma unroll
                    for (int r = 0; r < 16; ++r) S[j][r] = exp2f(fmaf(S[j][r], CSC, nb));
            }
            if (MODE == 0) {
#pragma unroll
                for (int j = 0; j < 2; ++j) { const unsigned w = (j ? mw.y : mw.x) >> (8 * hi);
#pragma unroll
                    for (int r = 0; r < 16; ++r) S[j][r] = (w & (1u << (16 * (r >> 3) + (r & 7)))) ? S[j][r] : 0.f; }
            }
            float ls = 0.f;
#pragma unroll
            for (int j = 0; j < 2; ++j)
#pragma unroll
                for (int r = 0; r < 16; ++r) ls += S[j][r];
            l_run += ls;
            bf16x8 pb[4];
#pragma unroll
            for (int s = 0; s < 4; ++s) { const int j = s >> 1, o = 8 * (s & 1); u32x4 w;
                w.x = cvtpk(S[j][o + 0], S[j][o + 1]); w.y = cvtpk(S[j][o + 2], S[j][o + 3]); w.z = cvtpk(S[j][o + 4], S[j][o + 5]); w.w = cvtpk(S[j][o + 6], S[j][o + 7]);
                pb[s] = __builtin_bit_cast(bf16x8, w); }
#pragma unroll
            for (int d = 0; d < NDT; ++d)
#pragma unroll
                for (int s = 0; s < 4; ++s) {
                    const bf16x8 vf = *(const LAS bf16x8*)(vb + (32 * d + ql) * KP + (16 * s + 8 * hi) * 2);
                    O[d] = __builtin_amdgcn_mfma_f32_32x32x16_bf16(vf, pb[s], O[d], 0, 0, 0);
                }
        }
        if (more) lstore(cur ^ 1);
        mw = mwn;
        __syncthreads();
    }
    const float l_tot = l_run + __shfl_xor(l_run, 32);
    const float inv = 1.f / l_tot;
    if (MODE == 0) {
#pragma unroll
        for (int d = 0; d < NDT; ++d)
#pragma unroll
            for (int g = 0; g < 4; ++g) { u32x2 w; w.x = cvtpk(O[d][4 * g] * inv, O[d][4 * g + 1] * inv); w.y = cvtpk(O[d][4 * g + 2] * inv, O[d][4 * g + 3] * inv);
                *(u32x2*)(OAB + (size_t)t * 1024 + h * 64 + 32 * d + 8 * g + 4 * hi) = w; }
    } else {
        LAS float* X = (LAS float*)lds;
        if (map == 1) {
#pragma unroll
            for (int d = 0; d < NDT; ++d)
#pragma unroll
                for (int r = 0; r < 16; ++r) X[(d * 16 + r) * 256 + qw * 64 + lane] = O[d][r] * inv;
        }
        __syncthreads();
        if (map == 0) {
            float ss = 0.f;
#pragma unroll
            for (int d = 0; d < NDT; ++d)
#pragma unroll
                for (int r = 0; r < 16; ++r) { const float v = O[d][r] * inv - lam * X[(d * 16 + r) * 256 + qw * 64 + lane]; O[d][r] = v; ss += v * v; }
            ss += __shfl_xor(ss, 32);
            const float rn = rsqrtf(ss * (1.f / 128.f) + 1e-5f) * (1.f - LAM_INIT);
#pragma unroll
            for (int d = 0; d < NDT; ++d)
#pragma unroll
                for (int g = 0; g < 4; ++g) { const int e0 = 32 * d + 8 * g + 4 * hi; const float4 sw = *(const float4*)(subw + e0);
                    u32x2 w; w.x = cvtpk(O[d][4 * g] * rn * sw.x, O[d][4 * g + 1] * rn * sw.y); w.y = cvtpk(O[d][4 * g + 2] * rn * sw.z, O[d][4 * g + 3] * rn * sw.w);
                    *(u32x2*)(OAB + (size_t)t * 1024 + 512 + h * 128 + e0) = w; }
        }
        __syncthreads();
    }
}
}

namespace idx {
typedef short bf16x8 __attribute__((ext_vector_type(8)));
typedef float f32x4 __attribute__((ext_vector_type(4)));
constexpr int NQ = 16, CAP = 1200, TRIG = CAP - 256, NSL = 19;
constexpr int OFF_CNT = NQ * CAP * 8, OFF_TAU = OFF_CNT + 128, OFF_DUMP = OFF_TAU + 128, IDX_LDS = OFF_DUMP + 8 * 512;
__device__ __forceinline__ unsigned fkey(float f) { const unsigned u = __float_as_uint(f); return (u & 0x80000000u) ? ~u : (u | 0x80000000u); }
__device__ __forceinline__ float keyf(unsigned k) { return __uint_as_float((k & 0x80000000u) ? (k & 0x7fffffffu) : ~k); }
__device__ __forceinline__ int wave_count_ge(const unsigned (&kv)[NSL], unsigned cand) {
    int tot = 0;
#pragma unroll
    for (int i = 0; i < NSL; ++i) tot += __popcll(__ballot(kv[i] >= cand));
    return tot;
}
template <int NB> __device__ __forceinline__ unsigned kth_prefix(const unsigned (&kv)[NSL]) {
    unsigned prefix = 0u;
#pragma unroll 1
    for (int b = 31; b >= 32 - NB; --b) { const unsigned cand = prefix | (1u << b); if (wave_count_ge(kv, cand) >= 256) prefix = cand; }
    return prefix;
}
__device__ __forceinline__ void load_pool(const LAS u32x2* pool, int c, int lane, unsigned (&kv)[NSL], unsigned (&sb)[NSL], unsigned (&kk)[NSL]) {
#pragma unroll
    for (int i = 0; i < NSL; ++i) { const int s = lane + 64 * i; u32x2 e = {0u, 0u}; if (s < c) e = pool[s]; sb[i] = e.x; kk[i] = e.y; kv[i] = (s < c) ? fkey(__uint_as_float(e.x)) : 0u; }
}
__device__ __forceinline__ void prune(LAS unsigned char* lds, int q, int lane) {
    LAS u32x2* pool = (LAS u32x2*)(lds + q * CAP * 8); LAS unsigned* cnt = (LAS unsigned*)(lds + OFF_CNT); LAS float* tau = (LAS float*)(lds + OFF_TAU);
    int c = (int)cnt[q]; c = c > CAP ? CAP : c;
    unsigned kv[NSL], sb[NSL], kk[NSL];
    load_pool(pool, c, lane, kv, sb, kk);
    const unsigned prefix = kth_prefix<17>(kv);
    int base = 0;
#pragma unroll
    for (int i = 0; i < NSL; ++i) { const bool keep = kv[i] >= prefix && prefix != 0u; const unsigned long long m = __ballot(keep);
        const int pos = base + __builtin_amdgcn_mbcnt_hi((unsigned)(m >> 32), __builtin_amdgcn_mbcnt_lo((unsigned)m, 0u));
        if (keep) pool[pos] = (u32x2){sb[i], kk[i]};
        base += __popcll(m); }
    if (lane == 0) { cnt[q] = (unsigned)base; tau[q] = keyf(prefix); }
}
__device__ __forceinline__ void finalize(LAS unsigned char* lds, int q, int lane, unsigned* __restrict__ bmp_row) {
    LAS u32x2* pool = (LAS u32x2*)(lds + q * CAP * 8); LAS unsigned* cnt = (LAS unsigned*)(lds + OFF_CNT);
    int c = (int)cnt[q]; c = c > CAP ? CAP : c;
    unsigned kv[NSL], sb[NSL], kk[NSL];
    load_pool(pool, c, lane, kv, sb, kk);
    unsigned prefix = 0u; int need = 1 << 20;
    if (c > 256) { prefix = kth_prefix<32>(kv); int gt = 0;
#pragma unroll
        for (int i = 0; i < NSL; ++i) gt += __popcll(__ballot(kv[i] > prefix));
        need = 256 - gt; }
    LAS unsigned* row = (LAS unsigned*)pool;
    *(LAS u32x4*)(row + 8 * lane) = (u32x4){0u, 0u, 0u, 0u}; *(LAS u32x4*)(row + 8 * lane + 4) = (u32x4){0u, 0u, 0u, 0u};
    int base = 0;
#pragma unroll
    for (int i = 0; i < NSL; ++i) { const bool valid = (lane + 64 * i) < c; bool sel = valid && kv[i] > prefix; const bool tie = valid && kv[i] == prefix;
        const unsigned long long m = __ballot(tie);
        const int rank = base + __builtin_amdgcn_mbcnt_hi((unsigned)(m >> 32), __builtin_amdgcn_mbcnt_lo((unsigned)m, 0u));
        if (tie && rank < need) sel = true;
        base += __popcll(m);
        if (sel) __hip_atomic_fetch_or(row + (kk[i] >> 5), 1u << (kk[i] & 31), __ATOMIC_RELAXED, __HIP_MEMORY_SCOPE_WORKGROUP); }
    const u32x4 w0 = *(LAS u32x4*)(row + 8 * lane), w1 = *(LAS u32x4*)(row + 8 * lane + 4);
    *(u32x4*)(bmp_row + 8 * lane) = w0; *(u32x4*)(bmp_row + 8 * lane + 4) = w1;
}

__device__ __forceinline__ void index_unit(LAS unsigned char* lds, int qblk, const bf16_t* __restrict__ QK, unsigned* __restrict__ BMP) {
    const int tid = threadIdx.x, lane = tid & 63, wave = __builtin_amdgcn_readfirstlane(tid >> 6), qc = lane & 15, g = lane >> 4;
    const int t = qblk * NQ + qc, NTL = (qblk + 2) >> 1;
    LAS unsigned* cnt = (LAS unsigned*)(lds + OFF_CNT); LAS float* tau = (LAS float*)(lds + OFF_TAU);
    if (tid < NQ) { cnt[tid] = 0u; tau[tid] = -INFINITY; }
    bf16x8 qf[8][2]; float wq[8];
#pragma unroll
    for (int h = 0; h < 8; ++h) {
        wq[h] = bf2f(QK[(size_t)t * NTOK + C_IW + h]) * (0.35355339059327373f * 0.125f);
#pragma unroll
        for (int ks = 0; ks < 2; ++ks) qf[h][ks] = *(const bf16x8*)(QK + (size_t)t * NTOK + C_IQ + h * 64 + 32 * ks + 8 * g);
    }
    const unsigned dump_a = (unsigned)(size_t)(lds + OFF_DUMP + wave * 512 + lane * 8), pool_a = (unsigned)(size_t)(lds + qc * CAP * 8);
    __syncthreads();
    const int nrounds = (NTL + 7) >> 3;
    bf16x8 kf[2][2];
    { const int kt0 = wave < NTL ? wave : 0;
#pragma unroll
      for (int i = 0; i < 2; ++i)
#pragma unroll
          for (int ks = 0; ks < 2; ++ks) kf[i][ks] = *(const bf16x8*)(QK + (size_t)(kt0 * 32 + 16 * i + qc) * NTOK + C_IK + 32 * ks + 8 * g); }
    for (int rd = 0; rd < nrounds; ++rd) {
        const int kt = rd * 8 + wave;
        if (kt < NTL) {
            const int k0 = kt * 32;
            const float tau_l = tau[qc];
            f32x4 sc[2];
#pragma unroll
            for (int i = 0; i < 2; ++i) {
                sc[i] = (f32x4){0.f, 0.f, 0.f, 0.f};
#pragma unroll
                for (int h = 0; h < 8; ++h) {
                    f32x4 acc = {0.f, 0.f, 0.f, 0.f};
                    acc = __builtin_amdgcn_mfma_f32_16x16x32_bf16(kf[i][0], qf[h][0], acc, 0, 0, 0);
                    acc = __builtin_amdgcn_mfma_f32_16x16x32_bf16(kf[i][1], qf[h][1], acc, 0, 0, 0);
#pragma unroll
                    for (int r = 0; r < 4; ++r) sc[i][r] = fmaf(wq[h], fmaxf(acc[r], 0.f), sc[i][r]);
                }
            }
            { const int ktn = (kt + 8 < NTL) ? kt + 8 : kt;
#pragma unroll
              for (int i = 0; i < 2; ++i)
#pragma unroll
                  for (int ks = 0; ks < 2; ++ks) kf[i][ks] = *(const bf16x8*)(QK + (size_t)(ktn * 32 + 16 * i + qc) * NTOK + C_IK + 32 * ks + 8 * g); }
            const int klim = (kt == NTL - 1) ? t : 0x7fffffff;
            int n = 0;
#pragma unroll
            for (int i = 0; i < 2; ++i)
#pragma unroll
                for (int r = 0; r < 4; ++r) { const int key = k0 + 16 * i + 4 * g + r; n += (sc[i][r] >= tau_l && key <= klim) ? 1 : 0; }
            int slot = 0;
            if (n > 0) slot = (int)__hip_atomic_fetch_add(cnt + qc, (unsigned)n, __ATOMIC_RELAXED, __HIP_MEMORY_SCOPE_WORKGROUP);
#pragma unroll
            for (int i = 0; i < 2; ++i)
#pragma unroll
                for (int r = 0; r < 4; ++r) { const int key = k0 + 16 * i + 4 * g + r; const bool pass = sc[i][r] >= tau_l && key <= klim; const bool ok = pass && slot < CAP;
                    const unsigned addr = ok ? pool_a + (unsigned)slot * 8u : dump_a;
                    *(LAS u32x2*)(size_t)addr = (u32x2){__float_as_uint(sc[i][r]), (unsigned)key};
                    slot += pass ? 1 : 0; }
        }
        __syncthreads();
        const bool over = cnt[qc] > (unsigned)TRIG;
        if (__any(over)) {
#pragma unroll 1
            for (int i = 0; i < 2; ++i) { const int q = wave * 2 + i; if (cnt[q] > (unsigned)TRIG) prune(lds, q, lane); }
            __syncthreads();
        }
    }
#pragma unroll 1
    for (int i = 0; i < 2; ++i) { const int q = wave * 2 + i; finalize(lds, q, lane, BMP + (size_t)(qblk * NQ + q) * 512); }
    __syncthreads();
}
}

constexpr int NWAVES = 8, NTHREADS = 512;
constexpr int LDS_BYTES = 163840;
enum Phase { PH_PRO = 0, PH_G1 = 1, PH_IDX = 2, PH_ATB = 3, PH_ATA = 4, PH_T1 = 5, PH_T2 = 6, PH_T3 = 7, PH_T4 = 8, PH_T5 = 9, PH_N = 10 };

struct Args {
    const float* x; const float* p; const float* w_in; const float* w_pa; const float* w_pb; const float* w_o; const float* lqk; const float* subw;
    const float* ln_g; const float* ln_b; const float* w_ple; const float* w_gate; const float* rel_bias;
    float* out; unsigned char* ws; int ph_lo, ph_hi;
};

template <int MODE>
__device__ __forceinline__ void p0_transpose_item(const float* __restrict__ W, int K, int ld, int N, bf16_t* __restrict__ WT, LAS float* scr, int item, int lane) {
    const int nblk = N / 32, kb = item / nblk, nb = item % nblk, k0 = 64 * kb, n0 = 32 * nb;
    const int n = n0 + (lane & 31); const int c = MODE == 0 ? n : win_src_col(n);
#pragma unroll 8
    for (int i = 0; i < 32; ++i) { const int kk = 2 * i + (lane >> 5); scr[kk * 33 + (lane & 31)] = (c >= 0) ? W[(size_t)(k0 + kk) * ld + c] : 0.f; }
    asm volatile("s_waitcnt lgkmcnt(0)" ::: "memory");
    const int cc = lane & 7;
#pragma unroll
    for (int j = 0; j < 4; ++j) { const int nn = (lane >> 3) + 8 * j; const LAS float* s = scr + (8 * cc) * 33 + nn;
        u32x4 o; o.x = f2bf(s[0 * 33]) | ((unsigned)f2bf(s[1 * 33]) << 16); o.y = f2bf(s[2 * 33]) | ((unsigned)f2bf(s[3 * 33]) << 16);
        o.z = f2bf(s[4 * 33]) | ((unsigned)f2bf(s[5 * 33]) << 16); o.w = f2bf(s[6 * 33]) | ((unsigned)f2bf(s[7 * 33]) << 16);
        *(u32x4*)(WT + (size_t)(n0 + nn) * K + k0 + 8 * cc) = o; }
    asm volatile("s_waitcnt lgkmcnt(0)" ::: "memory");
}
__device__ __forceinline__ void cvt_rows(const float* __restrict__ src, bf16_t* __restrict__ dst, size_t n4, size_t gtid, size_t gthreads) {
    for (size_t i = gtid; i < n4; i += gthreads) { const float4 v = ((const float4*)src)[i]; u32x2 o; o.x = f2bf(v.x) | ((unsigned)f2bf(v.y) << 16); o.y = f2bf(v.z) | ((unsigned)f2bf(v.w) << 16); ((u32x2*)dst)[i] = o; }
}
__device__ __forceinline__ void ln_row(float* __restrict__ io, const float* __restrict__ g, const float* __restrict__ b, bf16_t* __restrict__ xln, int lane) {
    float4* r = (float4*)io + lane; float4 v[4]; float s = 0.f;
#pragma unroll
    for (int j = 0; j < 4; ++j) { v[j] = r[64 * j]; s += (v[j].x + v[j].y) + (v[j].z + v[j].w); }
#pragma unroll
    for (int o = 1; o < 64; o <<= 1) s += __shfl_xor(s, o);
    const float mean = s * (1.f / 1024.f); float q = 0.f;
#pragma unroll
    for (int j = 0; j < 4; ++j) { v[j].x -= mean; v[j].y -= mean; v[j].z -= mean; v[j].w -= mean; q += (v[j].x * v[j].x + v[j].y * v[j].y) + (v[j].z * v[j].z + v[j].w * v[j].w); }
#pragma unroll
    for (int o = 1; o < 64; o <<= 1) q += __shfl_xor(q, o);
    const float rstd = rsqrtf(q * (1.f / 1024.f) + 1e-5f);
#pragma unroll
    for (int j = 0; j < 4; ++j) {
        const float4 gg = ((const float4*)g)[lane + 64 * j], bb = ((const float4*)b)[lane + 64 * j];
        float4 o; o.x = v[j].x * rstd * gg.x + bb.x; o.y = v[j].y * rstd * gg.y + bb.y; o.z = v[j].z * rstd * gg.z + bb.z; o.w = v[j].w * rstd * gg.w + bb.w;
        r[64 * j] = o; u32x2 w; w.x = f2bf(o.x) | ((unsigned)f2bf(o.y) << 16); w.y = f2bf(o.z) | ((unsigned)f2bf(o.w) << 16);
        ((u32x2*)xln)[lane + 64 * j] = w;
    }
}

__global__ void __launch_bounds__(NTHREADS, 2) mega(Args a) {
    extern __shared__ __attribute__((aligned(16))) unsigned char lds_raw[];
    LAS unsigned char* lds = (LAS unsigned char*)lds_raw;
    const int tid = threadIdx.x, lane = tid & 63, wave = __builtin_amdgcn_readfirstlane(tid >> 6);
    const int G = gridDim.x, bx = blockIdx.x;
    unsigned char* ws = a.ws;
    bf16_t* WIN = (bf16_t*)(ws + WS_WIN); bf16_t* WPA = (bf16_t*)(ws + WS_WPA); bf16_t* WPB = (bf16_t*)(ws + WS_WPB); bf16_t* WO = (bf16_t*)(ws + WS_WO);
    bf16_t* WGT = (bf16_t*)(ws + WS_WGT); bf16_t* WPLE = (bf16_t*)(ws + WS_WPLE); bf16_t* XBF = (bf16_t*)(ws + WS_XBF); bf16_t* PBF = (bf16_t*)(ws + WS_PBF);
    bf16_t* QK = (bf16_t*)(ws + WS_QK); bf16_t* VT = (bf16_t*)(ws + WS_VT); bf16_t* OAB = (bf16_t*)(ws + WS_OAB);
    bf16_t* PLEO = (bf16_t*)(ws + WS_PLEO); bf16_t* Gb = (bf16_t*)(ws + WS_G); bf16_t* MRG = (bf16_t*)(ws + WS_MRG); bf16_t* XLN = (bf16_t*)(ws + WS_XLN);
    float* BT = (float*)(ws + WS_BT);
    const int lo = a.ph_lo, hi = a.ph_hi;
#define IN(k) (lo <= (k) && (k) < hi)

    if (IN(PH_PRO)) {
        LAS float* scr = (LAS float*)(lds + wave * 16384);
        const int gw = bx * NWAVES + wave, NGW = G * NWAVES;
        constexpr int I_IN = (WT_ROWS / 32) * (1024 / 64), I_PA = 32 * 8, I_O = 32 * 16, I_PLE = 32 * 4;
        constexpr int NITEMS = I_IN + 2 * I_PA + 2 * I_O + I_PLE;
        for (int it = gw; it < NITEMS; it += NGW) {
            int r = it;
            if (r < I_IN) { p0_transpose_item<1>(a.w_in, 1024, IN_COLS, WT_ROWS, WIN, scr, r, lane); continue; } r -= I_IN;
            if (r < I_PA) { p0_transpose_item<0>(a.w_pa, 512, 1024, 1024, WPA, scr, r, lane); continue; } r -= I_PA;
            if (r < I_PA) { p0_transpose_item<0>(a.w_pb, 512, 1024, 1024, WPB, scr, r, lane); continue; } r -= I_PA;
            if (r < I_O) { p0_transpose_item<0>(a.w_o, 1024, 1024, 1024, WO, scr, r, lane); continue; } r -= I_O;
            if (r < I_O) { p0_transpose_item<0>(a.w_gate, 1024, 1024, 1024, WGT, scr, r, lane); continue; } r -= I_O;
            p0_transpose_item<0>(a.w_ple, 256, 1024, 1024, WPLE, scr, r, lane);
        }
        const size_t gtid = (size_t)bx * NTHREADS + tid, gth = (size_t)G * NTHREADS;
        cvt_rows(a.x, XBF, (size_t)L * 1024 / 4, gtid, gth);
        cvt_rows(a.p, PBF, (size_t)L * 256 / 4, gtid, gth);
        if (gtid < 128 * 12) { const int n = (int)gtid / 12, h = (int)gtid % 12; BT[gtid] = a.rel_bias[rel_bucket(n) * 12 + h]; }
    }
    if (IN(PH_G1)) {
        { pg8::Gemm g{XBF, WIN + (size_t)WT_TOK * 1024, L, NTOK, 1024, 1024, 1024}; pg8::StaticOrder S; S.init(L, NTOK, G, bx);
          pg8::EpiStoreBf E{QK, NTOK, 0}; pg8::gemm_phase<pg8::EpiStoreBf, pg8::StaticOrder, true, true>(lds, g, S, E); }
        { pg8::Gemm g{WIN + (size_t)WT_VT * 1024, XBF, 1024, L, 1024, 1024, 1024}; pg8::StaticOrder S; S.init(1024, L, G, bx);
          pg8::EpiVTdual E{VT, (bf16_t*)a.out}; pg8::gemm_phase<pg8::EpiVTdual, pg8::StaticOrder, true, true>(lds, g, S, E); }
    }
    if (IN(PH_IDX)) {
        unsigned* BMPw = (unsigned*)(ws + WS_BMP);
        for (int p = bx; p < 512; p += G) { idx::index_unit(lds, 1023 - p, QK, BMPw); idx::index_unit(lds, p, QK, BMPw); }
    }
    if (IN(PH_ATB) || IN(PH_ATA)) {
        const int vcu = (G % 8 == 0) ? (bx % 8) * (G / 8) + bx / 8 : bx;
        const unsigned* BMP = (const unsigned*)(ws + WS_BMP);
        if (IN(PH_ATB)) {
            float la = a.lqk[lane] * a.lqk[64 + lane], lb = a.lqk[128 + lane] * a.lqk[192 + lane];
#pragma unroll
            for (int o = 1; o < 64; o <<= 1) { la += __shfl_xor(la, o); lb += __shfl_xor(lb, o); }
            const float lam = __expf(la) - __expf(lb) + LAM_INIT;
            for (int p = vcu; p < 256; p += G) { const int h = p >> 6, xq = p & 63;
                att::attn_unit<1>(lds, h, 127 - xq, QK, VT, BMP, BT, a.subw, lam, OAB);
                att::attn_unit<1>(lds, h, xq, QK, VT, BMP, BT, a.subw, lam, OAB); }
        }
        if (IN(PH_ATA)) {
            for (int p = vcu; p < 256; p += G) { const int h = p >> 5, xq = p & 31;
                att::attn_unit<0>(lds, h, 63 - xq, QK, VT, BMP, BT, a.subw, 0.f, OAB);
                att::attn_unit<0>(lds, h, xq, QK, VT, BMP, BT, a.subw, 0.f, OAB); }
        }
    }
    if (IN(PH_T1)) {
        { pg8::Gemm g{XBF, WIN + (size_t)WT_Z * 1024, L, 1024, 1024, 1024, 1024}; pg8::StaticOrder S; S.init(L, 1024, G, bx);
          pg8::EpiZ E{OAB}; pg8::gemm_phase<pg8::EpiZ, pg8::StaticOrder, true, true>(lds, g, S, E); }
        { pg8::Gemm g{XBF, WIN + (size_t)WT_G * 1024, L, 2048, 1024, 1024, 1024}; pg8::StaticOrder S; S.init(L, 2048, G, bx);
          pg8::EpiG E{Gb}; pg8::gemm_phase<pg8::EpiG, pg8::StaticOrder, true, true>(lds, g, S, E); }
    }
    if (IN(PH_T2)) {
        { pg8::Gemm g{OAB, WPA, L, 1024, 512, 1024, 512}; pg8::StaticOrder S; S.init(L, 1024, G, bx);
          pg8::EpiPA E{Gb, MRG}; pg8::gemm_phase<pg8::EpiPA, pg8::StaticOrder, true, true>(lds, g, S, E); }
        { pg8::Gemm g{OAB + 512, WPB, L, 1024, 512, 1024, 512}; pg8::StaticOrder S; S.init(L, 1024, G, bx);
          pg8::EpiPB E{Gb, MRG}; pg8::gemm_phase<pg8::EpiPB, pg8::StaticOrder, true, true>(lds, g, S, E); }
        { pg8::Gemm g{PBF, WPLE, L, 1024, 256, 256, 256}; pg8::StaticOrder S; S.init(L, 1024, G, bx);
          pg8::EpiStoreBf E{PLEO, 1024, 0}; pg8::gemm_phase<pg8::EpiStoreBf, pg8::StaticOrder, true, true>(lds, g, S, E); }
    }
    if (IN(PH_T3)) {
        pg8::Gemm g{MRG, WO, L, 1024, 1024, 1024, 1024}; pg8::StaticOrder S; S.init(L, 1024, G, bx);
        pg8::EpiO E{a.x, a.out}; pg8::gemm_phase<pg8::EpiO, pg8::StaticOrder, true, true>(lds, g, S, E);
    }
    if (IN(PH_T4)) {
        const int gw = bx * NWAVES + wave, NGW = G * NWAVES;
        for (int m = gw; m < L; m += NGW) ln_row(a.out + (size_t)m * 1024, a.ln_g, a.ln_b, XLN + (size_t)m * 1024, lane);
    }
    if (IN(PH_T5)) {
        pg8::Gemm g{XLN, WGT, L, 1024, 1024, 1024, 1024}; pg8::StaticOrder S; S.init(L, 1024, G, bx);
        pg8::EpiGate E{a.out, PLEO}; pg8::gemm_phase<pg8::EpiGate, pg8::StaticOrder, true, true>(lds, g, S, E);
    }
#undef IN
}

extern "C" void kernel_launch(void* const* d_in, const int* in_sizes, int n_in, void* d_out, int out_size, void* d_ws, size_t ws_size, hipStream_t stream) {
    static int grid = 0;
    if (grid == 0) {
        if (ws_size < WS_END) { fprintf(stderr, "workspace too small: %zu\n", ws_size); grid = -1; return; }
        (void)hipFuncSetAttribute((const void*)mega, hipFuncAttributeMaxDynamicSharedMemorySize, LDS_BYTES);
        (void)hipFuncSetAttribute((const void*)naive_index, hipFuncAttributeMaxDynamicSharedMemorySize, 80 * 1024);
        int dev = 0, cus = 0; (void)hipGetDevice(&dev); (void)hipDeviceGetAttribute(&cus, hipDeviceAttributeMultiprocessorCount, dev);
        grid = cus > 0 ? cus : 256;
    }
    if (grid < 0) return;
    Args a{};
    a.x = (const float*)d_in[0]; a.p = (const float*)d_in[1]; a.w_in = (const float*)d_in[2]; a.w_pa = (const float*)d_in[3]; a.w_pb = (const float*)d_in[4]; a.w_o = (const float*)d_in[5];
    a.lqk = (const float*)d_in[6]; a.subw = (const float*)d_in[7]; a.ln_g = (const float*)d_in[8]; a.ln_b = (const float*)d_in[9];
    a.w_ple = (const float*)d_in[10]; a.w_gate = (const float*)d_in[11]; a.rel_bias = (const float*)d_in[12];
    a.out = (float*)d_out; a.ws = (unsigned char*)d_ws;
    unsigned char* ws = (unsigned char*)d_ws;
    bf16_t* QK = (bf16_t*)(ws + WS_QK); unsigned* BMP = (unsigned*)(ws + WS_BMP); bf16_t* OAB = (bf16_t*)(ws + WS_OAB); float* BT = (float*)(ws + WS_BT);
    bf16_t* VTOK = (bf16_t*)d_out; bf16_t* OB12 = (bf16_t*)((unsigned char*)d_out + 32 * MiB);
    auto run = [&](int lo, int hi) { a.ph_lo = lo; a.ph_hi = hi; hipLaunchKernelGGL(mega, dim3(grid), dim3(NTHREADS), LDS_BYTES, stream, a); };
    run(PH_PRO, PH_PRO + 1);
    run(PH_G1, PH_G1 + 1);
    run(PH_IDX, PH_IDX + 1);
    run(PH_ATB, PH_ATB + 1);
    run(PH_ATA, PH_ATA + 1);
    run(PH_T1, PH_T1 + 1);
    run(PH_T2, PH_T2 + 1);
    run(PH_T3, PH_T3 + 1);
    run(PH_T4, PH_T4 + 1);
    run(PH_T5, PH_T5 + 1);
}
```

```cpp
#include <hip/hip_runtime.h>
#include <hip/hip_cooperative_groups.h>
#include <cstdint>
#include <cstdio>

typedef unsigned short bf16_t;
typedef unsigned u32x4 __attribute__((ext_vector_type(4)));
typedef unsigned u32x2 __attribute__((ext_vector_type(2)));

constexpr int L = 16384, DM = 1024, PLE = 256;
constexpr int IN_COLS = 6728;
constexpr int NTOK = 2816;
constexpr int C_AQ = 0, C_AK = 512, C_BQ = 1024, C_BK = 1536, C_IQ = 2048, C_IK = 2560, C_IW = 2624;
constexpr int WT_TOK = 0, WT_VT = 2816, WT_Z = 3840, WT_G = 4864, WT_ROWS = 6912;
constexpr float ALPHA = 1.18920711500272f;
constexpr float LAM_INIT = 0.2f;

constexpr size_t MiB = 1u << 20;
constexpr size_t WS_CTL = 0;
constexpr size_t WS_BT = 512 * 1024;
constexpr size_t WS_WIN = 1 * MiB;
constexpr size_t WS_WPA = 15 * MiB;
constexpr size_t WS_WPB = 16 * MiB;
constexpr size_t WS_WO = 17 * MiB;
constexpr size_t WS_WGT = 19 * MiB;
constexpr size_t WS_WPLE = 21 * MiB;
constexpr size_t WS_XBF = 22 * MiB;
constexpr size_t WS_PBF = 54 * MiB;
constexpr size_t WS_QK = 62 * MiB;
constexpr size_t WS_VT = 154 * MiB;
constexpr size_t WS_BMP = 186 * MiB;
constexpr size_t WS_OAB = 218 * MiB;
constexpr size_t WS_END = 250 * MiB;
constexpr size_t WS_PLEO = WS_XBF, WS_G = WS_QK, WS_MRG = WS_VT, WS_XLN = WS_BMP;

__device__ __forceinline__ float bf2f(bf16_t v) { return __uint_as_float(((unsigned)v) << 16); }
__device__ __forceinline__ bf16_t f2bf(float f) { unsigned u = __float_as_uint(f); return (bf16_t)((u + 0x7fffu + ((u >> 16) & 1u)) >> 16); }
__device__ __forceinline__ float sigmoidf_(float v) { return 1.f / (1.f + __expf(-v)); }
__device__ __forceinline__ float siluf_(float v) { return v / (1.f + __expf(-v)); }

__host__ __device__ __forceinline__ int win_src_col(int n) {
    if (n < WT_VT) {
        if (n < 512) return n;
        if (n < 1024) return n;
        if (n < 1536) return 2632 + (n - 1024);
        if (n < 2048) return 3144 + (n - 1536);
        if (n < 2560) return 2048 + (n - 2048);
        if (n < 2624) return 2560 + (n - 2560);
        if (n < 2632) return 2624 + (n - 2624);
        return -1;
    }
    if (n < WT_Z) { int r = n - WT_VT; return r < 512 ? 1024 + r : 3656 + (r - 512); }
    if (n < WT_G) { int r = n - WT_Z; return r < 512 ? 1536 + r : 4168 + (r - 512); }
    return 4680 + (n - WT_G);
}

__device__ __forceinline__ int rel_bucket(int n) {
    if (n < 16) return n;
    int b = 16 + (int)(logf((float)n / 16.f) / logf(8.f) * 16.f);
    return b > 31 ? 31 : b;
}
namespace pg8 {
#define PG8_LAS __attribute__((address_space(3)))
typedef unsigned short bf16_t;
typedef short bf16x8 __attribute__((ext_vector_type(8)));
typedef float f32x4 __attribute__((ext_vector_type(4)));
typedef unsigned u32x4 __attribute__((ext_vector_type(4)));
constexpr int BM = 256, BK = 64, HALF = 128, HTB = HALF * BK * 2  , STAGE_BYTES = 8 * HTB, NXCD = 8, WGM = 8;

__host__ __device__ __forceinline__ int lds_byte(int r, int c) { const int st = (r >> 4) * 2 + (c >> 5), rr = r & 15, cc = c & 31, ob = rr * 64 + cc * 2; return st * 1024 + (ob ^ (((ob >> 9) & 1) << 5)); }
__host__ __device__ __forceinline__ void stage_rc(int b, int& R, int& C) { const int st = b / 1024, sb = b % 1024, swz = sb ^ (((sb >> 9) & 1) << 5); R = (st >> 1) * 16 + swz / 64; C = (st & 1) * 32 + (swz % 64) / 2; }
__host__ __device__ __forceinline__ int perm32(int rho) { const int n = rho >> 4, i = rho & 15; return 8 * (i >> 2) + 4 * n + (i & 3); }

struct Unit { int pm, pn; };
struct Gemm { const bf16_t* A; const bf16_t* Bt; int M, N, K, lda, ldb; };

struct StaticOrder {
    int nM, nN, nwg, G, c;
    __host__ __device__ void init(int M, int N, int G_, int c_) { nM = M / BM; nN = N / BM; nwg = nM * nN; G = G_; c = c_; }
    __host__ __device__ bool next(int i, Unit& u) const {
        const long L = (long)i * G + c; if (L >= nwg) return false;
        int wgid = (int)L; { const int q = nwg / NXCD, r = nwg % NXCD, xcd = wgid % NXCD, off = wgid / NXCD; wgid = (xcd < r ? xcd * (q + 1) : r * (q + 1) + (xcd - r) * q) + off; }
        const int nig = WGM * nN, gid = wgid / nig, fm = gid * WGM, gsz = (nM - fm) < WGM ? (nM - fm) : WGM;
        u.pm = fm + ((wgid % nig) % gsz); u.pn = (wgid % nig) / gsz; return true;
    }
    __device__ __forceinline__ void a_ready(const Unit&) const {}
    __device__ __forceinline__ void done(const Unit&) const {}
};


typedef float f32x2_t __attribute__((ext_vector_type(2))); typedef __bf16 bf16x2_t __attribute__((ext_vector_type(2)));
__device__ __forceinline__ unsigned cvt_pk_bf16(float lo, float hi) { f32x2_t v = {lo, hi}; bf16x2_t b = __builtin_convertvector(v, bf16x2_t); return __builtin_bit_cast(unsigned, b); }
__device__ __forceinline__ u32x4 pack8(const f32x4 a, const f32x4 b) { u32x4 w; w.x = cvt_pk_bf16(a[0], a[1]); w.y = cvt_pk_bf16(a[2], a[3]); w.z = cvt_pk_bf16(b[0], b[1]); w.w = cvt_pk_bf16(b[2], b[3]); return w; }
__device__ __forceinline__ void unpack8(const u32x4 w, f32x4& a, f32x4& b) {
    a[0] = __uint_as_float(w.x << 16); a[1] = __uint_as_float(w.x & 0xffff0000u); a[2] = __uint_as_float(w.y << 16); a[3] = __uint_as_float(w.y & 0xffff0000u);
    b[0] = __uint_as_float(w.z << 16); b[1] = __uint_as_float(w.z & 0xffff0000u); b[2] = __uint_as_float(w.w << 16); b[3] = __uint_as_float(w.w & 0xffff0000u); }
__device__ __forceinline__ float fsig(float v) { return __builtin_amdgcn_rcpf(1.f + __expf(-v)); }
__device__ __forceinline__ f32x4 sig4(const f32x4 v) { f32x4 r; r[0] = fsig(v[0]); r[1] = fsig(v[1]); r[2] = fsig(v[2]); r[3] = fsig(v[3]); return r; }
#define PG8_EPI_LOOP(...) \
    _Pragma("unroll") for (int ai = 0; ai < 2; ++ai) _Pragma("unroll") for (int m = 0; m < 4; ++m) { const size_t row = (size_t)(u.pm * BM + ai * HALF + wr * 64 + m * 16 + fr); \
    _Pragma("unroll") for (int bj = 0; bj < 2; ++bj) { const int col = u.pn * BM + bj * HALF + wc * 32 + 8 * fq; f32x4 v0 = acc[ai][bj][m][0], v1 = acc[ai][bj][m][1]; __VA_ARGS__ } }
#define PG8_EPI_SIG const f32x4 (&acc)[2][2][4][2], const Unit& u, int wr, int wc, int fr, int fq
struct EpiStoreBf { static constexpr bool PERM = true, AFTER_DRAIN = false; bf16_t* O; int ldc, pad;
    __device__ __forceinline__ void operator()(PG8_EPI_SIG) const { PG8_EPI_LOOP( *(u32x4*)(O + row * ldc + col) = pack8(v0, v1); ) } };
struct EpiVTdual { static constexpr bool PERM = true, AFTER_DRAIN = false; bf16_t* VT; bf16_t* VTOK;
    __device__ __forceinline__ void operator()(PG8_EPI_SIG) const { PG8_EPI_LOOP( const u32x4 w = pack8(v0, v1); *(u32x4*)(VT + row * 16384 + col) = w;
        if (VTOK) { VTOK[(size_t)(col + 0) * 1024 + row] = (bf16_t)(w.x & 0xffff); VTOK[(size_t)(col + 1) * 1024 + row] = (bf16_t)(w.x >> 16); VTOK[(size_t)(col + 2) * 1024 + row] = (bf16_t)(w.y & 0xffff); VTOK[(size_t)(col + 3) * 1024 + row] = (bf16_t)(w.y >> 16);
                    VTOK[(size_t)(col + 4) * 1024 + row] = (bf16_t)(w.z & 0xffff); VTOK[(size_t)(col + 5) * 1024 + row] = (bf16_t)(w.z >> 16); VTOK[(size_t)(col + 6) * 1024 + row] = (bf16_t)(w.w & 0xffff); VTOK[(size_t)(col + 7) * 1024 + row] = (bf16_t)(w.w >> 16); } ) } };
struct EpiZ { static constexpr bool PERM = true, AFTER_DRAIN = false; bf16_t* OAB;
    __device__ __forceinline__ void operator()(PG8_EPI_SIG) const { PG8_EPI_LOOP( u32x4* p = (u32x4*)(OAB + row * 1024 + col); f32x4 o0, o1; unpack8(*p, o0, o1);
        *p = pack8(v0 * sig4(v0) * o0, v1 * sig4(v1) * o1); ) } };
struct EpiG { static constexpr bool PERM = true, AFTER_DRAIN = false; bf16_t* G;
    __device__ __forceinline__ void operator()(PG8_EPI_SIG) const { PG8_EPI_LOOP( *(u32x4*)(G + row * 2048 + col) = pack8(sig4(v0), sig4(v1)); ) } };
struct EpiPA { static constexpr bool PERM = true, AFTER_DRAIN = false; const bf16_t* G; bf16_t* MRG;
    __device__ __forceinline__ void operator()(PG8_EPI_SIG) const { PG8_EPI_LOOP( f32x4 g0, g1; unpack8(*(const u32x4*)(G + row * 2048 + col), g0, g1);
        *(u32x4*)(MRG + row * 1024 + col) = pack8(g0 * v0, g1 * v1); ) } };
struct EpiPB { static constexpr bool PERM = true, AFTER_DRAIN = false; const bf16_t* G; bf16_t* MRG;
    __device__ __forceinline__ void operator()(PG8_EPI_SIG) const { PG8_EPI_LOOP( f32x4 g0, g1, m0, m1; unpack8(*(const u32x4*)(G + row * 2048 + 1024 + col), g0, g1);
        u32x4* p = (u32x4*)(MRG + row * 1024 + col); unpack8(*p, m0, m1); *p = pack8(m0 + g0 * v0, m1 + g1 * v1); ) } };
struct EpiO { static constexpr bool PERM = true, AFTER_DRAIN = false; const float* x; float* PRE;
    __device__ __forceinline__ void operator()(PG8_EPI_SIG) const { PG8_EPI_LOOP( const f32x4 x0 = *(const f32x4*)(x + row * 1024 + col), x1 = *(const f32x4*)(x + row * 1024 + col + 4);
        *(f32x4*)(PRE + row * 1024 + col) = x0 * 1.18920711500272f + v0; *(f32x4*)(PRE + row * 1024 + col + 4) = x1 * 1.18920711500272f + v1; ) } };
struct EpiGate { static constexpr bool PERM = true, AFTER_DRAIN = false; float* out; const bf16_t* PLEO;
    __device__ __forceinline__ void operator()(PG8_EPI_SIG) const { PG8_EPI_LOOP( f32x4 p0, p1; unpack8(*(const u32x4*)(PLEO + row * 1024 + col), p0, p1);
        f32x4* o = (f32x4*)(out + row * 1024 + col); const f32x4 a0 = o[0], a1 = o[1]; o[0] = a0 + sig4(v0) * p0; o[1] = a1 + sig4(v1) * p1; ) } };

template <class Epi, class Sched, bool ALIGN_EPI = false, bool SP2 = false>
__device__ __forceinline__ void gemm_phase(PG8_LAS unsigned char* lds, const Gemm g, const Sched& S, const Epi& E) {
    const int tid = threadIdx.x, wid = __builtin_amdgcn_readfirstlane(tid >> 6), lane = tid & 63, wr = wid >> 2, wc = wid & 3, fr = lane & 15, fq = lane >> 4;
    const int K = g.K, nt = K / BK;
    unsigned voffA[2], voffB[2];
#pragma unroll
    for (int i = 0; i < 2; ++i) { int R, C; stage_rc(tid * 16 + i * 8192, R, C); const int Rb = Epi::PERM ? ((R & ~31) + perm32(R & 31)) : R;
        voffA[i] = (unsigned)(R * g.lda + C) * 2u; voffB[i] = (unsigned)(Rb * g.ldb + C) * 2u; }
    const size_t kstep = (size_t)(BK * 2);
    const size_t hstepA = (size_t)HALF * g.lda * 2, hstepB = (size_t)HALF * g.ldb * 2;
    const size_t tstepA = 2 * hstepA, tstepB = 2 * hstepB;
    const unsigned ldsw = (unsigned)wid * 1024u;
    const int aoff = lds_byte(wr * 64 + fr, fq * 8), boff = lds_byte(wc * 32 + fr, fq * 8);
#define PG8_SA(b, h) (((b) * 2 + (h)) * HTB)
#define PG8_SB(b, h) ((4 + (b) * 2 + (h)) * HTB)
#define PG8_STAGE(bufoff, gbase, voff) do { _Pragma("unroll") for (int _i = 0; _i < 2; ++_i) \
        __builtin_amdgcn_global_load_lds((const unsigned*)((const char*)(gbase) + (voff)[_i]), (PG8_LAS unsigned*)(lds + (bufoff) + ldsw + _i * 8192), 16, 0, 0); } while (0)
#define PG8_LDA(dst, b, h) do { _Pragma("unroll") for (int m = 0; m < 4; ++m) _Pragma("unroll") for (int k = 0; k < 2; ++k) dst[m][k] = *(const PG8_LAS bf16x8*)(lds + PG8_SA(b, h) + aoff + m * 2048 + k * 1024); } while (0)
#define PG8_LDB(dst, b, h) do { _Pragma("unroll") for (int n = 0; n < 2; ++n) _Pragma("unroll") for (int k = 0; k < 2; ++k) dst[n][k] = *(const PG8_LAS bf16x8*)(lds + PG8_SB(b, h) + boff + n * 2048 + k * 1024); } while (0)
#define PG8_MMA(ai, bj, At, Bt) do { __builtin_amdgcn_s_setprio(1); _Pragma("unroll") for (int m = 0; m < 4; ++m) _Pragma("unroll") for (int n = 0; n < 2; ++n) _Pragma("unroll") for (int k = 0; k < 2; ++k) \
        acc[ai][bj][m][n] = __builtin_amdgcn_mfma_f32_16x16x32_bf16(Bt[n][k], At[m][k], acc[ai][bj][m][n], 0, 0, 0); __builtin_amdgcn_s_setprio(0); } while (0)
#define PG8_WAIT_V(n) asm volatile("s_waitcnt vmcnt(" #n ")" ::: "memory")
#define PG8_WAIT_L(n) asm volatile("s_waitcnt lgkmcnt(" #n ")" ::: "memory")
#define PG8_BAR __builtin_amdgcn_s_barrier()
#define PG8_SCHED __builtin_amdgcn_sched_barrier(0)
    Unit cur, nxt; int ui = 0;
    if (!S.next(0, cur)) return;
    f32x4 acc[2][2][4][2];
#pragma unroll
    for (int a = 0; a < 2; ++a)
#pragma unroll
        for (int b = 0; b < 2; ++b)
#pragma unroll
            for (int m = 0; m < 4; ++m)
#pragma unroll
                for (int n = 0; n < 2; ++n) acc[a][b][m][n] = (f32x4){0.f, 0.f, 0.f, 0.f};
    bf16x8 At[4][2], B0[2][2], B1[2][2];
    const char* cA = (const char*)g.A + (size_t)cur.pm * tstepA; const char* cB = (const char*)g.Bt + (size_t)cur.pn * tstepB;
    S.a_ready(cur);
    if constexpr (SP2) {
        PG8_STAGE(PG8_SB(0, 0), cB, voffB); PG8_STAGE(PG8_SB(0, 1), cB + hstepB, voffB); PG8_STAGE(PG8_SA(0, 0), cA, voffA); PG8_STAGE(PG8_SA(0, 1), cA + hstepA, voffA);
        if (wr == 1) PG8_BAR;
        PG8_WAIT_V(2); PG8_BAR;
        PG8_STAGE(PG8_SB(1, 0), cB + kstep, voffB); PG8_STAGE(PG8_SA(1, 0), cA + kstep, voffA); PG8_STAGE(PG8_SB(1, 1), cB + hstepB + kstep, voffB);
        PG8_WAIT_V(6); PG8_BAR;
    } else {
        PG8_STAGE(PG8_SB(0, 0), cB, voffB); PG8_STAGE(PG8_SA(0, 0), cA, voffA); PG8_STAGE(PG8_SB(0, 1), cB + hstepB, voffB); PG8_STAGE(PG8_SA(0, 1), cA + hstepA, voffA);
        if (wr == 1) PG8_BAR;
        PG8_WAIT_V(4); PG8_BAR;
        PG8_STAGE(PG8_SB(1, 0), cB + kstep, voffB); PG8_STAGE(PG8_SA(1, 0), cA + kstep, voffA); PG8_STAGE(PG8_SB(1, 1), cB + hstepB + kstep, voffB);
        PG8_WAIT_V(6); PG8_BAR;
    }
    for (;;) {
        const bool has_next = S.next(ui + 1, nxt);
        const char* nA = has_next ? (const char*)g.A + (size_t)nxt.pm * tstepA : cA; const char* nB = has_next ? (const char*)g.Bt + (size_t)nxt.pn * tstepB : cB;
        for (int t = 0; t < nt; t += 2) {
            const bool last = (t == nt - 2);
            const char* a1 = cA + (size_t)(t + 1) * kstep;
            const char* a2 = last ? nA : cA + (size_t)(t + 2) * kstep; const char* b2 = last ? nB : cB + (size_t)(t + 2) * kstep;
            const char* a3 = a2 + kstep; const char* b3 = b2 + kstep;
            if (last && has_next) S.a_ready(nxt);
            if constexpr (SP2) {
            PG8_LDB(B0, 0, 0); PG8_LDB(B1, 0, 1); PG8_SCHED; PG8_LDA(At, 0, 0); PG8_STAGE(PG8_SA(1, 1), a1 + hstepA, voffA);
            PG8_WAIT_V(8); PG8_WAIT_L(0); PG8_BAR; PG8_MMA(0, 0, At, B0); PG8_MMA(0, 1, At, B1); PG8_BAR; PG8_SCHED;
            PG8_LDA(At, 0, 1); PG8_STAGE(PG8_SB(0, 0), b2, voffB); PG8_STAGE(PG8_SB(0, 1), b2 + hstepB, voffB); PG8_STAGE(PG8_SA(0, 0), a2, voffA);
            PG8_WAIT_V(8); PG8_WAIT_L(0); PG8_BAR; PG8_MMA(1, 0, At, B0); PG8_MMA(1, 1, At, B1); PG8_BAR; PG8_SCHED;
            PG8_LDB(B0, 1, 0); PG8_LDB(B1, 1, 1); PG8_SCHED; PG8_LDA(At, 1, 0); PG8_STAGE(PG8_SA(0, 1), a2 + hstepA, voffA);
            PG8_WAIT_V(8); PG8_WAIT_L(0); PG8_BAR; PG8_MMA(0, 0, At, B0); PG8_MMA(0, 1, At, B1); PG8_BAR; PG8_SCHED;
            PG8_LDA(At, 1, 1); PG8_STAGE(PG8_SB(1, 0), b3, voffB); PG8_STAGE(PG8_SB(1, 1), b3 + hstepB, voffB); PG8_STAGE(PG8_SA(1, 0), a3, voffA);
            PG8_WAIT_V(8); PG8_WAIT_L(0); PG8_BAR; PG8_MMA(1, 0, At, B0); PG8_MMA(1, 1, At, B1); PG8_BAR; PG8_SCHED;
            } else {
            PG8_LDB(B0, 0, 0); PG8_SCHED; PG8_LDA(At, 0, 0); PG8_STAGE(PG8_SA(1, 1), a1 + hstepA, voffA);
            PG8_WAIT_L(8); PG8_BAR; PG8_WAIT_L(0); PG8_MMA(0, 0, At, B0); PG8_BAR; PG8_SCHED;
            PG8_LDB(B1, 0, 1); PG8_STAGE(PG8_SB(0, 0), b2, voffB);
            PG8_BAR; PG8_WAIT_L(0); PG8_MMA(0, 1, At, B1); PG8_BAR;
            PG8_LDA(At, 0, 1); PG8_STAGE(PG8_SA(0, 0), a2, voffA);
            PG8_BAR; PG8_WAIT_L(0); PG8_MMA(1, 0, At, B0); PG8_BAR; PG8_SCHED;
            PG8_STAGE(PG8_SB(0, 1), b2 + hstepB, voffB);
            PG8_WAIT_V(6); PG8_BAR; PG8_MMA(1, 1, At, B1); PG8_BAR;
            PG8_LDB(B0, 1, 0); PG8_SCHED; PG8_LDA(At, 1, 0); PG8_STAGE(PG8_SA(0, 1), a2 + hstepA, voffA);
            PG8_WAIT_L(8); PG8_BAR; PG8_WAIT_L(0); PG8_MMA(0, 0, At, B0); PG8_BAR; PG8_SCHED;
            PG8_LDB(B1, 1, 1); PG8_STAGE(PG8_SB(1, 0), b3, voffB);
            PG8_BAR; PG8_WAIT_L(0); PG8_MMA(0, 1, At, B1); PG8_BAR;
            PG8_LDA(At, 1, 1); PG8_STAGE(PG8_SA(1, 0), a3, voffA);
            PG8_BAR; PG8_WAIT_L(0); PG8_MMA(1, 0, At, B0); PG8_BAR; PG8_SCHED;
            PG8_STAGE(PG8_SB(1, 1), b3 + hstepB, voffB);
            PG8_WAIT_V(6); PG8_BAR; PG8_MMA(1, 1, At, B1); PG8_BAR;
            }
        }
        if constexpr (ALIGN_EPI) { if (wr == 0) PG8_BAR; }
        if constexpr (!Epi::AFTER_DRAIN) { E(acc, cur, wr, wc, fr, fq); S.done(cur); }
        if (!has_next) break;
#pragma unroll
        for (int a = 0; a < 2; ++a)
#pragma unroll
            for (int b = 0; b < 2; ++b)
#pragma unroll
                for (int m = 0; m < 4; ++m)
#pragma unroll
                    for (int n = 0; n < 2; ++n) acc[a][b][m][n] = (f32x4){0.f, 0.f, 0.f, 0.f};
        cur = nxt; cA = nA; cB = nB; ++ui;
        if constexpr (ALIGN_EPI) { if (wr == 1) PG8_BAR; }
    }
    PG8_WAIT_V(0);
    if constexpr (!ALIGN_EPI) { if (wr == 0) PG8_BAR; }
    PG8_BAR;
    if constexpr (Epi::AFTER_DRAIN) { E.fused(acc, cur, wr, wc, fr, fq, lds, wid, lane); S.done(cur); }
#undef PG8_SA
#undef PG8_SB
#undef PG8_STAGE
#undef PG8_LDA
#undef PG8_LDB
#undef PG8_MMA
#undef PG8_WAIT_V
#undef PG8_WAIT_L
#undef PG8_BAR
#undef PG8_SCHED
}
}

#define LAS __attribute__((address_space(3)))
namespace att {
typedef short bf16x8 __attribute__((ext_vector_type(8)));
typedef float f32x16 __attribute__((ext_vector_type(16)));
typedef float f32x2_t __attribute__((ext_vector_type(2))); typedef __bf16 bf16x2_t __attribute__((ext_vector_type(2)));
__device__ __forceinline__ unsigned cvtpk(float lo, float hi) { f32x2_t v = {lo, hi}; bf16x2_t b = __builtin_convertvector(v, bf16x2_t); return __builtin_bit_cast(unsigned, b); }
constexpr int KP = 144;
constexpr float LOG2E = 1.4426950408889634f, CSC = 0.125f * LOG2E, THR = 6.0f;
__device__ __forceinline__ int crow(int r, int hi) { return (r & 3) + 8 * (r >> 2) + 4 * hi; }

template <int MODE>
__device__ __forceinline__ void attn_unit(LAS unsigned char* lds, int h, int qb, const bf16_t* __restrict__ QK, const bf16_t* __restrict__ VT, const unsigned* __restrict__ BMP,
                                          const float* __restrict__ BT, const float* __restrict__ subw, float lam, bf16_t* __restrict__ OAB) {
    constexpr int DV = MODE ? 128 : 64, QB = MODE ? 128 : 256, NDT = DV / 32, NKT = MODE ? 2 : 1;
    constexpr int KBYTES = 64 * KP, VBYTES = DV * KP, BUFB = NKT * KBYTES + VBYTES;
    constexpr int OFF_BIAS = 2 * BUFB;
    const int tid = threadIdx.x, lane = tid & 63, wave = __builtin_amdgcn_readfirstlane(tid >> 6), ql = lane & 31, hi = lane >> 5;
    const int qw = MODE ? (wave & 3) : wave, map = MODE ? (wave >> 2) : 0;
    const int q0 = qb * QB, qw0 = q0 + 32 * qw, t = qw0 + ql;
    const int qcol = MODE ? C_BQ + (2 * h + map) * 64 : C_AQ + h * 64;
    const int kcol0 = MODE ? C_BK + (2 * h) * 64 : C_AK + h * 64;
    const int vrow0 = MODE ? 512 + h * 128 : h * 64;
    const int hb = MODE ? 8 + h : h;
    LAS float* bias2 = (LAS float*)(lds + OFF_BIAS);
    if (tid < 128) bias2[tid] = BT[tid * 12 + hb] * LOG2E;
    bf16x8 qf[4];
#pragma unroll
    for (int ks = 0; ks < 4; ++ks) qf[ks] = *(const bf16x8*)(QK + (size_t)t * NTOK + qcol + 16 * ks + 8 * hi);
    const int pr = tid >> 3, pc = tid & 7;
    u32x4 sk[NKT], sv[NKT];
    const int NT = (q0 + QB) / 64;
    auto gload = [&](int kt) {
        const int k0 = kt * 64;
#pragma unroll
        for (int i = 0; i < NKT; ++i) {
            sk[i] = *(const u32x4*)(QK + (size_t)(k0 + pr) * NTOK + kcol0 + i * 64 + pc * 8);
            sv[i] = *(const u32x4*)(VT + (size_t)(vrow0 + pr + 64 * i) * L + k0 + pc * 8);
        }
    };
    auto lstore = [&](int buf) {
        LAS unsigned char* b = lds + buf * BUFB;
#pragma unroll
        for (int i = 0; i < NKT; ++i) {
            *(LAS u32x4*)(b + i * KBYTES + pr * KP + pc * 16) = sk[i];
            *(LAS u32x4*)(b + NKT * KBYTES + (pr + 64 * i) * KP + pc * 16) = sv[i];
        }
    };
    f32x16 O[NDT];
#pragma unroll
    for (int d = 0; d < NDT; ++d)
#pragma unroll
        for (int r = 0; r < 16; ++r) O[d][r] = 0.f;
    float m_run = -INFINITY, l_run = 0.f;
    const int kperm = (ql & 0x13) | ((ql & 4) << 1) | ((ql & 8) >> 1);
    gload(0); lstore(0);
    __syncthreads();
    const float b31 = bias2[127];
    u32x2 mw = {0u, 0u};
    if (MODE == 0) mw = *(const u32x2*)(BMP + (size_t)t * 512);
    for (int kt = 0; kt < NT; ++kt) {
        const int cur = kt & 1, k0 = kt * 64;
        const bool more = kt + 1 < NT;
        if (more) gload(kt + 1);
        u32x2 mwn = {0u, 0u};
        if (MODE == 0 && more) mwn = *(const u32x2*)(BMP + (size_t)t * 512 + 2 * (kt + 1));
        if (k0 <= qw0 + 31) {
            const LAS unsigned char* kb = lds + cur * BUFB + (MODE ? map * KBYTES : 0);
            const LAS unsigned char* vb = lds + cur * BUFB + NKT * KBYTES;
            f32x16 S[2];
#pragma unroll
            for (int j = 0; j < 2; ++j) {
#pragma unroll
                for (int r = 0; r < 16; ++r) S[j][r] = 0.f;
#pragma unroll
                for (int ks = 0; ks < 4; ++ks) {
                    const bf16x8 kf = *(const LAS bf16x8*)(kb + (32 * j + kperm) * KP + (16 * ks + 8 * hi) * 2);
                    S[j] = __builtin_amdgcn_mfma_f32_32x32x16_bf16(kf, qf[ks], S[j], 0, 0, 0);
                }
            }
            const bool nearb = (qw0 - (k0 + 63)) < 113;
            float mx = -INFINITY;
            if (nearb) {
#pragma unroll
                for (int j = 0; j < 2; ++j)
#pragma unroll
                    for (int r = 0; r < 16; ++r) {
                        const int key = k0 + 32 * j + 16 * (r >> 3) + 8 * hi + (r & 7); const int dist = t - key;
                        const float bb = bias2[dist < 0 ? 0 : (dist > 127 ? 127 : dist)];
                        const float e = dist < 0 ? -INFINITY : fmaf(S[j][r], CSC, bb);
                        S[j][r] = e; mx = fmaxf(mx, e);
                    }
            } else {
#pragma unroll
                for (int j = 0; j < 2; ++j)
#pragma unroll
                    for (int r = 0; r < 16; ++r) mx = fmaxf(mx, S[j][r]);
                mx = fmaf(mx, CSC, b31);
            }
            mx = fmaxf(mx, __shfl_xor(mx, 32));
            const bool need = mx > m_run + THR;
            if (__any(need)) {
                const float m_new = need ? mx : m_run;
                const float alpha = (m_new == m_run) ? 1.f : exp2f(m_run - m_new);
                l_run *= alpha;
#pragma unroll
                for (int d = 0; d < NDT; ++d)
#pragma unroll
                    for (int r = 0; r < 16; ++r) O[d][r] *= alpha;
                m_run = m_new;
            }
            if (nearb) {
#pragma unroll
                for (int j = 0; j < 2; ++j)
#pragma unroll
                    for (int r = 0; r < 16; ++r) S[j][r] = exp2f(S[j][r] - m_run);
            } else {
                const float nb = b31 - m_run;
#pragma unroll
                for (int j = 0; j < 2; ++j)
#pragma unroll
                    for (int r = 0; r < 16; ++r) S[j][r] = exp2f(fmaf(S[j][r], CSC, nb));
            }
            if (MODE == 0) {
#pragma unroll
                for (int j = 0; j < 2; ++j) { const unsigned w = (j ? mw.y : mw.x) >> (8 * hi);
#pragma unroll
                    for (int r = 0; r < 16; ++r) S[j][r] = (w & (1u << (16 * (r >> 3) + (r & 7)))) ? S[j][r] : 0.f; }
            }
            float ls = 0.f;
#pragma unroll
            for (int j = 0; j < 2; ++j)
#pragma unroll
                for (int r = 0; r < 16; ++r) ls += S[j][r];
            l_run += ls;
            bf16x8 pb[4];
#pragma unroll
            for (int s = 0; s < 4; ++s) { const int j = s >> 1, o = 8 * (s & 1); u32x4 w;
                w.x = cvtpk(S[j][o + 0], S[j][o + 1]); w.y = cvtpk(S[j][o + 2], S[j][o + 3]); w.z = cvtpk(S[j][o + 4], S[j][o + 5]); w.w = cvtpk(S[j][o + 6], S[j][o + 7]);
                pb[s] = __builtin_bit_cast(bf16x8, w); }
#pragma unroll
            for (int d = 0; d < NDT; ++d)
#pragma unroll
                for (int s = 0; s < 4; ++s) {
                    const bf16x8 vf = *(const LAS bf16x8*)(vb + (32 * d + ql) * KP + (16 * s + 8 * hi) * 2);
                    O[d] = __builtin_amdgcn_mfma_f32_32x32x16_bf16(vf, pb[s], O[d], 0, 0, 0);
                }
        }
        if (more) lstore(cur ^ 1);
        mw = mwn;
        __syncthreads();
    }
    const float l_tot = l_run + __shfl_xor(l_run, 32);
    const float inv = 1.f / l_tot;
    if (MODE == 0) {
#pragma unroll
        for (int d = 0; d < NDT; ++d)
#pragma unroll
            for (int g = 0; g < 4; ++g) { u32x2 w; w.x = cvtpk(O[d][4 * g] * inv, O[d][4 * g + 1] * inv); w.y = cvtpk(O[d][4 * g + 2] * inv, O[d][4 * g + 3] * inv);
                *(u32x2*)(OAB + (size_t)t * 1024 + h * 64 + 32 * d + 8 * g + 4 * hi) = w; }
    } else {
        LAS float* X = (LAS float*)lds;
        if (map == 1) {
#pragma unroll
            for (int d = 0; d < NDT; ++d)
#pragma unroll
                for (int r = 0; r < 16; ++r) X[(d * 16 + r) * 256 + qw * 64 + lane] = O[d][r] * inv;
        }
        __syncthreads();
        if (map == 0) {
            float ss = 0.f;
#pragma unroll
            for (int d = 0; d < NDT; ++d)
#pragma unroll
                for (int r = 0; r < 16; ++r) { const float v = O[d][r] * inv - lam * X[(d * 16 + r) * 256 + qw * 64 + lane]; O[d][r] = v; ss += v * v; }
            ss += __shfl_xor(ss, 32);
            const float rn = rsqrtf(ss * (1.f / 128.f) + 1e-5f) * (1.f - LAM_INIT);
#pragma unroll
            for (int d = 0; d < NDT; ++d)
#pragma unroll
                for (int g = 0; g < 4; ++g) { const int e0 = 32 * d + 8 * g + 4 * hi; const float4 sw = *(const float4*)(subw + e0);
                    u32x2 w; w.x = cvtpk(O[d][4 * g] * rn * sw.x, O[d][4 * g + 1] * rn * sw.y); w.y = cvtpk(O[d][4 * g + 2] * rn * sw.z, O[d][4 * g + 3] * rn * sw.w);
                    *(u32x2*)(OAB + (size_t)t * 1024 + 512 + h * 128 + e0) = w; }
        }
        __syncthreads();
    }
}
}

namespace idx {
typedef short bf16x8 __attribute__((ext_vector_type(8)));
typedef float f32x4 __attribute__((ext_vector_type(4)));
constexpr int NQ = 16, CAP = 1200, TRIG = CAP - 256, NSL = 19;
constexpr int OFF_CNT = NQ * CAP * 8, OFF_TAU = OFF_CNT + 128, OFF_DUMP = OFF_TAU + 128, IDX_LDS = OFF_DUMP + 8 * 512;
__device__ __forceinline__ unsigned fkey(float f) { const unsigned u = __float_as_uint(f); return (u & 0x80000000u) ? ~u : (u | 0x80000000u); }
__device__ __forceinline__ float keyf(unsigned k) { return __uint_as_float((k & 0x80000000u) ? (k & 0x7fffffffu) : ~k); }
__device__ __forceinline__ int wave_count_ge(const unsigned (&kv)[NSL], unsigned cand) {
    int tot = 0;
#pragma unroll
    for (int i = 0; i < NSL; ++i) tot += __popcll(__ballot(kv[i] >= cand));
    return tot;
}
template <int NB> __device__ __forceinline__ unsigned kth_prefix(const unsigned (&kv)[NSL]) {
    unsigned prefix = 0u;
#pragma unroll 1
    for (int b = 31; b >= 32 - NB; --b) { const unsigned cand = prefix | (1u << b); if (wave_count_ge(kv, cand) >= 256) prefix = cand; }
    return prefix;
}
__device__ __forceinline__ void load_pool(const LAS u32x2* pool, int c, int lane, unsigned (&kv)[NSL], unsigned (&sb)[NSL], unsigned (&kk)[NSL]) {
#pragma unroll
    for (int i = 0; i < NSL; ++i) { const int s = lane + 64 * i; u32x2 e = {0u, 0u}; if (s < c) e = pool[s]; sb[i] = e.x; kk[i] = e.y; kv[i] = (s < c) ? fkey(__uint_as_float(e.x)) : 0u; }
}
__device__ __forceinline__ void prune(LAS unsigned char* lds, int q, int lane) {
    LAS u32x2* pool = (LAS u32x2*)(lds + q * CAP * 8); LAS unsigned* cnt = (LAS unsigned*)(lds + OFF_CNT); LAS float* tau = (LAS float*)(lds + OFF_TAU);
    int c = (int)cnt[q]; c = c > CAP ? CAP : c;
    unsigned kv[NSL], sb[NSL], kk[NSL];
    load_pool(pool, c, lane, kv, sb, kk);
    const unsigned prefix = kth_prefix<17>(kv);
    int base = 0;
#pragma unroll
    for (int i = 0; i < NSL; ++i) { const bool keep = kv[i] >= prefix && prefix != 0u; const unsigned long long m = __ballot(keep);
        const int pos = base + __builtin_amdgcn_mbcnt_hi((unsigned)(m >> 32), __builtin_amdgcn_mbcnt_lo((unsigned)m, 0u));
        if (keep) pool[pos] = (u32x2){sb[i], kk[i]};
        base += __popcll(m); }
    if (lane == 0) { cnt[q] = (unsigned)base; tau[q] = keyf(prefix); }
}
__device__ __forceinline__ void finalize(LAS unsigned char* lds, int q, int lane, unsigned* __restrict__ bmp_row) {
    LAS u32x2* pool = (LAS u32x2*)(lds + q * CAP * 8); LAS unsigned* cnt = (LAS unsigned*)(lds + OFF_CNT);
    int c = (int)cnt[q]; c = c > CAP ? CAP : c;
    unsigned kv[NSL], sb[NSL], kk[NSL];
    load_pool(pool, c, lane, kv, sb, kk);
    unsigned prefix = 0u; int need = 1 << 20;
    if (c > 256) { prefix = kth_prefix<32>(kv); int gt = 0;
#pragma unroll
        for (int i = 0; i < NSL; ++i) gt += __popcll(__ballot(kv[i] > prefix));
        need = 256 - gt; }
    LAS unsigned* row = (LAS unsigned*)pool;
    *(LAS u32x4*)(row + 8 * lane) = (u32x4){0u, 0u, 0u, 0u}; *(LAS u32x4*)(row + 8 * lane + 4) = (u32x4){0u, 0u, 0u, 0u};
    int base = 0;
#pragma unroll
    for (int i = 0; i < NSL; ++i) { const bool valid = (lane + 64 * i) < c; bool sel = valid && kv[i] > prefix; const bool tie = valid && kv[i] == prefix;
        const unsigned long long m = __ballot(tie);
        const int rank = base + __builtin_amdgcn_mbcnt_hi((unsigned)(m >> 32), __builtin_amdgcn_mbcnt_lo((unsigned)m, 0u));
        if (tie && rank < need) sel = true;
        base += __popcll(m);
        if (sel) __hip_atomic_fetch_or(row + (kk[i] >> 5), 1u << (kk[i] & 31), __ATOMIC_RELAXED, __HIP_MEMORY_SCOPE_WORKGROUP); }
    const u32x4 w0 = *(LAS u32x4*)(row + 8 * lane), w1 = *(LAS u32x4*)(row + 8 * lane + 4);
    *(u32x4*)(bmp_row + 8 * lane) = w0; *(u32x4*)(bmp_row + 8 * lane + 4) = w1;
}

__device__ __forceinline__ void index_unit(LAS unsigned char* lds, int qblk, const bf16_t* __restrict__ QK, unsigned* __restrict__ BMP) {
    const int tid = threadIdx.x, lane = tid & 63, wave = __builtin_amdgcn_readfirstlane(tid >> 6), qc = lane & 15, g = lane >> 4;
    const int t = qblk * NQ + qc, NTL = (qblk + 2) >> 1;
    LAS unsigned* cnt = (LAS unsigned*)(lds + OFF_CNT); LAS float* tau = (LAS float*)(lds + OFF_TAU);
    if (tid < NQ) { cnt[tid] = 0u; tau[tid] = -INFINITY; }
    bf16x8 qf[8][2]; float wq[8];
#pragma unroll
    for (int h = 0; h < 8; ++h) {
        wq[h] = bf2f(QK[(size_t)t * NTOK + C_IW + h]) * (0.35355339059327373f * 0.125f);
#pragma unroll
        for (int ks = 0; ks < 2; ++ks) qf[h][ks] = *(const bf16x8*)(QK + (size_t)t * NTOK + C_IQ + h * 64 + 32 * ks + 8 * g);
    }
    const unsigned dump_a = (unsigned)(size_t)(lds + OFF_DUMP + wave * 512 + lane * 8), pool_a = (unsigned)(size_t)(lds + qc * CAP * 8);
    __syncthreads();
    const int nrounds = (NTL + 7) >> 3;
    bf16x8 kf[2][2];
    { const int kt0 = wave < NTL ? wave : 0;
#pragma unroll
      for (int i = 0; i < 2; ++i)
#pragma unroll
          for (int ks = 0; ks < 2; ++ks) kf[i][ks] = *(const bf16x8*)(QK + (size_t)(kt0 * 32 + 16 * i + qc) * NTOK + C_IK + 32 * ks + 8 * g); }
    for (int rd = 0; rd < nrounds; ++rd) {
        const int kt = rd * 8 + wave;
        if (kt < NTL) {
            const int k0 = kt * 32;
            const float tau_l = tau[qc];
            f32x4 sc[2];
#pragma unroll
            for (int i = 0; i < 2; ++i) {
                sc[i] = (f32x4){0.f, 0.f, 0.f, 0.f};
#pragma unroll
                for (int h = 0; h < 8; ++h) {
                    f32x4 acc = {0.f, 0.f, 0.f, 0.f};
                    acc = __builtin_amdgcn_mfma_f32_16x16x32_bf16(kf[i][0], qf[h][0], acc, 0, 0, 0);
                    acc = __builtin_amdgcn_mfma_f32_16x16x32_bf16(kf[i][1], qf[h][1], acc, 0, 0, 0);
#pragma unroll
                    for (int r = 0; r < 4; ++r) sc[i][r] = fmaf(wq[h], fmaxf(acc[r], 0.f), sc[i][r]);
                }
            }
            { const int ktn = (kt + 8 < NTL) ? kt + 8 : kt;
#pragma unroll
              for (int i = 0; i < 2; ++i)
#pragma unroll
                  for (int ks = 0; ks < 2; ++ks) kf[i][ks] = *(const bf16x8*)(QK + (size_t)(ktn * 32 + 16 * i + qc) * NTOK + C_IK + 32 * ks + 8 * g); }
            const int klim = (kt == NTL - 1) ? t : 0x7fffffff;
            int n = 0;
#pragma unroll
            for (int i = 0; i < 2; ++i)
#pragma unroll
                for (int r = 0; r < 4; ++r) { const int key = k0 + 16 * i + 4 * g + r; n += (sc[i][r] >= tau_l && key <= klim) ? 1 : 0; }
            int slot = 0;
            if (n > 0) slot = (int)__hip_atomic_fetch_add(cnt + qc, (unsigned)n, __ATOMIC_RELAXED, __HIP_MEMORY_SCOPE_WORKGROUP);
#pragma unroll
            for (int i = 0; i < 2; ++i)
#pragma unroll
                for (int r = 0; r < 4; ++r) { const int key = k0 + 16 * i + 4 * g + r; const bool pass = sc[i][r] >= tau_l && key <= klim; const bool ok = pass && slot < CAP;
                    const unsigned addr = ok ? pool_a + (unsigned)slot * 8u : dump_a;
                    *(LAS u32x2*)(size_t)addr = (u32x2){__float_as_uint(sc[i][r]), (unsigned)key};
                    slot += pass ? 1 : 0; }
        }
        __syncthreads();
        const bool over = cnt[qc] > (unsigned)TRIG;
        if (__any(over)) {
#pragma unroll 1
            for (int i = 0; i < 2; ++i) { const int q = wave * 2 + i; if (cnt[q] > (unsigned)TRIG) prune(lds, q, lane); }
            __syncthreads();
        }
    }
#pragma unroll 1
    for (int i = 0; i < 2; ++i) { const int q = wave * 2 + i; finalize(lds, q, lane, BMP + (size_t)(qblk * NQ + q) * 512); }
    __syncthreads();
}
}

constexpr int NWAVES = 8, NTHREADS = 512;
constexpr int LDS_BYTES = 163840;
enum Phase { PH_PRO = 0, PH_G1 = 1, PH_IDX = 2, PH_ATB = 3, PH_ATA = 4, PH_T1 = 5, PH_T2 = 6, PH_T3 = 7, PH_T4 = 8, PH_T5 = 9, PH_N = 10 };

struct Args {
    const float* x; const float* p; const float* w_in; const float* w_pa; const float* w_pb; const float* w_o; const float* lqk; const float* subw;
    const float* ln_g; const float* ln_b; const float* w_ple; const float* w_gate; const float* rel_bias;
    float* out; unsigned char* ws; int ph_lo, ph_hi;
};

template <int MODE>
__device__ __forceinline__ void p0_transpose_item(const float* __restrict__ W, int K, int ld, int N, bf16_t* __restrict__ WT, LAS float* scr, int item, int lane) {
    const int nblk = N / 32, kb = item / nblk, nb = item % nblk, k0 = 64 * kb, n0 = 32 * nb;
    const int n = n0 + (lane & 31); const int c = MODE == 0 ? n : win_src_col(n);
#pragma unroll 8
    for (int i = 0; i < 32; ++i) { const int kk = 2 * i + (lane >> 5); scr[kk * 33 + (lane & 31)] = (c >= 0) ? W[(size_t)(k0 + kk) * ld + c] : 0.f; }
    asm volatile("s_waitcnt lgkmcnt(0)" ::: "memory");
    const int cc = lane & 7;
#pragma unroll
    for (int j = 0; j < 4; ++j) { const int nn = (lane >> 3) + 8 * j; const LAS float* s = scr + (8 * cc) * 33 + nn;
        u32x4 o; o.x = f2bf(s[0 * 33]) | ((unsigned)f2bf(s[1 * 33]) << 16); o.y = f2bf(s[2 * 33]) | ((unsigned)f2bf(s[3 * 33]) << 16);
        o.z = f2bf(s[4 * 33]) | ((unsigned)f2bf(s[5 * 33]) << 16); o.w = f2bf(s[6 * 33]) | ((unsigned)f2bf(s[7 * 33]) << 16);
        *(u32x4*)(WT + (size_t)(n0 + nn) * K + k0 + 8 * cc) = o; }
    asm volatile("s_waitcnt lgkmcnt(0)" ::: "memory");
}
__device__ __forceinline__ void cvt_rows(const float* __restrict__ src, bf16_t* __restrict__ dst, size_t n4, size_t gtid, size_t gthreads) {
    for (size_t i = gtid; i < n4; i += gthreads) { const float4 v = ((const float4*)src)[i]; u32x2 o; o.x = f2bf(v.x) | ((unsigned)f2bf(v.y) << 16); o.y = f2bf(v.z) | ((unsigned)f2bf(v.w) << 16); ((u32x2*)dst)[i] = o; }
}
__device__ __forceinline__ void ln_row(float* __restrict__ io, const float* __restrict__ g, const float* __restrict__ b, bf16_t* __restrict__ xln, int lane) {
    float4* r = (float4*)io + lane; float4 v[4]; float s = 0.f;
#pragma unroll
    for (int j = 0; j < 4; ++j) { v[j] = r[64 * j]; s += (v[j].x + v[j].y) + (v[j].z + v[j].w); }
#pragma unroll
    for (int o = 1; o < 64; o <<= 1) s += __shfl_xor(s, o);
    const float mean = s * (1.f / 1024.f); float q = 0.f;
#pragma unroll
    for (int j = 0; j < 4; ++j) { v[j].x -= mean; v[j].y -= mean; v[j].z -= mean; v[j].w -= mean; q += (v[j].x * v[j].x + v[j].y * v[j].y) + (v[j].z * v[j].z + v[j].w * v[j].w); }
#pragma unroll
    for (int o = 1; o < 64; o <<= 1) q += __shfl_xor(q, o);
    const float rstd = rsqrtf(q * (1.f / 1024.f) + 1e-5f);
#pragma unroll
    for (int j = 0; j < 4; ++j) {
        const float4 gg = ((const float4*)g)[lane + 64 * j], bb = ((const float4*)b)[lane + 64 * j];
        float4 o; o.x = v[j].x * rstd * gg.x + bb.x; o.y = v[j].y * rstd * gg.y + bb.y; o.z = v[j].z * rstd * gg.z + bb.z; o.w = v[j].w * rstd * gg.w + bb.w;
        r[64 * j] = o; u32x2 w; w.x = f2bf(o.x) | ((unsigned)f2bf(o.y) << 16); w.y = f2bf(o.z) | ((unsigned)f2bf(o.w) << 16);
        ((u32x2*)xln)[lane + 64 * j] = w;
    }
}

__global__ void __launch_bounds__(NTHREADS, 2) mega(Args a) {
    extern __shared__ __attribute__((aligned(16))) unsigned char lds_raw[];
    LAS unsigned char* lds = (LAS unsigned char*)lds_raw;
    const int tid = threadIdx.x, lane = tid & 63, wave = __builtin_amdgcn_readfirstlane(tid >> 6);
    const int G = gridDim.x, bx = blockIdx.x;
    unsigned char* ws = a.ws;
    bf16_t* WIN = (bf16_t*)(ws + WS_WIN); bf16_t* WPA = (bf16_t*)(ws + WS_WPA); bf16_t* WPB = (bf16_t*)(ws + WS_WPB); bf16_t* WO = (bf16_t*)(ws + WS_WO);
    bf16_t* WGT = (bf16_t*)(ws + WS_WGT); bf16_t* WPLE = (bf16_t*)(ws + WS_WPLE); bf16_t* XBF = (bf16_t*)(ws + WS_XBF); bf16_t* PBF = (bf16_t*)(ws + WS_PBF);
    bf16_t* QK = (bf16_t*)(ws + WS_QK); bf16_t* VT = (bf16_t*)(ws + WS_VT); bf16_t* OAB = (bf16_t*)(ws + WS_OAB);
    bf16_t* PLEO = (bf16_t*)(ws + WS_PLEO); bf16_t* Gb = (bf16_t*)(ws + WS_G); bf16_t* MRG = (bf16_t*)(ws + WS_MRG); bf16_t* XLN = (bf16_t*)(ws + WS_XLN);
    float* BT = (float*)(ws + WS_BT);
    const int lo = a.ph_lo, hi = a.ph_hi;
#define IN(k) (lo <= (k) && (k) < hi)
#define SEAM(k) do { if (IN(k) && IN((k) + 1)) cooperative_groups::this_grid().sync(); } while (0)

    if (IN(PH_PRO)) {
        LAS float* scr = (LAS float*)(lds + wave * 16384);
        const int gw = bx * NWAVES + wave, NGW = G * NWAVES;
        constexpr int I_IN = (WT_ROWS / 32) * (1024 / 64), I_PA = 32 * 8, I_O = 32 * 16, I_PLE = 32 * 4;
        constexpr int NITEMS = I_IN + 2 * I_PA + 2 * I_O + I_PLE;
        for (int it = gw; it < NITEMS; it += NGW) {
            int r = it;
            if (r < I_IN) { p0_transpose_item<1>(a.w_in, 1024, IN_COLS, WT_ROWS, WIN, scr, r, lane); continue; } r -= I_IN;
            if (r < I_PA) { p0_transpose_item<0>(a.w_pa, 512, 1024, 1024, WPA, scr, r, lane); continue; } r -= I_PA;
            if (r < I_PA) { p0_transpose_item<0>(a.w_pb, 512, 1024, 1024, WPB, scr, r, lane); continue; } r -= I_PA;
            if (r < I_O) { p0_transpose_item<0>(a.w_o, 1024, 1024, 1024, WO, scr, r, lane); continue; } r -= I_O;
            if (r < I_O) { p0_transpose_item<0>(a.w_gate, 1024, 1024, 1024, WGT, scr, r, lane); continue; } r -= I_O;
            p0_transpose_item<0>(a.w_ple, 256, 1024, 1024, WPLE, scr, r, lane);
        }
        const size_t gtid = (size_t)bx * NTHREADS + tid, gth = (size_t)G * NTHREADS;
        cvt_rows(a.x, XBF, (size_t)L * 1024 / 4, gtid, gth);
        cvt_rows(a.p, PBF, (size_t)L * 256 / 4, gtid, gth);
        if (gtid < 128 * 12) { const int n = (int)gtid / 12, h = (int)gtid % 12; BT[gtid] = a.rel_bias[rel_bucket(n) * 12 + h]; }
    }
    SEAM(PH_PRO);
    if (IN(PH_G1)) {
        { pg8::Gemm g{XBF, WIN + (size_t)WT_TOK * 1024, L, NTOK, 1024, 1024, 1024}; pg8::StaticOrder S; S.init(L, NTOK, G, bx);
          pg8::EpiStoreBf E{QK, NTOK, 0}; pg8::gemm_phase<pg8::EpiStoreBf, pg8::StaticOrder, true, true>(lds, g, S, E); }
        { pg8::Gemm g{WIN + (size_t)WT_VT * 1024, XBF, 1024, L, 1024, 1024, 1024}; pg8::StaticOrder S; S.init(1024, L, G, bx);
          pg8::EpiStoreBf E{VT, L, 0}; pg8::gemm_phase<pg8::EpiStoreBf, pg8::StaticOrder, true, true>(lds, g, S, E); }
    }
    SEAM(PH_G1);
    if (IN(PH_IDX)) {
        unsigned* BMPw = (unsigned*)(ws + WS_BMP);
        for (int p = bx; p < 512; p += G) { idx::index_unit(lds, 1023 - p, QK, BMPw); idx::index_unit(lds, p, QK, BMPw); }
    }
    if (IN(PH_ATB) || IN(PH_ATA)) {
        const int vcu = (G % 8 == 0) ? (bx % 8) * (G / 8) + bx / 8 : bx;
        const unsigned* BMP = (const unsigned*)(ws + WS_BMP);
        if (IN(PH_ATB)) {
            float la = a.lqk[lane] * a.lqk[64 + lane], lb = a.lqk[128 + lane] * a.lqk[192 + lane];
#pragma unroll
            for (int o = 1; o < 64; o <<= 1) { la += __shfl_xor(la, o); lb += __shfl_xor(lb, o); }
            const float lam = __expf(la) - __expf(lb) + LAM_INIT;
            for (int p = vcu; p < 256; p += G) { const int h = p >> 6, xq = p & 63;
                att::attn_unit<1>(lds, h, 127 - xq, QK, VT, BMP, BT, a.subw, lam, OAB);
                att::attn_unit<1>(lds, h, xq, QK, VT, BMP, BT, a.subw, lam, OAB); }
        }
        SEAM(PH_ATB);
        if (IN(PH_ATA)) {
            for (int p = vcu; p < 256; p += G) { const int h = p >> 5, xq = p & 31;
                att::attn_unit<0>(lds, h, 63 - xq, QK, VT, BMP, BT, a.subw, 0.f, OAB);
                att::attn_unit<0>(lds, h, xq, QK, VT, BMP, BT, a.subw, 0.f, OAB); }
        }
    }
    SEAM(PH_ATA);
    if (IN(PH_T1)) {
        { pg8::Gemm g{XBF, WIN + (size_t)WT_Z * 1024, L, 1024, 1024, 1024, 1024}; pg8::StaticOrder S; S.init(L, 1024, G, bx);
          pg8::EpiZ E{OAB}; pg8::gemm_phase<pg8::EpiZ, pg8::StaticOrder, true, true>(lds, g, S, E); }
        { pg8::Gemm g{XBF, WIN + (size_t)WT_G * 1024, L, 2048, 1024, 1024, 1024}; pg8::StaticOrder S; S.init(L, 2048, G, bx);
          pg8::EpiG E{Gb}; pg8::gemm_phase<pg8::EpiG, pg8::StaticOrder, true, true>(lds, g, S, E); }
    }
    SEAM(PH_T1);
    if (IN(PH_T2)) {
        { pg8::Gemm g{OAB, WPA, L, 1024, 512, 1024, 512}; pg8::StaticOrder S; S.init(L, 1024, G, bx);
          pg8::EpiPA E{Gb, MRG}; pg8::gemm_phase<pg8::EpiPA, pg8::StaticOrder, true, true>(lds, g, S, E); }
        { pg8::Gemm g{OAB + 512, WPB, L, 1024, 512, 1024, 512}; pg8::StaticOrder S; S.init(L, 1024, G, bx);
          pg8::EpiPB E{Gb, MRG}; pg8::gemm_phase<pg8::EpiPB, pg8::StaticOrder, true, true>(lds, g, S, E); }
        { pg8::Gemm g{PBF, WPLE, L, 1024, 256, 256, 256}; pg8::StaticOrder S; S.init(L, 1024, G, bx);
          pg8::EpiStoreBf E{PLEO, 1024, 0}; pg8::gemm_phase<pg8::EpiStoreBf, pg8::StaticOrder, true, true>(lds, g, S, E); }
    }
    SEAM(PH_T2);
    if (IN(PH_T3)) {
        pg8::Gemm g{MRG, WO, L, 1024, 1024, 1024, 1024}; pg8::StaticOrder S; S.init(L, 1024, G, bx);
        pg8::EpiO E{a.x, a.out}; pg8::gemm_phase<pg8::EpiO, pg8::StaticOrder, true, true>(lds, g, S, E);
    }
    SEAM(PH_T3);
    if (IN(PH_T4)) {
        const int gw = bx * NWAVES + wave, NGW = G * NWAVES;
        for (int m = gw; m < L; m += NGW) ln_row(a.out + (size_t)m * 1024, a.ln_g, a.ln_b, XLN + (size_t)m * 1024, lane);
    }
    SEAM(PH_T4);
    if (IN(PH_T5)) {
        pg8::Gemm g{XLN, WGT, L, 1024, 1024, 1024, 1024}; pg8::StaticOrder S; S.init(L, 1024, G, bx);
        pg8::EpiGate E{a.out, PLEO}; pg8::gemm_phase<pg8::EpiGate, pg8::StaticOrder, true, true>(lds, g, S, E);
    }
#undef IN
#undef SEAM
}

extern "C" void kernel_launch(void* const* d_in, const int* in_sizes, int n_in, void* d_out, int out_size, void* d_ws, size_t ws_size, hipStream_t stream) {
    static int grid = 0;
    if (grid == 0) {
        if (ws_size < WS_END) { fprintf(stderr, "workspace too small: %zu\n", ws_size); grid = -1; return; }
        (void)hipFuncSetAttribute((const void*)mega, hipFuncAttributeMaxDynamicSharedMemorySize, LDS_BYTES);
        int dev = 0, cus = 0, per_cu = 0; (void)hipGetDevice(&dev); (void)hipDeviceGetAttribute(&cus, hipDeviceAttributeMultiprocessorCount, dev);
        (void)hipOccupancyMaxActiveBlocksPerMultiprocessor(&per_cu, (const void*)mega, NTHREADS, LDS_BYTES);
        if (per_cu < 1) fprintf(stderr, "kernel_launch: occupancy query reports %d workgroups per CU\n", per_cu);
        grid = cus > 0 ? cus : 256;
    }
    if (grid < 0) return;
    Args a{};
    a.x = (const float*)d_in[0]; a.p = (const float*)d_in[1]; a.w_in = (const float*)d_in[2]; a.w_pa = (const float*)d_in[3]; a.w_pb = (const float*)d_in[4]; a.w_o = (const float*)d_in[5];
    a.lqk = (const float*)d_in[6]; a.subw = (const float*)d_in[7]; a.ln_g = (const float*)d_in[8]; a.ln_b = (const float*)d_in[9];
    a.w_ple = (const float*)d_in[10]; a.w_gate = (const float*)d_in[11]; a.rel_bias = (const float*)d_in[12];
    a.out = (float*)d_out; a.ws = (unsigned char*)d_ws; a.ph_lo = 0; a.ph_hi = PH_N;
    void* args[] = {&a};
    const hipError_t e = hipLaunchCooperativeKernel((const void*)mega, dim3(grid), dim3(NTHREADS), args, LDS_BYTES, stream);
    if (e != hipSuccess) fprintf(stderr, "cooperative launch failed: %s (grid %d)\n", hipGetErrorString(e), grid);
}
```

```cpp
#include <hip/hip_runtime.h>
#include <hip/hip_cooperative_groups.h>
#include <cstdint>
#include <cstdio>

typedef unsigned short bf16_t;
typedef unsigned u32x4 __attribute__((ext_vector_type(4)));
typedef unsigned u32x2 __attribute__((ext_vector_type(2)));

constexpr int L = 16384, DM = 1024, PLE = 256;
constexpr int IN_COLS = 6728;
constexpr int NTOK = 2816;
constexpr int C_AQ = 0, C_AK = 512, C_BQ = 1024, C_BK = 1536, C_IQ = 2048, C_IK = 2560, C_IW = 2624;
constexpr int WT_TOK = 0, WT_VT = 2816, WT_Z = 3840, WT_G = 4864, WT_ROWS = 6912;
constexpr float ALPHA = 1.18920711500272f;
constexpr float LAM_INIT = 0.2f;

constexpr size_t MiB = 1u << 20;
constexpr size_t WS_CTL = 0;
constexpr size_t WS_BT = 512 * 1024;
constexpr size_t WS_WIN = 1 * MiB;
constexpr size_t WS_WPA = 15 * MiB;
constexpr size_t WS_WPB = 16 * MiB;
constexpr size_t WS_WO = 17 * MiB;
constexpr size_t WS_WGT = 19 * MiB;
constexpr size_t WS_WPLE = 21 * MiB;
constexpr size_t WS_XBF = 22 * MiB;
constexpr size_t WS_PBF = 54 * MiB;
constexpr size_t WS_QK = 62 * MiB;
constexpr size_t WS_VT = 154 * MiB;
constexpr size_t WS_BMP = 186 * MiB;
constexpr size_t WS_OAB = 218 * MiB;
constexpr size_t WS_END = 250 * MiB;
constexpr size_t WS_PLEO = WS_XBF, WS_G = WS_QK, WS_MRG = WS_VT, WS_XLN = WS_BMP;

__device__ __forceinline__ float bf2f(bf16_t v) { return __uint_as_float(((unsigned)v) << 16); }
__device__ __forceinline__ bf16_t f2bf(float f) { unsigned u = __float_as_uint(f); return (bf16_t)((u + 0x7fffu + ((u >> 16) & 1u)) >> 16); }
__device__ __forceinline__ float sigmoidf_(float v) { return 1.f / (1.f + __expf(-v)); }
__device__ __forceinline__ float siluf_(float v) { return v / (1.f + __expf(-v)); }

__host__ __device__ __forceinline__ int win_src_col(int n) {
    if (n < WT_VT) {
        if (n < 512) return n;
        if (n < 1024) return n;
        if (n < 1536) return 2632 + (n - 1024);
        if (n < 2048) return 3144 + (n - 1536);
        if (n < 2560) return 2048 + (n - 2048);
        if (n < 2624) return 2560 + (n - 2560);
        if (n < 2632) return 2624 + (n - 2624);
        return -1;
    }
    if (n < WT_Z) { int r = n - WT_VT; return r < 512 ? 1024 + r : 3656 + (r - 512); }
    if (n < WT_G) { int r = n - WT_Z; return r < 512 ? 1536 + r : 4168 + (r - 512); }
    return 4680 + (n - WT_G);
}

__device__ __forceinline__ int rel_bucket(int n) {
    if (n < 16) return n;
    int b = 16 + (int)(logf((float)n / 16.f) / logf(8.f) * 16.f);
    return b > 31 ? 31 : b;
}
namespace pg8 {
#define PG8_LAS __attribute__((address_space(3)))
typedef unsigned short bf16_t;
typedef short bf16x8 __attribute__((ext_vector_type(8)));
typedef float f32x4 __attribute__((ext_vector_type(4)));
typedef unsigned u32x4 __attribute__((ext_vector_type(4)));
constexpr int BM = 256, BK = 64, HALF = 128, HTB = HALF * BK * 2  , STAGE_BYTES = 8 * HTB, NXCD = 8, WGM = 8;

__host__ __device__ __forceinline__ int lds_byte(int r, int c) { const int st = (r >> 4) * 2 + (c >> 5), rr = r & 15, cc = c & 31, ob = rr * 64 + cc * 2; return st * 1024 + (ob ^ (((ob >> 9) & 1) << 5)); }
__host__ __device__ __forceinline__ void stage_rc(int b, int& R, int& C) { const int st = b / 1024, sb = b % 1024, swz = sb ^ (((sb >> 9) & 1) << 5); R = (st >> 1) * 16 + swz / 64; C = (st & 1) * 32 + (swz % 64) / 2; }
__host__ __device__ __forceinline__ int perm32(int rho) { const int n = rho >> 4, i = rho & 15; return 8 * (i >> 2) + 4 * n + (i & 3); }

struct Unit { int pm, pn; };
struct Gemm { const bf16_t* A; const bf16_t* Bt; int M, N, K, lda, ldb; };

struct StaticOrder {
    int nM, nN, nwg, G, c;
    __host__ __device__ void init(int M, int N, int G_, int c_) { nM = M / BM; nN = N / BM; nwg = nM * nN; G = G_; c = c_; }
    __host__ __device__ bool next(int i, Unit& u) const {
        const long L = (long)i * G + c; if (L >= nwg) return false;
        int wgid = (int)L; { const int q = nwg / NXCD, r = nwg % NXCD, xcd = wgid % NXCD, off = wgid / NXCD; wgid = (xcd < r ? xcd * (q + 1) : r * (q + 1) + (xcd - r) * q) + off; }
        const int nig = WGM * nN, gid = wgid / nig, fm = gid * WGM, gsz = (nM - fm) < WGM ? (nM - fm) : WGM;
        u.pm = fm + ((wgid % nig) % gsz); u.pn = (wgid % nig) / gsz; return true;
    }
    __device__ __forceinline__ void a_ready(const Unit&) const {}
    __device__ __forceinline__ void done(const Unit&) const {}
};


typedef float f32x2_t __attribute__((ext_vector_type(2))); typedef __bf16 bf16x2_t __attribute__((ext_vector_type(2)));
__device__ __forceinline__ unsigned cvt_pk_bf16(float lo, float hi) { f32x2_t v = {lo, hi}; bf16x2_t b = __builtin_convertvector(v, bf16x2_t); return __builtin_bit_cast(unsigned, b); }
__device__ __forceinline__ u32x4 pack8(const f32x4 a, const f32x4 b) { u32x4 w; w.x = cvt_pk_bf16(a[0], a[1]); w.y = cvt_pk_bf16(a[2], a[3]); w.z = cvt_pk_bf16(b[0], b[1]); w.w = cvt_pk_bf16(b[2], b[3]); return w; }
__device__ __forceinline__ void unpack8(const u32x4 w, f32x4& a, f32x4& b) {
    a[0] = __uint_as_float(w.x << 16); a[1] = __uint_as_float(w.x & 0xffff0000u); a[2] = __uint_as_float(w.y << 16); a[3] = __uint_as_float(w.y & 0xffff0000u);
    b[0] = __uint_as_float(w.z << 16); b[1] = __uint_as_float(w.z & 0xffff0000u); b[2] = __uint_as_float(w.w << 16); b[3] = __uint_as_float(w.w & 0xffff0000u); }
__device__ __forceinline__ float fsig(float v) { return __builtin_amdgcn_rcpf(1.f + __expf(-v)); }
__device__ __forceinline__ f32x4 sig4(const f32x4 v) { f32x4 r; r[0] = fsig(v[0]); r[1] = fsig(v[1]); r[2] = fsig(v[2]); r[3] = fsig(v[3]); return r; }
#define PG8_EPI_LOOP(...) \
    _Pragma("unroll") for (int ai = 0; ai < 2; ++ai) _Pragma("unroll") for (int m = 0; m < 4; ++m) { const size_t row = (size_t)(u.pm * BM + ai * HALF + wr * 64 + m * 16 + fr); \
    _Pragma("unroll") for (int bj = 0; bj < 2; ++bj) { const int col = u.pn * BM + bj * HALF + wc * 32 + 8 * fq; f32x4 v0 = acc[ai][bj][m][0], v1 = acc[ai][bj][m][1]; __VA_ARGS__ } }
#define PG8_EPI_SIG const f32x4 (&acc)[2][2][4][2], const Unit& u, int wr, int wc, int fr, int fq
struct EpiStoreBf { static constexpr bool PERM = true, AFTER_DRAIN = false; bf16_t* O; int ldc, pad;
    __device__ __forceinline__ void operator()(PG8_EPI_SIG) const { PG8_EPI_LOOP( *(u32x4*)(O + row * ldc + col) = pack8(v0, v1); ) } };
struct EpiVTdual { static constexpr bool PERM = true, AFTER_DRAIN = false; bf16_t* VT; bf16_t* VTOK;
    __device__ __forceinline__ void operator()(PG8_EPI_SIG) const { PG8_EPI_LOOP( const u32x4 w = pack8(v0, v1); *(u32x4*)(VT + row * 16384 + col) = w;
        if (VTOK) { VTOK[(size_t)(col + 0) * 1024 + row] = (bf16_t)(w.x & 0xffff); VTOK[(size_t)(col + 1) * 1024 + row] = (bf16_t)(w.x >> 16); VTOK[(size_t)(col + 2) * 1024 + row] = (bf16_t)(w.y & 0xffff); VTOK[(size_t)(col + 3) * 1024 + row] = (bf16_t)(w.y >> 16);
                    VTOK[(size_t)(col + 4) * 1024 + row] = (bf16_t)(w.z & 0xffff); VTOK[(size_t)(col + 5) * 1024 + row] = (bf16_t)(w.z >> 16); VTOK[(size_t)(col + 6) * 1024 + row] = (bf16_t)(w.w & 0xffff); VTOK[(size_t)(col + 7) * 1024 + row] = (bf16_t)(w.w >> 16); } ) } };
struct EpiZ { static constexpr bool PERM = true, AFTER_DRAIN = false; bf16_t* OAB;
    __device__ __forceinline__ void operator()(PG8_EPI_SIG) const { PG8_EPI_LOOP( u32x4* p = (u32x4*)(OAB + row * 1024 + col); f32x4 o0, o1; unpack8(*p, o0, o1);
        *p = pack8(v0 * sig4(v0) * o0, v1 * sig4(v1) * o1); ) } };
struct EpiG { static constexpr bool PERM = true, AFTER_DRAIN = false; bf16_t* G;
    __device__ __forceinline__ void operator()(PG8_EPI_SIG) const { PG8_EPI_LOOP( *(u32x4*)(G + row * 2048 + col) = pack8(sig4(v0), sig4(v1)); ) } };
struct EpiPA { static constexpr bool PERM = true, AFTER_DRAIN = false; const bf16_t* G; bf16_t* MRG;
    __device__ __forceinline__ void operator()(PG8_EPI_SIG) const { PG8_EPI_LOOP( f32x4 g0, g1; unpack8(*(const u32x4*)(G + row * 2048 + col), g0, g1);
        *(u32x4*)(MRG + row * 1024 + col) = pack8(g0 * v0, g1 * v1); ) } };
struct EpiPB { static constexpr bool PERM = true, AFTER_DRAIN = false; const bf16_t* G; bf16_t* MRG;
    __device__ __forceinline__ void operator()(PG8_EPI_SIG) const { PG8_EPI_LOOP( f32x4 g0, g1, m0, m1; unpack8(*(const u32x4*)(G + row * 2048 + 1024 + col), g0, g1);
        u32x4* p = (u32x4*)(MRG + row * 1024 + col); unpack8(*p, m0, m1); *p = pack8(m0 + g0 * v0, m1 + g1 * v1); ) } };
struct EpiO { static constexpr bool PERM = true, AFTER_DRAIN = false; const float* x; float* PRE;
    __device__ __forceinline__ void operator()(PG8_EPI_SIG) const { PG8_EPI_LOOP( const f32x4 x0 = *(const f32x4*)(x + row * 1024 + col), x1 = *(const f32x4*)(x + row * 1024 + col + 4);
        *(f32x4*)(PRE + row * 1024 + col) = x0 * 1.18920711500272f + v0; *(f32x4*)(PRE + row * 1024 + col + 4) = x1 * 1.18920711500272f + v1; ) } };
struct EpiGate { static constexpr bool PERM = true, AFTER_DRAIN = false; float* out; const bf16_t* PLEO;
    __device__ __forceinline__ void operator()(PG8_EPI_SIG) const { PG8_EPI_LOOP( f32x4 p0, p1; unpack8(*(const u32x4*)(PLEO + row * 1024 + col), p0, p1);
        f32x4* o = (f32x4*)(out + row * 1024 + col); const f32x4 a0 = o[0], a1 = o[1]; o[0] = a0 + sig4(v0) * p0; o[1] = a1 + sig4(v1) * p1; ) } };

template <class Epi, class Sched, bool ALIGN_EPI = false, bool SP2 = false>
__device__ __forceinline__ void gemm_phase(PG8_LAS unsigned char* lds, const Gemm g, const Sched& S, const Epi& E) {
    const int tid = threadIdx.x, wid = __builtin_amdgcn_readfirstlane(tid >> 6), lane = tid & 63, wr = wid >> 2, wc = wid & 3, fr = lane & 15, fq = lane >> 4;
    const int K = g.K, nt = K / BK;
    unsigned voffA[2], voffB[2];
#pragma unroll
    for (int i = 0; i < 2; ++i) { int R, C; stage_rc(tid * 16 + i * 8192, R, C); const int Rb = Epi::PERM ? ((R & ~31) + perm32(R & 31)) : R;
        voffA[i] = (unsigned)(R * g.lda + C) * 2u; voffB[i] = (unsigned)(Rb * g.ldb + C) * 2u; }
    const size_t kstep = (size_t)(BK * 2);
    const size_t hstepA = (size_t)HALF * g.lda * 2, hstepB = (size_t)HALF * g.ldb * 2;
    const size_t tstepA = 2 * hstepA, tstepB = 2 * hstepB;
    const unsigned ldsw = (unsigned)wid * 1024u;
    const int aoff = lds_byte(wr * 64 + fr, fq * 8), boff = lds_byte(wc * 32 + fr, fq * 8);
#define PG8_SA(b, h) (((b) * 2 + (h)) * HTB)
#define PG8_SB(b, h) ((4 + (b) * 2 + (h)) * HTB)
#define PG8_STAGE(bufoff, gbase, voff) do { _Pragma("unroll") for (int _i = 0; _i < 2; ++_i) \
        __builtin_amdgcn_global_load_lds((const unsigned*)((const char*)(gbase) + (voff)[_i]), (PG8_LAS unsigned*)(lds + (bufoff) + ldsw + _i * 8192), 16, 0, 0); } while (0)
#define PG8_LDA(dst, b, h) do { _Pragma("unroll") for (int m = 0; m < 4; ++m) _Pragma("unroll") for (int k = 0; k < 2; ++k) dst[m][k] = *(const PG8_LAS bf16x8*)(lds + PG8_SA(b, h) + aoff + m * 2048 + k * 1024); } while (0)
#define PG8_LDB(dst, b, h) do { _Pragma("unroll") for (int n = 0; n < 2; ++n) _Pragma("unroll") for (int k = 0; k < 2; ++k) dst[n][k] = *(const PG8_LAS bf16x8*)(lds + PG8_SB(b, h) + boff + n * 2048 + k * 1024); } while (0)
#define PG8_MMA(ai, bj, At, Bt) do { __builtin_amdgcn_s_setprio(1); _Pragma("unroll") for (int m = 0; m < 4; ++m) _Pragma("unroll") for (int n = 0; n < 2; ++n) _Pragma("unroll") for (int k = 0; k < 2; ++k) \
        acc[ai][bj][m][n] = __builtin_amdgcn_mfma_f32_16x16x32_bf16(Bt[n][k], At[m][k], acc[ai][bj][m][n], 0, 0, 0); __builtin_amdgcn_s_setprio(0); } while (0)
#define PG8_WAIT_V(n) asm volatile("s_waitcnt vmcnt(" #n ")" ::: "memory")
#define PG8_WAIT_L(n) asm volatile("s_waitcnt lgkmcnt(" #n ")" ::: "memory")
#define PG8_BAR __builtin_amdgcn_s_barrier()
#define PG8_SCHED __builtin_amdgcn_sched_barrier(0)
    Unit cur, nxt; int ui = 0;
    if (!S.next(0, cur)) return;
    f32x4 acc[2][2][4][2];
#pragma unroll
    for (int a = 0; a < 2; ++a)
#pragma unroll
        for (int b = 0; b < 2; ++b)
#pragma unroll
            for (int m = 0; m < 4; ++m)
#pragma unroll
                for (int n = 0; n < 2; ++n) acc[a][b][m][n] = (f32x4){0.f, 0.f, 0.f, 0.f};
    bf16x8 At[4][2], B0[2][2], B1[2][2];
    const char* cA = (const char*)g.A + (size_t)cur.pm * tstepA; const char* cB = (const char*)g.Bt + (size_t)cur.pn * tstepB;
    S.a_ready(cur);
    if constexpr (SP2) {
        PG8_STAGE(PG8_SB(0, 0), cB, voffB); PG8_STAGE(PG8_SB(0, 1), cB + hstepB, voffB); PG8_STAGE(PG8_SA(0, 0), cA, voffA); PG8_STAGE(PG8_SA(0, 1), cA + hstepA, voffA);
        if (wr == 1) PG8_BAR;
        PG8_WAIT_V(2); PG8_BAR;
        PG8_STAGE(PG8_SB(1, 0), cB + kstep, voffB); PG8_STAGE(PG8_SA(1, 0), cA + kstep, voffA); PG8_STAGE(PG8_SB(1, 1), cB + hstepB + kstep, voffB);
        PG8_WAIT_V(6); PG8_BAR;
    } else {
        PG8_STAGE(PG8_SB(0, 0), cB, voffB); PG8_STAGE(PG8_SA(0, 0), cA, voffA); PG8_STAGE(PG8_SB(0, 1), cB + hstepB, voffB); PG8_STAGE(PG8_SA(0, 1), cA + hstepA, voffA);
        if (wr == 1) PG8_BAR;
        PG8_WAIT_V(4); PG8_BAR;
        PG8_STAGE(PG8_SB(1, 0), cB + kstep, voffB); PG8_STAGE(PG8_SA(1, 0), cA + kstep, voffA); PG8_STAGE(PG8_SB(1, 1), cB + hstepB + kstep, voffB);
        PG8_WAIT_V(6); PG8_BAR;
    }
    for (;;) {
        const bool has_next = S.next(ui + 1, nxt);
        const char* nA = has_next ? (const char*)g.A + (size_t)nxt.pm * tstepA : cA; const char* nB = has_next ? (const char*)g.Bt + (size_t)nxt.pn * tstepB : cB;
        for (int t = 0; t < nt; t += 2) {
            const bool last = (t == nt - 2);
            const char* a1 = cA + (size_t)(t + 1) * kstep;
            const char* a2 = last ? nA : cA + (size_t)(t + 2) * kstep; const char* b2 = last ? nB : cB + (size_t)(t + 2) * kstep;
            const char* a3 = a2 + kstep; const char* b3 = b2 + kstep;
            if (last && has_next) S.a_ready(nxt);
            if constexpr (SP2) {
            PG8_LDB(B0, 0, 0); PG8_LDB(B1, 0, 1); PG8_SCHED; PG8_LDA(At, 0, 0); PG8_STAGE(PG8_SA(1, 1), a1 + hstepA, voffA);
            PG8_WAIT_V(8); PG8_WAIT_L(0); PG8_BAR; PG8_MMA(0, 0, At, B0); PG8_MMA(0, 1, At, B1); PG8_BAR; PG8_SCHED;
            PG8_LDA(At, 0, 1); PG8_STAGE(PG8_SB(0, 0), b2, voffB); PG8_STAGE(PG8_SB(0, 1), b2 + hstepB, voffB); PG8_STAGE(PG8_SA(0, 0), a2, voffA);
            PG8_WAIT_V(8); PG8_WAIT_L(0); PG8_BAR; PG8_MMA(1, 0, At, B0); PG8_MMA(1, 1, At, B1); PG8_BAR; PG8_SCHED;
            PG8_LDB(B0, 1, 0); PG8_LDB(B1, 1, 1); PG8_SCHED; PG8_LDA(At, 1, 0); PG8_STAGE(PG8_SA(0, 1), a2 + hstepA, voffA);
            PG8_WAIT_V(8); PG8_WAIT_L(0); PG8_BAR; PG8_MMA(0, 0, At, B0); PG8_MMA(0, 1, At, B1); PG8_BAR; PG8_SCHED;
            PG8_LDA(At, 1, 1); PG8_STAGE(PG8_SB(1, 0), b3, voffB); PG8_STAGE(PG8_SB(1, 1), b3 + hstepB, voffB); PG8_STAGE(PG8_SA(1, 0), a3, voffA);
            PG8_WAIT_V(8); PG8_WAIT_L(0); PG8_BAR; PG8_MMA(1, 0, At, B0); PG8_MMA(1, 1, At, B1); PG8_BAR; PG8_SCHED;
            } else {
            PG8_LDB(B0, 0, 0); PG8_SCHED; PG8_LDA(At, 0, 0); PG8_STAGE(PG8_SA(1, 1), a1 + hstepA, voffA);
            PG8_WAIT_L(8); PG8_BAR; PG8_WAIT_L(0); PG8_MMA(0, 0, At, B0); PG8_BAR; PG8_SCHED;
            PG8_LDB(B1, 0, 1); PG8_STAGE(PG8_SB(0, 0), b2, voffB);
            PG8_BAR; PG8_WAIT_L(0); PG8_MMA(0, 1, At, B1); PG8_BAR;
            PG8_LDA(At, 0, 1); PG8_STAGE(PG8_SA(0, 0), a2, voffA);
            PG8_BAR; PG8_WAIT_L(0); PG8_MMA(1, 0, At, B0); PG8_BAR; PG8_SCHED;
            PG8_STAGE(PG8_SB(0, 1), b2 + hstepB, voffB);
            PG8_WAIT_V(6); PG8_BAR; PG8_MMA(1, 1, At, B1); PG8_BAR;
            PG8_LDB(B0, 1, 0); PG8_SCHED; PG8_LDA(At, 1, 0); PG8_STAGE(PG8_SA(0, 1), a2 + hstepA, voffA);
            PG8_WAIT_L(8); PG8_BAR; PG8_WAIT_L(0); PG8_MMA(0, 0, At, B0); PG8_BAR; PG8_SCHED;
            PG8_LDB(B1, 1, 1); PG8_STAGE(PG8_SB(1, 0), b3, voffB);
            PG8_BAR; PG8_WAIT_L(0); PG8_MMA(0, 1, At, B1); PG8_BAR;
            PG8_LDA(At, 1, 1); PG8_STAGE(PG8_SA(1, 0), a3, voffA);
            PG8_BAR; PG8_WAIT_L(0); PG8_MMA(1, 0, At, B0); PG8_BAR; PG8_SCHED;
            PG8_STAGE(PG8_SB(1, 1), b3 + hstepB, voffB);
            PG8_WAIT_V(6); PG8_BAR; PG8_MMA(1, 1, At, B1); PG8_BAR;
            }
        }
        if constexpr (ALIGN_EPI) { if (wr == 0) PG8_BAR; }
        if constexpr (!Epi::AFTER_DRAIN) { E(acc, cur, wr, wc, fr, fq); S.done(cur); }
        if (!has_next) break;
#pragma unroll
        for (int a = 0; a < 2; ++a)
#pragma unroll
            for (int b = 0; b < 2; ++b)
#pragma unroll
                for (int m = 0; m < 4; ++m)
#pragma unroll
                    for (int n = 0; n < 2; ++n) acc[a][b][m][n] = (f32x4){0.f, 0.f, 0.f, 0.f};
        cur = nxt; cA = nA; cB = nB; ++ui;
        if constexpr (ALIGN_EPI) { if (wr == 1) PG8_BAR; }
    }
    PG8_WAIT_V(0);
    if constexpr (!ALIGN_EPI) { if (wr == 0) PG8_BAR; }
    PG8_BAR;
    if constexpr (Epi::AFTER_DRAIN) { E.fused(acc, cur, wr, wc, fr, fq, lds, wid, lane); S.done(cur); }
#undef PG8_SA
#undef PG8_SB
#undef PG8_STAGE
#undef PG8_LDA
#undef PG8_LDB
#undef PG8_MMA
#undef PG8_WAIT_V
#undef PG8_WAIT_L
#undef PG8_BAR
#undef PG8_SCHED
}
}

#define LAS __attribute__((address_space(3)))
namespace att {
typedef short bf16x8 __attribute__((ext_vector_type(8)));
typedef float f32x16 __attribute__((ext_vector_type(16)));
typedef float f32x2_t __attribute__((ext_vector_type(2))); typedef __bf16 bf16x2_t __attribute__((ext_vector_type(2)));
__device__ __forceinline__ unsigned cvtpk(float lo, float hi) { f32x2_t v = {lo, hi}; bf16x2_t b = __builtin_convertvector(v, bf16x2_t); return __builtin_bit_cast(unsigned, b); }
constexpr int KP = 144;
constexpr float LOG2E = 1.4426950408889634f, CSC = 0.125f * LOG2E, THR = 6.0f;
__device__ __forceinline__ int crow(int r, int hi) { return (r & 3) + 8 * (r >> 2) + 4 * hi; }

template <int MODE>
__device__ __forceinline__ void attn_unit(LAS unsigned char* lds, int h, int qb, const bf16_t* __restrict__ QK, const bf16_t* __restrict__ VT, const unsigned* __restrict__ BMP,
                                          const float* __restrict__ BT, const float* __restrict__ subw, float lam, bf16_t* __restrict__ OAB) {
    constexpr int DV = MODE ? 128 : 64, QB = MODE ? 128 : 256, NDT = DV / 32, NKT = MODE ? 2 : 1;
    constexpr int KBYTES = 64 * KP, VBYTES = DV * KP, KRING = NKT * KBYTES, OFF_V = 3 * KRING;
    constexpr int OFF_BIAS = OFF_V + 2 * VBYTES;
    const int tid = threadIdx.x, lane = tid & 63, wave = __builtin_amdgcn_readfirstlane(tid >> 6), ql = lane & 31, hi = lane >> 5;
    const int qw = MODE ? (wave & 3) : wave, map = MODE ? (wave >> 2) : 0;
    const int q0 = qb * QB, qw0 = q0 + 32 * qw, t = qw0 + ql;
    const int qcol = MODE ? C_BQ + (2 * h + map) * 64 : C_AQ + h * 64;
    const int kcol0 = MODE ? C_BK + (2 * h) * 64 : C_AK + h * 64;
    const int vrow0 = MODE ? 512 + h * 128 : h * 64;
    const int hb = MODE ? 8 + h : h;
    LAS float* bias2 = (LAS float*)(lds + OFF_BIAS);
    if (tid < 128) bias2[tid] = BT[tid * 12 + hb] * LOG2E;
    bf16x8 qf[4];
#pragma unroll
    for (int ks = 0; ks < 4; ++ks) qf[ks] = *(const bf16x8*)(QK + (size_t)t * NTOK + qcol + 16 * ks + 8 * hi);
    const int pr = tid >> 3, pc = tid & 7;
    u32x4 sk[NKT], sv[NKT];
    const int NT = (q0 + QB) / 64;
#define AT_GLOADK(kt) do { _Pragma("unroll") for (int i_ = 0; i_ < NKT; ++i_) sk[i_] = *(const u32x4*)(QK + (size_t)((kt) * 64 + pr) * NTOK + kcol0 + i_ * 64 + pc * 8); } while (0)
#define AT_GLOADV(kt) do { _Pragma("unroll") for (int i_ = 0; i_ < NKT; ++i_) sv[i_] = *(const u32x4*)(VT + (size_t)(vrow0 + pr + 64 * i_) * L + (kt) * 64 + pc * 8); } while (0)
#define AT_LSTOREK(buf) do { _Pragma("unroll") for (int i_ = 0; i_ < NKT; ++i_) *(LAS u32x4*)(lds + (buf) * KRING + i_ * KBYTES + pr * KP + pc * 16) = sk[i_]; } while (0)
#define AT_LSTOREV(buf) do { _Pragma("unroll") for (int i_ = 0; i_ < NKT; ++i_) *(LAS u32x4*)(lds + OFF_V + (buf) * VBYTES + (pr + 64 * i_) * KP + pc * 16) = sv[i_]; } while (0)
#define AT_QK(Sx, buf, j) do { const LAS unsigned char* kb_ = lds + (buf) * KRING + (MODE ? map * KBYTES : 0); \
        _Pragma("unroll") for (int r = 0; r < 16; ++r) Sx[r] = 0.f; \
        _Pragma("unroll") for (int ks = 0; ks < 4; ++ks) { const bf16x8 kf = *(const LAS bf16x8*)(kb_ + (32 * (j) + kperm) * KP + (16 * ks + 8 * hi) * 2); \
            Sx = __builtin_amdgcn_mfma_f32_32x32x16_bf16(kf, qf[ks], Sx, 0, 0, 0); } } while (0)
    f32x16 O[NDT];
#pragma unroll
    for (int d = 0; d < NDT; ++d)
#pragma unroll
        for (int r = 0; r < 16; ++r) O[d][r] = 0.f;
    float m_run = -INFINITY, l_run = 0.f;
    const int kperm = (ql & 0x13) | ((ql & 4) << 1) | ((ql & 8) >> 1);
    AT_GLOADK(0); AT_GLOADV(0); AT_LSTOREK(0); AT_LSTOREV(0);
    if (NT > 1) { AT_GLOADK(1); AT_LSTOREK(1); }
    __syncthreads();
    const float b31 = bias2[127];
    u32x2 mw = {0u, 0u};
    if (MODE == 0) mw = *(const u32x2*)(BMP + (size_t)t * 512);
    f32x16 S, Sn;
    AT_QK(S, 0, 0);
    int k3 = 0, kt = 0;
    const int NF = (q0 >= 176) ? (((q0 - 176) >> 6) + 1 < NT - 2 ? ((q0 - 176) >> 6) + 1 : NT - 2) : 0;
#define AT_ROWMAX(Sx, mxv) do { float a_ = __builtin_fmaxf(Sx[0], Sx[1]), b_ = __builtin_fmaxf(Sx[2], Sx[3]); \
        _Pragma("unroll") for (int r = 4; r < 16; r += 4) { a_ = __builtin_fmaxf(__builtin_fmaxf(Sx[r], Sx[r + 1]), a_); b_ = __builtin_fmaxf(__builtin_fmaxf(Sx[r + 2], Sx[r + 3]), b_); } \
        float m_ = fmaf(__builtin_fmaxf(a_, b_), CSC, b31); \
        auto rr_ = __builtin_amdgcn_permlane32_swap(__float_as_uint(m_), __float_as_uint(m_), false, false); \
        mxv = __builtin_fmaxf(__uint_as_float(rr_[0]), __uint_as_float(rr_[1])); } while (0)
#define AT_RESCALE(mxv) do { const bool need_ = mxv > m_run + THR; \
        if (__any(need_)) { const float m_new = need_ ? mxv : m_run; const float alpha = (m_new == m_run) ? 1.f : __builtin_amdgcn_exp2f(m_run - m_new); l_run *= alpha; \
            _Pragma("unroll") for (int d = 0; d < NDT; ++d) _Pragma("unroll") for (int r = 0; r < 16; ++r) O[d][r] *= alpha; \
            m_run = m_new; } } while (0)
    if (NF > 0) { float mx0; AT_ROWMAX(S, mx0); AT_RESCALE(mx0); }
    for (; kt < NF; ++kt) {
        const int cur = kt & 1, k3n = (k3 == 2) ? 0 : k3 + 1, k3nn = (k3n == 2) ? 0 : k3n + 1;
        AT_GLOADK(kt + 2); AT_GLOADV(kt + 1);
        u32x2 mwn = {0u, 0u};
        if (MODE == 0) mwn = *(const u32x2*)(BMP + (size_t)t * 512 + 2 * (kt + 1));
        const LAS unsigned char* vb = lds + OFF_V + cur * VBYTES;
#pragma unroll
        for (int j = 0; j < 2; ++j) {
            if (j == 0) AT_QK(Sn, k3, 1); else AT_QK(Sn, k3n, 0);
            const float nb = b31 - m_run;
#pragma unroll
            for (int r = 0; r < 16; ++r) S[r] = __builtin_amdgcn_exp2f(fmaf(S[r], CSC, nb));
            if (MODE == 0) { const unsigned w = (j ? mw.y : mw.x) >> (8 * hi);
#pragma unroll
                for (int r = 0; r < 16; ++r) S[r] = __uint_as_float(__float_as_uint(S[r]) & (unsigned)__builtin_amdgcn_sbfe((int)w, 16 * (r >> 3) + (r & 7), 1)); }
            float ls0 = 0.f, ls1 = 0.f;
#pragma unroll
            for (int r = 0; r < 16; r += 2) { ls0 += S[r]; ls1 += S[r + 1]; }
            l_run += ls0 + ls1;
            bf16x8 pb[2];
#pragma unroll
            for (int s2 = 0; s2 < 2; ++s2) { const int o = 8 * s2; u32x4 w;
                w.x = cvtpk(S[o + 0], S[o + 1]); w.y = cvtpk(S[o + 2], S[o + 3]); w.z = cvtpk(S[o + 4], S[o + 5]); w.w = cvtpk(S[o + 6], S[o + 7]);
                pb[s2] = __builtin_bit_cast(bf16x8, w); }
#pragma unroll
            for (int d = 0; d < NDT; ++d)
#pragma unroll
                for (int s2 = 0; s2 < 2; ++s2) {
                    const bf16x8 vf = *(const LAS bf16x8*)(vb + (32 * d + ql) * KP + (32 * j + 16 * s2 + 8 * hi) * 2);
                    O[d] = __builtin_amdgcn_mfma_f32_32x32x16_bf16(vf, pb[s2], O[d], 0, 0, 0);
                }
            float mxn; AT_ROWMAX(Sn, mxn); AT_RESCALE(mxn);
            S = Sn;
        }
        AT_LSTOREK(k3nn); AT_LSTOREV(cur ^ 1);
        k3 = k3n; mw = mwn;
        __syncthreads();
    }
    for (; kt < NT; ++kt) {
        const int cur = kt & 1, k0 = kt * 64, k3n = (k3 == 2) ? 0 : k3 + 1, k3nn = (k3n == 2) ? 0 : k3n + 1;
        const bool more1 = kt + 1 < NT, more2 = kt + 2 < NT;
        if (more2) AT_GLOADK(kt + 2);
        if (more1) AT_GLOADV(kt + 1);
        u32x2 mwn = {0u, 0u};
        if (MODE == 0 && more1) mwn = *(const u32x2*)(BMP + (size_t)t * 512 + 2 * (kt + 1));
#pragma unroll
        for (int j = 0; j < 2; ++j) {
            const int kj = k0 + 32 * j;
            if (j == 0) { if (kj + 32 <= qw0 + 31) AT_QK(Sn, k3, 1); }
            else        { if (more1 && (kj + 32 <= qw0 + 31)) AT_QK(Sn, k3n, 0); }
            if (kj <= qw0 + 31) {
                const LAS unsigned char* vb = lds + OFF_V + cur * VBYTES;
                const bool nearb = (qw0 - (kj + 31)) < 113;
                float mx = -INFINITY;
                if (nearb) {
#pragma unroll
                    for (int r = 0; r < 16; ++r) {
                        const int key = kj + 16 * (r >> 3) + 8 * hi + (r & 7); const int dist = t - key;
                        const float bb = bias2[dist < 0 ? 0 : (dist > 127 ? 127 : dist)];
                        const float e = dist < 0 ? -INFINITY : fmaf(S[r], CSC, bb);
                        S[r] = e; mx = fmaxf(mx, e);
                    }
                } else {
#pragma unroll
                    for (int r = 0; r < 16; r += 2) mx = __builtin_fmaxf(__builtin_fmaxf(S[r], S[r + 1]), mx);
                    mx = fmaf(mx, CSC, b31);
                }
                mx = fmaxf(mx, __shfl_xor(mx, 32));
                const bool need = mx > m_run + THR;
                if (__any(need)) {
                    const float m_new = need ? mx : m_run;
                    const float alpha = (m_new == m_run) ? 1.f : __builtin_amdgcn_exp2f(m_run - m_new);
                    l_run *= alpha;
#pragma unroll
                    for (int d = 0; d < NDT; ++d)
#pragma unroll
                        for (int r = 0; r < 16; ++r) O[d][r] *= alpha;
                    m_run = m_new;
                }
                if (nearb) {
#pragma unroll
                    for (int r = 0; r < 16; ++r) S[r] = __builtin_amdgcn_exp2f(S[r] - m_run);
                } else {
                    const float nb = b31 - m_run;
#pragma unroll
                    for (int r = 0; r < 16; ++r) S[r] = __builtin_amdgcn_exp2f(fmaf(S[r], CSC, nb));
                }
                if (MODE == 0) {
                    const unsigned w = (j ? mw.y : mw.x) >> (8 * hi);
#pragma unroll
                    for (int r = 0; r < 16; ++r) S[r] = __uint_as_float(__float_as_uint(S[r]) & (unsigned)__builtin_amdgcn_sbfe((int)w, 16 * (r >> 3) + (r & 7), 1));
                }
                float ls0 = 0.f, ls1 = 0.f;
#pragma unroll
                for (int r = 0; r < 16; r += 2) { ls0 += S[r]; ls1 += S[r + 1]; }
                l_run += ls0 + ls1;
                bf16x8 pb[2];
#pragma unroll
                for (int s = 0; s < 2; ++s) { const int o = 8 * s; u32x4 w;
                    w.x = cvtpk(S[o + 0], S[o + 1]); w.y = cvtpk(S[o + 2], S[o + 3]); w.z = cvtpk(S[o + 4], S[o + 5]); w.w = cvtpk(S[o + 6], S[o + 7]);
                    pb[s] = __builtin_bit_cast(bf16x8, w); }
#pragma unroll
                for (int d = 0; d < NDT; ++d)
#pragma unroll
                    for (int s = 0; s < 2; ++s) {
                        const bf16x8 vf = *(const LAS bf16x8*)(vb + (32 * d + ql) * KP + (32 * j + 16 * s + 8 * hi) * 2);
                        O[d] = __builtin_amdgcn_mfma_f32_32x32x16_bf16(vf, pb[s], O[d], 0, 0, 0);
                    }
            }
            S = Sn;
        }
        if (more2) AT_LSTOREK(k3nn);
        if (more1) AT_LSTOREV(cur ^ 1);
        k3 = k3n;
        mw = mwn;
        __syncthreads();
    }
#undef AT_GLOADK
#undef AT_ROWMAX
#undef AT_RESCALE
#undef AT_GLOADV
#undef AT_LSTOREK
#undef AT_LSTOREV
#undef AT_QK
    const float l_tot = l_run + __shfl_xor(l_run, 32);
    const float inv = 1.f / l_tot;
    if (MODE == 0) {
#pragma unroll
        for (int d = 0; d < NDT; ++d)
#pragma unroll
            for (int g = 0; g < 4; ++g) { u32x2 w; w.x = cvtpk(O[d][4 * g] * inv, O[d][4 * g + 1] * inv); w.y = cvtpk(O[d][4 * g + 2] * inv, O[d][4 * g + 3] * inv);
                *(u32x2*)(OAB + (size_t)t * 1024 + h * 64 + 32 * d + 8 * g + 4 * hi) = w; }
    } else {
        LAS float* X = (LAS float*)lds;
        if (map == 1) {
#pragma unroll
            for (int d = 0; d < NDT; ++d)
#pragma unroll
                for (int r = 0; r < 16; ++r) X[(d * 16 + r) * 256 + qw * 64 + lane] = O[d][r] * inv;
        }
        __syncthreads();
        if (map == 0) {
            float ss = 0.f;
#pragma unroll
            for (int d = 0; d < NDT; ++d)
#pragma unroll
                for (int r = 0; r < 16; ++r) { const float v = O[d][r] * inv - lam * X[(d * 16 + r) * 256 + qw * 64 + lane]; O[d][r] = v; ss += v * v; }
            ss += __shfl_xor(ss, 32);
            const float rn = rsqrtf(ss * (1.f / 128.f) + 1e-5f) * (1.f - LAM_INIT);
#pragma unroll
            for (int d = 0; d < NDT; ++d)
#pragma unroll
                for (int g = 0; g < 4; ++g) { const int e0 = 32 * d + 8 * g + 4 * hi; const float4 sw = *(const float4*)(subw + e0);
                    u32x2 w; w.x = cvtpk(O[d][4 * g] * rn * sw.x, O[d][4 * g + 1] * rn * sw.y); w.y = cvtpk(O[d][4 * g + 2] * rn * sw.z, O[d][4 * g + 3] * rn * sw.w);
                    *(u32x2*)(OAB + (size_t)t * 1024 + 512 + h * 128 + e0) = w; }
        }
        __syncthreads();
    }
}
}

namespace idx {
typedef short bf16x8 __attribute__((ext_vector_type(8)));
typedef float f32x4 __attribute__((ext_vector_type(4)));
constexpr int NQ = 16, CAP = 1200, TRIG = CAP - 256, NSL = 19;
constexpr int OFF_CNT = NQ * CAP * 8, OFF_TAU = OFF_CNT + 128, OFF_DUMP = OFF_TAU + 128, IDX_LDS = OFF_DUMP + 8 * 512;
__device__ __forceinline__ unsigned fkey(float f) { const unsigned u = __float_as_uint(f); return (u & 0x80000000u) ? ~u : (u | 0x80000000u); }
__device__ __forceinline__ float keyf(unsigned k) { return __uint_as_float((k & 0x80000000u) ? (k & 0x7fffffffu) : ~k); }
__device__ __forceinline__ int wave_count_ge(const unsigned (&kv)[NSL], unsigned cand) {
    int tot = 0;
#pragma unroll
    for (int i = 0; i < NSL; ++i) tot += __popcll(__ballot(kv[i] >= cand));
    return tot;
}
template <int NB> __device__ __forceinline__ unsigned kth_prefix(const unsigned (&kv)[NSL]) {
    unsigned prefix = 0u;
#pragma unroll 1
    for (int b = 31; b >= 32 - NB; --b) { const unsigned cand = prefix | (1u << b); if (wave_count_ge(kv, cand) >= 256) prefix = cand; }
    return prefix;
}
__device__ __forceinline__ void load_pool(const LAS u32x2* pool, int c, int lane, unsigned (&kv)[NSL], unsigned (&sb)[NSL], unsigned (&kk)[NSL]) {
#pragma unroll
    for (int i = 0; i < NSL; ++i) { const int s = lane + 64 * i; u32x2 e = {0u, 0u}; if (s < c) e = pool[s]; sb[i] = e.x; kk[i] = e.y; kv[i] = (s < c) ? fkey(__uint_as_float(e.x)) : 0u; }
}
__device__ __forceinline__ void prune(LAS unsigned char* lds, int q, int lane) {
    LAS u32x2* pool = (LAS u32x2*)(lds + q * CAP * 8); LAS unsigned* cnt = (LAS unsigned*)(lds + OFF_CNT); LAS float* tau = (LAS float*)(lds + OFF_TAU);
    int c = (int)cnt[q]; c = c > CAP ? CAP : c;
    unsigned kv[NSL], sb[NSL], kk[NSL];
    load_pool(pool, c, lane, kv, sb, kk);
    const unsigned prefix = kth_prefix<17>(kv);
    int base = 0;
#pragma unroll
    for (int i = 0; i < NSL; ++i) { const bool keep = kv[i] >= prefix && prefix != 0u; const unsigned long long m = __ballot(keep);
        const int pos = base + __builtin_amdgcn_mbcnt_hi((unsigned)(m >> 32), __builtin_amdgcn_mbcnt_lo((unsigned)m, 0u));
        if (keep) pool[pos] = (u32x2){sb[i], kk[i]};
        base += __popcll(m); }
    if (lane == 0) { cnt[q] = (unsigned)base; tau[q] = keyf(prefix); }
}
__device__ __forceinline__ void finalize(LAS unsigned char* lds, int q, int lane, unsigned* __restrict__ bmp_row) {
    LAS u32x2* pool = (LAS u32x2*)(lds + q * CAP * 8); LAS unsigned* cnt = (LAS unsigned*)(lds + OFF_CNT);
    int c = (int)cnt[q]; c = c > CAP ? CAP : c;
    unsigned kv[NSL], sb[NSL], kk[NSL];
    load_pool(pool, c, lane, kv, sb, kk);
    unsigned prefix = 0u; int need = 1 << 20;
    if (c > 256) { prefix = kth_prefix<32>(kv); int gt = 0;
#pragma unroll
        for (int i = 0; i < NSL; ++i) gt += __popcll(__ballot(kv[i] > prefix));
        need = 256 - gt; }
    LAS unsigned* row = (LAS unsigned*)pool;
    *(LAS u32x4*)(row + 8 * lane) = (u32x4){0u, 0u, 0u, 0u}; *(LAS u32x4*)(row + 8 * lane + 4) = (u32x4){0u, 0u, 0u, 0u};
    int base = 0;
#pragma unroll
    for (int i = 0; i < NSL; ++i) { const bool valid = (lane + 64 * i) < c; bool sel = valid && kv[i] > prefix; const bool tie = valid && kv[i] == prefix;
        const unsigned long long m = __ballot(tie);
        const int rank = base + __builtin_amdgcn_mbcnt_hi((unsigned)(m >> 32), __builtin_amdgcn_mbcnt_lo((unsigned)m, 0u));
        if (tie && rank < need) sel = true;
        base += __popcll(m);
        if (sel) __hip_atomic_fetch_or(row + (kk[i] >> 5), 1u << (kk[i] & 31), __ATOMIC_RELAXED, __HIP_MEMORY_SCOPE_WORKGROUP); }
    const u32x4 w0 = *(LAS u32x4*)(row + 8 * lane), w1 = *(LAS u32x4*)(row + 8 * lane + 4);
    *(u32x4*)(bmp_row + 8 * lane) = w0; *(u32x4*)(bmp_row + 8 * lane + 4) = w1;
}

__device__ __forceinline__ void index_unit(LAS unsigned char* lds, int qblk, const bf16_t* __restrict__ QK, unsigned* __restrict__ BMP) {
    const int tid = threadIdx.x, lane = tid & 63, wave = __builtin_amdgcn_readfirstlane(tid >> 6), qc = lane & 15, g = lane >> 4;
    const int t = qblk * NQ + qc, NTL = (qblk + 2) >> 1;
    LAS unsigned* cnt = (LAS unsigned*)(lds + OFF_CNT); LAS float* tau = (LAS float*)(lds + OFF_TAU);
    if (tid < NQ) { cnt[tid] = 0u; tau[tid] = -INFINITY; }
    bf16x8 qf[8][2]; float wq[8];
#pragma unroll
    for (int h = 0; h < 8; ++h) {
        wq[h] = bf2f(QK[(size_t)t * NTOK + C_IW + h]) * (0.35355339059327373f * 0.125f);
#pragma unroll
        for (int ks = 0; ks < 2; ++ks) qf[h][ks] = *(const bf16x8*)(QK + (size_t)t * NTOK + C_IQ + h * 64 + 32 * ks + 8 * g);
    }
    const unsigned dump_a = (unsigned)(size_t)(lds + OFF_DUMP + wave * 512 + lane * 8), pool_a = (unsigned)(size_t)(lds + qc * CAP * 8);
    __syncthreads();
    const int nrounds = (NTL + 7) >> 3;
    bf16x8 kf[2][2];
    { const int kt0 = wave < NTL ? wave : 0;
#pragma unroll
      for (int i = 0; i < 2; ++i)
#pragma unroll
          for (int ks = 0; ks < 2; ++ks) kf[i][ks] = *(const bf16x8*)(QK + (size_t)(kt0 * 32 + 16 * i + qc) * NTOK + C_IK + 32 * ks + 8 * g); }
    for (int rd = 0; rd < nrounds; ++rd) {
        const int kt = rd * 8 + wave;
        if (kt < NTL) {
            const int k0 = kt * 32;
            const float tau_l = tau[qc];
            f32x4 sc[2];
#pragma unroll
            for (int i = 0; i < 2; ++i) {
                sc[i] = (f32x4){0.f, 0.f, 0.f, 0.f};
#pragma unroll
                for (int h = 0; h < 8; ++h) {
                    f32x4 acc = {0.f, 0.f, 0.f, 0.f};
                    acc = __builtin_amdgcn_mfma_f32_16x16x32_bf16(kf[i][0], qf[h][0], acc, 0, 0, 0);
                    acc = __builtin_amdgcn_mfma_f32_16x16x32_bf16(kf[i][1], qf[h][1], acc, 0, 0, 0);
#pragma unroll
                    for (int r = 0; r < 4; ++r) sc[i][r] = fmaf(wq[h], fmaxf(acc[r], 0.f), sc[i][r]);
                }
            }
            { const int ktn = (kt + 8 < NTL) ? kt + 8 : kt;
#pragma unroll
              for (int i = 0; i < 2; ++i)
#pragma unroll
                  for (int ks = 0; ks < 2; ++ks) kf[i][ks] = *(const bf16x8*)(QK + (size_t)(ktn * 32 + 16 * i + qc) * NTOK + C_IK + 32 * ks + 8 * g); }
            const int klim = (kt == NTL - 1) ? t : 0x7fffffff;
            int n = 0;
#pragma unroll
            for (int i = 0; i < 2; ++i)
#pragma unroll
                for (int r = 0; r < 4; ++r) { const int key = k0 + 16 * i + 4 * g + r; n += (sc[i][r] >= tau_l && key <= klim) ? 1 : 0; }
            int slot = 0;
            if (n > 0) slot = (int)__hip_atomic_fetch_add(cnt + qc, (unsigned)n, __ATOMIC_RELAXED, __HIP_MEMORY_SCOPE_WORKGROUP);
#pragma unroll
            for (int i = 0; i < 2; ++i)
#pragma unroll
                for (int r = 0; r < 4; ++r) { const int key = k0 + 16 * i + 4 * g + r; const bool pass = sc[i][r] >= tau_l && key <= klim; const bool ok = pass && slot < CAP;
                    const unsigned addr = ok ? pool_a + (unsigned)slot * 8u : dump_a;
                    *(LAS u32x2*)(size_t)addr = (u32x2){__float_as_uint(sc[i][r]), (unsigned)key};
                    slot += pass ? 1 : 0; }
        }
        __syncthreads();
        const bool over = cnt[qc] > (unsigned)TRIG;
        if (__any(over)) {
#pragma unroll 1
            for (int i = 0; i < 2; ++i) { const int q = wave * 2 + i; if (cnt[q] > (unsigned)TRIG) prune(lds, q, lane); }
            __syncthreads();
        }
    }
#pragma unroll 1
    for (int i = 0; i < 2; ++i) { const int q = wave * 2 + i; finalize(lds, q, lane, BMP + (size_t)(qblk * NQ + q) * 512); }
    __syncthreads();
}
}

typedef __attribute__((address_space(1))) unsigned gu32;
#define XB_TMO      128
#define XB_XCNT(j)  (256  + 64 * (j))
#define XB_XSUB(j)  (1280 + 64 * (j))
#define XB_XGEN(j)  (2304 + 64 * (j))
#define XB_TOP      3328
#define XB_TOPGEN   3392
#define XCD_BAR_WORDS 3456
#define XB_SPIN_CAP (1u << 23)

__device__ __forceinline__ unsigned xb_ld(unsigned* p)              { return __hip_atomic_load(p, __ATOMIC_RELAXED, __HIP_MEMORY_SCOPE_AGENT); }
__device__ __forceinline__ unsigned xb_add(unsigned* p, unsigned v) { return __hip_atomic_fetch_add(p, v, __ATOMIC_RELAXED, __HIP_MEMORY_SCOPE_AGENT); }
__device__ __forceinline__ unsigned xb_xcc_id() { return (unsigned)__builtin_amdgcn_s_getreg((3 << 11) | 20) & 0xFu; }
#define XB_SPIN(cond, bar) do { unsigned _sp = 0; while (cond) { __builtin_amdgcn_s_sleep(1); \
    if ((++_sp & 255u) == 0u) { if (xb_ld(&(bar)[XB_TMO])) break; if (_sp > XB_SPIN_CAP) { atomicAdd(&(bar)[XB_TMO], 1u); break; } } } } while (0)

struct XcdBarrier {
    unsigned* bar; unsigned x;
    volatile LAS unsigned* st;
};

__device__ __forceinline__ XcdBarrier xcd_barrier_post(unsigned* bar, volatile LAS unsigned* st) {
    XcdBarrier b; b.bar = bar; b.x = xb_xcc_id(); b.st = st;
    if (threadIdx.x == 0) (void)xb_add(&bar[XB_XCNT(b.x)], 1u);
    return b;
}
__device__ __forceinline__ void xcd_barrier_complete(unsigned* bar, unsigned x, unsigned& nloc, unsigned& nx) {
    const unsigned G = gridDim.x * gridDim.y * gridDim.z;
    unsigned sum, cnt, mine, sp = 0u;
    for (;;) {
        sum = 0u; cnt = 0u; mine = 0u;
#pragma unroll
        for (unsigned j = 0; j < 16; ++j) { const unsigned c = xb_ld(&bar[XB_XCNT(j)]); sum += c; cnt += (c > 0u) ? 1u : 0u; mine = (j == x) ? c : mine; }
        if (sum == G) break;
        __builtin_amdgcn_s_sleep(1);
        if ((++sp & 255u) == 0u) { if (xb_ld(&bar[XB_TMO])) break; if (sp > XB_SPIN_CAP) { atomicAdd(&bar[XB_TMO], 1u); break; } }
    }
    nloc = mine > 0u ? mine : 1u; nx = cnt > 0u ? cnt : 1u;
}

__device__ __forceinline__ void xcd_barrier(const XcdBarrier& b) {
    asm volatile("s_waitcnt vmcnt(0)" ::: "memory");
    __syncthreads();
    if (threadIdx.x == 0) {
        unsigned* bar = b.bar;
        __builtin_amdgcn_s_waitcnt(0);
        unsigned nloc = b.st[0], nx = b.st[1];
        if (nloc == 0u) { xcd_barrier_complete(bar, b.x, nloc, nx); b.st[0] = nloc; b.st[1] = nx; }
        const unsigned old = xb_add(&bar[XB_XSUB(b.x)], 1u);
        const unsigned gen = old / nloc;
        if (old + 1u == (gen + 1u) * nloc) {
            __builtin_amdgcn_fence(__ATOMIC_RELEASE, "agent");
            asm volatile("s_waitcnt vmcnt(0)" ::: "memory");
            const unsigned og = xb_add(&bar[XB_TOP], 1u);
            const unsigned tg = og / nx;
            if (og + 1u == (tg + 1u) * nx) xb_add(&bar[XB_TOPGEN], 1u);
            else XB_SPIN(xb_ld(&bar[XB_TOPGEN]) == tg, bar);
            __builtin_amdgcn_fence(__ATOMIC_ACQUIRE, "agent");
            xb_add(&bar[XB_XGEN(b.x)], 1u);
            asm volatile("s_waitcnt vmcnt(0)" ::: "memory");
        } else {
            XB_SPIN(xb_ld(&bar[XB_XGEN(b.x)]) == gen, bar);
            __builtin_amdgcn_fence(__ATOMIC_ACQUIRE, "agent");
            asm volatile("s_waitcnt vmcnt(0)" ::: "memory");
        }
    }
    __syncthreads();
}

constexpr int NWAVES = 8, NTHREADS = 512;
constexpr int LDS_BYTES = 163840;
enum Phase { PH_PRO = 0, PH_G1 = 1, PH_IDX = 2, PH_ATB = 3, PH_ATA = 4, PH_T1 = 5, PH_T2 = 6, PH_T3 = 7, PH_T4 = 8, PH_T5 = 9, PH_N = 10 };

struct Args {
    const float* x; const float* p; const float* w_in; const float* w_pa; const float* w_pb; const float* w_o; const float* lqk; const float* subw;
    const float* ln_g; const float* ln_b; const float* w_ple; const float* w_gate; const float* rel_bias;
    float* out; unsigned char* ws; int ph_lo, ph_hi;
};

template <int MODE>
__device__ __forceinline__ void p0_transpose_item(const float* __restrict__ W, int K, int ld, int N, bf16_t* __restrict__ WT, LAS float* scr, int item, int lane) {
    const int nblk = N / 32, kb = item / nblk, nb = item % nblk, k0 = 64 * kb, n0 = 32 * nb;
    const int n = n0 + (lane & 31); const int c = MODE == 0 ? n : win_src_col(n);
#pragma unroll 8
    for (int i = 0; i < 32; ++i) { const int kk = 2 * i + (lane >> 5); scr[kk * 33 + (lane & 31)] = (c >= 0) ? W[(size_t)(k0 + kk) * ld + c] : 0.f; }
    asm volatile("s_waitcnt lgkmcnt(0)" ::: "memory");
    const int cc = lane & 7;
#pragma unroll
    for (int j = 0; j < 4; ++j) { const int nn = (lane >> 3) + 8 * j; const LAS float* s = scr + (8 * cc) * 33 + nn;
        u32x4 o; o.x = f2bf(s[0 * 33]) | ((unsigned)f2bf(s[1 * 33]) << 16); o.y = f2bf(s[2 * 33]) | ((unsigned)f2bf(s[3 * 33]) << 16);
        o.z = f2bf(s[4 * 33]) | ((unsigned)f2bf(s[5 * 33]) << 16); o.w = f2bf(s[6 * 33]) | ((unsigned)f2bf(s[7 * 33]) << 16);
        *(u32x4*)(WT + (size_t)(n0 + nn) * K + k0 + 8 * cc) = o; }
    asm volatile("s_waitcnt lgkmcnt(0)" ::: "memory");
}
__device__ __forceinline__ void cvt_rows(const float* __restrict__ src, bf16_t* __restrict__ dst, size_t n4, size_t gtid, size_t gthreads) {
    for (size_t i = gtid; i < n4; i += gthreads) { const float4 v = ((const float4*)src)[i]; u32x2 o; o.x = f2bf(v.x) | ((unsigned)f2bf(v.y) << 16); o.y = f2bf(v.z) | ((unsigned)f2bf(v.w) << 16); ((u32x2*)dst)[i] = o; }
}
__device__ __forceinline__ void ln_row(float* __restrict__ io, const float* __restrict__ g, const float* __restrict__ b, bf16_t* __restrict__ xln, int lane) {
    float4* r = (float4*)io + lane; float4 v[4]; float s = 0.f;
#pragma unroll
    for (int j = 0; j < 4; ++j) { v[j] = r[64 * j]; s += (v[j].x + v[j].y) + (v[j].z + v[j].w); }
#pragma unroll
    for (int o = 1; o < 64; o <<= 1) s += __shfl_xor(s, o);
    const float mean = s * (1.f / 1024.f); float q = 0.f;
#pragma unroll
    for (int j = 0; j < 4; ++j) { v[j].x -= mean; v[j].y -= mean; v[j].z -= mean; v[j].w -= mean; q += (v[j].x * v[j].x + v[j].y * v[j].y) + (v[j].z * v[j].z + v[j].w * v[j].w); }
#pragma unroll
    for (int o = 1; o < 64; o <<= 1) q += __shfl_xor(q, o);
    const float rstd = rsqrtf(q * (1.f / 1024.f) + 1e-5f);
#pragma unroll
    for (int j = 0; j < 4; ++j) {
        const float4 gg = ((const float4*)g)[lane + 64 * j], bb = ((const float4*)b)[lane + 64 * j];
        float4 o; o.x = v[j].x * rstd * gg.x + bb.x; o.y = v[j].y * rstd * gg.y + bb.y; o.z = v[j].z * rstd * gg.z + bb.z; o.w = v[j].w * rstd * gg.w + bb.w;
        r[64 * j] = o; u32x2 w; w.x = f2bf(o.x) | ((unsigned)f2bf(o.y) << 16); w.y = f2bf(o.z) | ((unsigned)f2bf(o.w) << 16);
        ((u32x2*)xln)[lane + 64 * j] = w;
    }
}

__global__ void __launch_bounds__(NTHREADS, 2) mega(Args a) {
    extern __shared__ __attribute__((aligned(16))) unsigned char lds_raw[];
    LAS unsigned char* lds = (LAS unsigned char*)lds_raw;
    const int tid = threadIdx.x, lane = tid & 63, wave = __builtin_amdgcn_readfirstlane(tid >> 6);
    const int G = gridDim.x, bx = blockIdx.x;
    unsigned char* ws = a.ws;
    bf16_t* WIN = (bf16_t*)(ws + WS_WIN); bf16_t* WPA = (bf16_t*)(ws + WS_WPA); bf16_t* WPB = (bf16_t*)(ws + WS_WPB); bf16_t* WO = (bf16_t*)(ws + WS_WO);
    bf16_t* WGT = (bf16_t*)(ws + WS_WGT); bf16_t* WPLE = (bf16_t*)(ws + WS_WPLE); bf16_t* XBF = (bf16_t*)(ws + WS_XBF); bf16_t* PBF = (bf16_t*)(ws + WS_PBF);
    bf16_t* QK = (bf16_t*)(ws + WS_QK); bf16_t* VT = (bf16_t*)(ws + WS_VT); bf16_t* OAB = (bf16_t*)(ws + WS_OAB);
    bf16_t* PLEO = (bf16_t*)(ws + WS_PLEO); bf16_t* Gb = (bf16_t*)(ws + WS_G); bf16_t* MRG = (bf16_t*)(ws + WS_MRG); bf16_t* XLN = (bf16_t*)(ws + WS_XLN);
    float* BT = (float*)(ws + WS_BT);
    const int lo = a.ph_lo, hi = a.ph_hi;
    volatile LAS unsigned* bst = (volatile LAS unsigned*)(lds + LDS_BYTES - 16);
    if (tid < 4) bst[tid] = 0u;
    __syncthreads();
    XcdBarrier bar = xcd_barrier_post((unsigned*)(ws + WS_CTL), bst);
#define IN(k) (lo <= (k) && (k) < hi)
#define SEAM(k) do { if (IN(k) && IN((k) + 1)) { if ((k) == PH_PRO) cooperative_groups::this_grid().sync(); else xcd_barrier(bar); } } while (0)

    if (IN(PH_PRO)) {
        LAS float* scr = (LAS float*)(lds + wave * 16384);
        const int gw = bx * NWAVES + wave, NGW = G * NWAVES;
        constexpr int I_IN = (WT_ROWS / 32) * (1024 / 64), I_PA = 32 * 8, I_O = 32 * 16, I_PLE = 32 * 4;
        constexpr int NITEMS = I_IN + 2 * I_PA + 2 * I_O + I_PLE;
        for (int it = gw; it < NITEMS; it += NGW) {
            int r = it;
            if (r < I_IN) { p0_transpose_item<1>(a.w_in, 1024, IN_COLS, WT_ROWS, WIN, scr, r, lane); continue; } r -= I_IN;
            if (r < I_PA) { p0_transpose_item<0>(a.w_pa, 512, 1024, 1024, WPA, scr, r, lane); continue; } r -= I_PA;
            if (r < I_PA) { p0_transpose_item<0>(a.w_pb, 512, 1024, 1024, WPB, scr, r, lane); continue; } r -= I_PA;
            if (r < I_O) { p0_transpose_item<0>(a.w_o, 1024, 1024, 1024, WO, scr, r, lane); continue; } r -= I_O;
            if (r < I_O) { p0_transpose_item<0>(a.w_gate, 1024, 1024, 1024, WGT, scr, r, lane); continue; } r -= I_O;
            p0_transpose_item<0>(a.w_ple, 256, 1024, 1024, WPLE, scr, r, lane);
        }
        const size_t gtid = (size_t)bx * NTHREADS + tid, gth = (size_t)G * NTHREADS;
        cvt_rows(a.x, XBF, (size_t)L * 1024 / 4, gtid, gth);
        cvt_rows(a.p, PBF, (size_t)L * 256 / 4, gtid, gth);
        if (gtid < 128 * 12) { const int n = (int)gtid / 12, h = (int)gtid % 12; BT[gtid] = a.rel_bias[rel_bucket(n) * 12 + h]; }
    }
    SEAM(PH_PRO);
    if (IN(PH_G1)) {
        { pg8::Gemm g{XBF, WIN + (size_t)WT_TOK * 1024, L, NTOK, 1024, 1024, 1024}; pg8::StaticOrder S; S.init(L, NTOK, G, bx);
          pg8::EpiStoreBf E{QK, NTOK, 0}; pg8::gemm_phase<pg8::EpiStoreBf, pg8::StaticOrder, true, true>(lds, g, S, E); }
        { pg8::Gemm g{WIN + (size_t)WT_VT * 1024, XBF, 1024, L, 1024, 1024, 1024}; pg8::StaticOrder S; S.init(1024, L, G, bx);
          pg8::EpiStoreBf E{VT, L, 0}; pg8::gemm_phase<pg8::EpiStoreBf, pg8::StaticOrder, true, true>(lds, g, S, E); }
    }
    SEAM(PH_G1);
    if (IN(PH_IDX)) {
        unsigned* BMPw = (unsigned*)(ws + WS_BMP);
        for (int p = bx; p < 512; p += G) { idx::index_unit(lds, 1023 - p, QK, BMPw); idx::index_unit(lds, p, QK, BMPw); }
    }
    if (IN(PH_ATB) || IN(PH_ATA)) {
        const int vcu = (G % 8 == 0) ? (bx % 8) * (G / 8) + bx / 8 : bx;
        const unsigned* BMP = (const unsigned*)(ws + WS_BMP);
        if (IN(PH_ATB)) {
            float la = a.lqk[lane] * a.lqk[64 + lane], lb = a.lqk[128 + lane] * a.lqk[192 + lane];
#pragma unroll
            for (int o = 1; o < 64; o <<= 1) { la += __shfl_xor(la, o); lb += __shfl_xor(lb, o); }
            const float lam = __expf(la) - __expf(lb) + LAM_INIT;
            for (int p = vcu; p < 256; p += G) { const int h = p >> 6, xq = p & 63;
                att::attn_unit<1>(lds, h, 127 - xq, QK, VT, BMP, BT, a.subw, lam, OAB);
                att::attn_unit<1>(lds, h, xq, QK, VT, BMP, BT, a.subw, lam, OAB); }
        }
        SEAM(PH_ATB);
        if (IN(PH_ATA)) {
            for (int p = vcu; p < 256; p += G) { const int h = p >> 5, xq = p & 31;
                att::attn_unit<0>(lds, h, 63 - xq, QK, VT, BMP, BT, a.subw, 0.f, OAB);
                att::attn_unit<0>(lds, h, xq, QK, VT, BMP, BT, a.subw, 0.f, OAB); }
        }
    }
    SEAM(PH_ATA);
    if (IN(PH_T1)) {
        { pg8::Gemm g{XBF, WIN + (size_t)WT_Z * 1024, L, 1024, 1024, 1024, 1024}; pg8::StaticOrder S; S.init(L, 1024, G, bx);
          pg8::EpiZ E{OAB}; pg8::gemm_phase<pg8::EpiZ, pg8::StaticOrder, true, true>(lds, g, S, E); }
        { pg8::Gemm g{XBF, WIN + (size_t)WT_G * 1024, L, 2048, 1024, 1024, 1024}; pg8::StaticOrder S; S.init(L, 2048, G, bx);
          pg8::EpiG E{Gb}; pg8::gemm_phase<pg8::EpiG, pg8::StaticOrder, true, true>(lds, g, S, E); }
    }
    SEAM(PH_T1);
    if (IN(PH_T2)) {
        { pg8::Gemm g{OAB, WPA, L, 1024, 512, 1024, 512}; pg8::StaticOrder S; S.init(L, 1024, G, bx);
          pg8::EpiPA E{Gb, MRG}; pg8::gemm_phase<pg8::EpiPA, pg8::StaticOrder, true, true>(lds, g, S, E); }
        { pg8::Gemm g{OAB + 512, WPB, L, 1024, 512, 1024, 512}; pg8::StaticOrder S; S.init(L, 1024, G, bx);
          pg8::EpiPB E{Gb, MRG}; pg8::gemm_phase<pg8::EpiPB, pg8::StaticOrder, true, true>(lds, g, S, E); }
        { pg8::Gemm g{PBF, WPLE, L, 1024, 256, 256, 256}; pg8::StaticOrder S; S.init(L, 1024, G, bx);
          pg8::EpiStoreBf E{PLEO, 1024, 0}; pg8::gemm_phase<pg8::EpiStoreBf, pg8::StaticOrder, true, true>(lds, g, S, E); }
    }
    SEAM(PH_T2);
    if (IN(PH_T3)) {
        pg8::Gemm g{MRG, WO, L, 1024, 1024, 1024, 1024}; pg8::StaticOrder S; S.init(L, 1024, G, bx);
        pg8::EpiO E{a.x, a.out}; pg8::gemm_phase<pg8::EpiO, pg8::StaticOrder, true, true>(lds, g, S, E);
    }
    SEAM(PH_T3);
    if (IN(PH_T4)) {
        const int gw = bx * NWAVES + wave, NGW = G * NWAVES;
        for (int m = gw; m < L; m += NGW) ln_row(a.out + (size_t)m * 1024, a.ln_g, a.ln_b, XLN + (size_t)m * 1024, lane);
    }
    SEAM(PH_T4);
    if (IN(PH_T5)) {
        pg8::Gemm g{XLN, WGT, L, 1024, 1024, 1024, 1024}; pg8::StaticOrder S; S.init(L, 1024, G, bx);
        pg8::EpiGate E{a.out, PLEO}; pg8::gemm_phase<pg8::EpiGate, pg8::StaticOrder, true, true>(lds, g, S, E);
    }
#undef IN
#undef SEAM
}

extern "C" void kernel_launch(void* const* d_in, const int* in_sizes, int n_in, void* d_out, int out_size, void* d_ws, size_t ws_size, hipStream_t stream) {
    static int grid = 0;
    if (grid == 0) {
        if (ws_size < WS_END) { fprintf(stderr, "workspace too small: %zu\n", ws_size); grid = -1; return; }
        (void)hipFuncSetAttribute((const void*)mega, hipFuncAttributeMaxDynamicSharedMemorySize, LDS_BYTES);
        int dev = 0, cus = 0, per_cu = 0; (void)hipGetDevice(&dev); (void)hipDeviceGetAttribute(&cus, hipDeviceAttributeMultiprocessorCount, dev);
        (void)hipOccupancyMaxActiveBlocksPerMultiprocessor(&per_cu, (const void*)mega, NTHREADS, LDS_BYTES);
        if (per_cu < 1) fprintf(stderr, "kernel_launch: occupancy query reports %d workgroups per CU\n", per_cu);
        grid = cus > 0 ? cus : 256;
    }
    if (grid < 0) return;
    (void)hipMemsetAsync(d_ws, 0, 16384, stream);
    Args a{};
    a.x = (const float*)d_in[0]; a.p = (const float*)d_in[1]; a.w_in = (const float*)d_in[2]; a.w_pa = (const float*)d_in[3]; a.w_pb = (const float*)d_in[4]; a.w_o = (const float*)d_in[5];
    a.lqk = (const float*)d_in[6]; a.subw = (const float*)d_in[7]; a.ln_g = (const float*)d_in[8]; a.ln_b = (const float*)d_in[9];
    a.w_ple = (const float*)d_in[10]; a.w_gate = (const float*)d_in[11]; a.rel_bias = (const float*)d_in[12];
    a.out = (float*)d_out; a.ws = (unsigned char*)d_ws; a.ph_lo = 0; a.ph_hi = PH_N;
    void* args[] = {&a};
    const hipError_t e = hipLaunchCooperativeKernel((const void*)mega, dim3(grid), dim3(NTHREADS), args, LDS_BYTES, stream);
    if (e != hipSuccess) fprintf(stderr, "cooperative launch failed: %s (grid %d)\n", hipGetErrorString(e), grid);
}
```

```cpp
#include <hip/hip_runtime.h>
#include <hip/hip_cooperative_groups.h>
#include <cstdint>
#include <cstdio>

typedef unsigned short bf16_t;
typedef unsigned u32x4 __attribute__((ext_vector_type(4)));
typedef unsigned u32x2 __attribute__((ext_vector_type(2)));

constexpr int L = 16384, DM = 1024, PLE = 256;
constexpr int IN_COLS = 6728;
constexpr int NTOK = 2816;
constexpr int C_AQ = 0, C_AK = 512, C_BQ = 1024, C_BK = 1536, C_IQ = 2048, C_IK = 2560, C_IW = 2624;
constexpr int WT_TOK = 0, WT_VT = 2816, WT_Z = 3840, WT_G = 4864, WT_ROWS = 6912;
constexpr float ALPHA = 1.18920711500272f;
constexpr float LAM_INIT = 0.2f;

constexpr size_t MiB = 1u << 20;
constexpr size_t WS_CTL = 0;
constexpr size_t WS_BT = 512 * 1024;
constexpr size_t WS_WIN = 1 * MiB;
constexpr size_t WS_WPA = 15 * MiB;
constexpr size_t WS_WPB = 16 * MiB;
constexpr size_t WS_WO = 17 * MiB;
constexpr size_t WS_WGT = 19 * MiB;
constexpr size_t WS_WPLE = 21 * MiB;
constexpr size_t WS_XBF = 22 * MiB;
constexpr size_t WS_PBF = 54 * MiB;
constexpr size_t WS_QK = 62 * MiB;
constexpr size_t WS_VT = 154 * MiB;
constexpr size_t WS_BMP = 186 * MiB;
constexpr size_t WS_OAB = 218 * MiB;
constexpr size_t WS_END = 250 * MiB;
constexpr size_t WS_PLEO = WS_XBF, WS_G = WS_QK, WS_MRG = WS_VT, WS_XLN = WS_BMP;

__device__ __forceinline__ float bf2f(bf16_t v) { return __uint_as_float(((unsigned)v) << 16); }
__device__ __forceinline__ bf16_t f2bf(float f) { unsigned u = __float_as_uint(f); return (bf16_t)((u + 0x7fffu + ((u >> 16) & 1u)) >> 16); }
__device__ __forceinline__ float sigmoidf_(float v) { return 1.f / (1.f + __expf(-v)); }
__device__ __forceinline__ float siluf_(float v) { return v / (1.f + __expf(-v)); }

__host__ __device__ __forceinline__ int win_src_col(int n) {
    if (n < WT_VT) {
        if (n < 512) return n;
        if (n < 1024) return n;
        if (n < 1536) return 2632 + (n - 1024);
        if (n < 2048) return 3144 + (n - 1536);
        if (n < 2560) return 2048 + (n - 2048);
        if (n < 2624) return 2560 + (n - 2560);
        if (n < 2632) return 2624 + (n - 2624);
        return -1;
    }
    if (n < WT_Z) { int r = n - WT_VT; return r < 512 ? 1024 + r : 3656 + (r - 512); }
    if (n < WT_G) { int r = n - WT_Z; return r < 512 ? 1536 + r : 4168 + (r - 512); }
    return 4680 + (n - WT_G);
}

__device__ __forceinline__ int rel_bucket(int n) {
    if (n < 16) return n;
    int b = 16 + (int)(logf((float)n / 16.f) / logf(8.f) * 16.f);
    return b > 31 ? 31 : b;
}
namespace pg8 {
#define PG8_LAS __attribute__((address_space(3)))
typedef unsigned short bf16_t;
typedef short bf16x8 __attribute__((ext_vector_type(8)));
typedef float f32x4 __attribute__((ext_vector_type(4)));
typedef unsigned u32x4 __attribute__((ext_vector_type(4)));
constexpr int BM = 256, BK = 64, HALF = 128, HTB = HALF * BK * 2  , STAGE_BYTES = 8 * HTB, NXCD = 8, WGM = 8;

__host__ __device__ __forceinline__ int lds_byte(int r, int c) { const int st = (r >> 4) * 2 + (c >> 5), rr = r & 15, cc = c & 31, ob = rr * 64 + cc * 2; return st * 1024 + (ob ^ (((ob >> 9) & 1) << 5)); }
__host__ __device__ __forceinline__ void stage_rc(int b, int& R, int& C) { const int st = b / 1024, sb = b % 1024, swz = sb ^ (((sb >> 9) & 1) << 5); R = (st >> 1) * 16 + swz / 64; C = (st & 1) * 32 + (swz % 64) / 2; }
__host__ __device__ __forceinline__ int perm32(int rho) { const int n = rho >> 4, i = rho & 15; return 8 * (i >> 2) + 4 * n + (i & 3); }

struct Unit { int pm, pn; };
struct Gemm { const bf16_t* A; const bf16_t* Bt; int M, N, K, lda, ldb; };

struct StaticOrder {
    int nM, nN, nwg, G, c;
    __host__ __device__ void init(int M, int N, int G_, int c_) { nM = M / BM; nN = N / BM; nwg = nM * nN; G = G_; c = c_; }
    __host__ __device__ bool next(int i, Unit& u) const {
        const long L = (long)i * G + c; if (L >= nwg) return false;
        int wgid = (int)L; { const int q = nwg / NXCD, r = nwg % NXCD, xcd = wgid % NXCD, off = wgid / NXCD; wgid = (xcd < r ? xcd * (q + 1) : r * (q + 1) + (xcd - r) * q) + off; }
        const int nig = WGM * nN, gid = wgid / nig, fm = gid * WGM, gsz = (nM - fm) < WGM ? (nM - fm) : WGM;
        u.pm = fm + ((wgid % nig) % gsz); u.pn = (wgid % nig) / gsz; return true;
    }
    __device__ __forceinline__ void a_ready(const Unit&) const {}
    __device__ __forceinline__ void done(const Unit&) const {}
};


typedef float f32x2_t __attribute__((ext_vector_type(2))); typedef __bf16 bf16x2_t __attribute__((ext_vector_type(2)));
__device__ __forceinline__ unsigned cvt_pk_bf16(float lo, float hi) { f32x2_t v = {lo, hi}; bf16x2_t b = __builtin_convertvector(v, bf16x2_t); return __builtin_bit_cast(unsigned, b); }
__device__ __forceinline__ u32x4 pack8(const f32x4 a, const f32x4 b) { u32x4 w; w.x = cvt_pk_bf16(a[0], a[1]); w.y = cvt_pk_bf16(a[2], a[3]); w.z = cvt_pk_bf16(b[0], b[1]); w.w = cvt_pk_bf16(b[2], b[3]); return w; }
__device__ __forceinline__ void unpack8(const u32x4 w, f32x4& a, f32x4& b) {
    a[0] = __uint_as_float(w.x << 16); a[1] = __uint_as_float(w.x & 0xffff0000u); a[2] = __uint_as_float(w.y << 16); a[3] = __uint_as_float(w.y & 0xffff0000u);
    b[0] = __uint_as_float(w.z << 16); b[1] = __uint_as_float(w.z & 0xffff0000u); b[2] = __uint_as_float(w.w << 16); b[3] = __uint_as_float(w.w & 0xffff0000u); }
__device__ __forceinline__ float fsig(float v) { return __builtin_amdgcn_rcpf(1.f + __expf(-v)); }
__device__ __forceinline__ f32x4 sig4(const f32x4 v) { f32x4 r; r[0] = fsig(v[0]); r[1] = fsig(v[1]); r[2] = fsig(v[2]); r[3] = fsig(v[3]); return r; }
#define PG8_EPI_LOOP(...) \
    _Pragma("unroll") for (int ai = 0; ai < 2; ++ai) _Pragma("unroll") for (int m = 0; m < 4; ++m) { const size_t row = (size_t)(u.pm * BM + ai * HALF + wr * 64 + m * 16 + fr); \
    _Pragma("unroll") for (int bj = 0; bj < 2; ++bj) { const int col = u.pn * BM + bj * HALF + wc * 32 + 8 * fq; f32x4 v0 = acc[ai][bj][m][0], v1 = acc[ai][bj][m][1]; __VA_ARGS__ } }
#define PG8_EPI_SIG const f32x4 (&acc)[2][2][4][2], const Unit& u, int wr, int wc, int fr, int fq
struct EpiStoreBf { static constexpr bool PERM = true, AFTER_DRAIN = false; bf16_t* O; int ldc, pad;
    __device__ __forceinline__ void operator()(PG8_EPI_SIG) const { PG8_EPI_LOOP( *(u32x4*)(O + row * ldc + col) = pack8(v0, v1); ) } };
struct EpiVTdual { static constexpr bool PERM = true, AFTER_DRAIN = false; bf16_t* VT; bf16_t* VTOK;
    __device__ __forceinline__ void operator()(PG8_EPI_SIG) const { PG8_EPI_LOOP( const u32x4 w = pack8(v0, v1); *(u32x4*)(VT + row * 16384 + col) = w;
        if (VTOK) { VTOK[(size_t)(col + 0) * 1024 + row] = (bf16_t)(w.x & 0xffff); VTOK[(size_t)(col + 1) * 1024 + row] = (bf16_t)(w.x >> 16); VTOK[(size_t)(col + 2) * 1024 + row] = (bf16_t)(w.y & 0xffff); VTOK[(size_t)(col + 3) * 1024 + row] = (bf16_t)(w.y >> 16);
                    VTOK[(size_t)(col + 4) * 1024 + row] = (bf16_t)(w.z & 0xffff); VTOK[(size_t)(col + 5) * 1024 + row] = (bf16_t)(w.z >> 16); VTOK[(size_t)(col + 6) * 1024 + row] = (bf16_t)(w.w & 0xffff); VTOK[(size_t)(col + 7) * 1024 + row] = (bf16_t)(w.w >> 16); } ) } };
struct EpiZ { static constexpr bool PERM = true, AFTER_DRAIN = false; bf16_t* OAB;
    __device__ __forceinline__ void operator()(PG8_EPI_SIG) const { PG8_EPI_LOOP( u32x4* p = (u32x4*)(OAB + row * 1024 + col); f32x4 o0, o1; unpack8(*p, o0, o1);
        *p = pack8(v0 * sig4(v0) * o0, v1 * sig4(v1) * o1); ) } };
struct EpiG { static constexpr bool PERM = true, AFTER_DRAIN = false; bf16_t* G;
    __device__ __forceinline__ void operator()(PG8_EPI_SIG) const { PG8_EPI_LOOP( *(u32x4*)(G + row * 2048 + col) = pack8(sig4(v0), sig4(v1)); ) } };
struct EpiPA { static constexpr bool PERM = true, AFTER_DRAIN = false; const bf16_t* G; bf16_t* MRG;
    __device__ __forceinline__ void operator()(PG8_EPI_SIG) const { PG8_EPI_LOOP( f32x4 g0, g1; unpack8(*(const u32x4*)(G + row * 2048 + col), g0, g1);
        *(u32x4*)(MRG + row * 1024 + col) = pack8(g0 * v0, g1 * v1); ) } };
struct EpiPB { static constexpr bool PERM = true, AFTER_DRAIN = false; const bf16_t* G; bf16_t* MRG;
    __device__ __forceinline__ void operator()(PG8_EPI_SIG) const { PG8_EPI_LOOP( f32x4 g0, g1, m0, m1; unpack8(*(const u32x4*)(G + row * 2048 + 1024 + col), g0, g1);
        u32x4* p = (u32x4*)(MRG + row * 1024 + col); unpack8(*p, m0, m1); *p = pack8(m0 + g0 * v0, m1 + g1 * v1); ) } };
struct EpiO { static constexpr bool PERM = true, AFTER_DRAIN = false; const float* x; float* PRE;
    __device__ __forceinline__ void operator()(PG8_EPI_SIG) const { PG8_EPI_LOOP( const f32x4 x0 = *(const f32x4*)(x + row * 1024 + col), x1 = *(const f32x4*)(x + row * 1024 + col + 4);
        *(f32x4*)(PRE + row * 1024 + col) = x0 * 1.18920711500272f + v0; *(f32x4*)(PRE + row * 1024 + col + 4) = x1 * 1.18920711500272f + v1; ) } };
struct EpiGate { static constexpr bool PERM = true, AFTER_DRAIN = false; float* out; const bf16_t* PLEO;
    __device__ __forceinline__ void operator()(PG8_EPI_SIG) const { PG8_EPI_LOOP( f32x4 p0, p1; unpack8(*(const u32x4*)(PLEO + row * 1024 + col), p0, p1);
        f32x4* o = (f32x4*)(out + row * 1024 + col); const f32x4 a0 = o[0], a1 = o[1]; o[0] = a0 + sig4(v0) * p0; o[1] = a1 + sig4(v1) * p1; ) } };

template <class Epi, class Sched, bool ALIGN_EPI = false, bool SP2 = false>
__device__ __forceinline__ void gemm_phase(PG8_LAS unsigned char* lds, const Gemm g, const Sched& S, const Epi& E) {
    const int tid = threadIdx.x, wid = __builtin_amdgcn_readfirstlane(tid >> 6), lane = tid & 63, wr = wid >> 2, wc = wid & 3, fr = lane & 15, fq = lane >> 4;
    const int K = g.K, nt = K / BK;
    unsigned voffA[2], voffB[2];
#pragma unroll
    for (int i = 0; i < 2; ++i) { int R, C; stage_rc(tid * 16 + i * 8192, R, C); const int Rb = Epi::PERM ? ((R & ~31) + perm32(R & 31)) : R;
        voffA[i] = (unsigned)(R * g.lda + C) * 2u; voffB[i] = (unsigned)(Rb * g.ldb + C) * 2u; }
    const size_t kstep = (size_t)(BK * 2);
    const size_t hstepA = (size_t)HALF * g.lda * 2, hstepB = (size_t)HALF * g.ldb * 2;
    const size_t tstepA = 2 * hstepA, tstepB = 2 * hstepB;
    const unsigned ldsw = (unsigned)wid * 1024u;
    const int aoff = lds_byte(wr * 64 + fr, fq * 8), boff = lds_byte(wc * 32 + fr, fq * 8);
#define PG8_SA(b, h) (((b) * 2 + (h)) * HTB)
#define PG8_SB(b, h) ((4 + (b) * 2 + (h)) * HTB)
#define PG8_STAGE(bufoff, gbase, voff) do { _Pragma("unroll") for (int _i = 0; _i < 2; ++_i) \
        __builtin_amdgcn_global_load_lds((const unsigned*)((const char*)(gbase) + (voff)[_i]), (PG8_LAS unsigned*)(lds + (bufoff) + ldsw + _i * 8192), 16, 0, 0); } while (0)
#define PG8_LDA(dst, b, h) do { _Pragma("unroll") for (int m = 0; m < 4; ++m) _Pragma("unroll") for (int k = 0; k < 2; ++k) dst[m][k] = *(const PG8_LAS bf16x8*)(lds + PG8_SA(b, h) + aoff + m * 2048 + k * 1024); } while (0)
#define PG8_LDB(dst, b, h) do { _Pragma("unroll") for (int n = 0; n < 2; ++n) _Pragma("unroll") for (int k = 0; k < 2; ++k) dst[n][k] = *(const PG8_LAS bf16x8*)(lds + PG8_SB(b, h) + boff + n * 2048 + k * 1024); } while (0)
#define PG8_MMA(ai, bj, At, Bt) do { __builtin_amdgcn_s_setprio(1); _Pragma("unroll") for (int m = 0; m < 4; ++m) _Pragma("unroll") for (int n = 0; n < 2; ++n) _Pragma("unroll") for (int k = 0; k < 2; ++k) \
        acc[ai][bj][m][n] = __builtin_amdgcn_mfma_f32_16x16x32_bf16(Bt[n][k], At[m][k], acc[ai][bj][m][n], 0, 0, 0); __builtin_amdgcn_s_setprio(0); } while (0)
#define PG8_WAIT_V(n) asm volatile("s_waitcnt vmcnt(" #n ")" ::: "memory")
#define PG8_WAIT_L(n) asm volatile("s_waitcnt lgkmcnt(" #n ")" ::: "memory")
#define PG8_BAR __builtin_amdgcn_s_barrier()
#define PG8_SCHED __builtin_amdgcn_sched_barrier(0)
    Unit cur, nxt; int ui = 0;
    if (!S.next(0, cur)) return;
    f32x4 acc[2][2][4][2];
#pragma unroll
    for (int a = 0; a < 2; ++a)
#pragma unroll
        for (int b = 0; b < 2; ++b)
#pragma unroll
            for (int m = 0; m < 4; ++m)
#pragma unroll
                for (int n = 0; n < 2; ++n) acc[a][b][m][n] = (f32x4){0.f, 0.f, 0.f, 0.f};
    bf16x8 At[4][2], B0[2][2], B1[2][2];
    const char* cA = (const char*)g.A + (size_t)cur.pm * tstepA; const char* cB = (const char*)g.Bt + (size_t)cur.pn * tstepB;
    S.a_ready(cur);
    if constexpr (SP2) {
        PG8_STAGE(PG8_SB(0, 0), cB, voffB); PG8_STAGE(PG8_SB(0, 1), cB + hstepB, voffB); PG8_STAGE(PG8_SA(0, 0), cA, voffA); PG8_STAGE(PG8_SA(0, 1), cA + hstepA, voffA);
        if (wr == 1) PG8_BAR;
        PG8_WAIT_V(2); PG8_BAR;
        PG8_STAGE(PG8_SB(1, 0), cB + kstep, voffB); PG8_STAGE(PG8_SA(1, 0), cA + kstep, voffA); PG8_STAGE(PG8_SB(1, 1), cB + hstepB + kstep, voffB);
        PG8_WAIT_V(6); PG8_BAR;
    } else {
        PG8_STAGE(PG8_SB(0, 0), cB, voffB); PG8_STAGE(PG8_SA(0, 0), cA, voffA); PG8_STAGE(PG8_SB(0, 1), cB + hstepB, voffB); PG8_STAGE(PG8_SA(0, 1), cA + hstepA, voffA);
        if (wr == 1) PG8_BAR;
        PG8_WAIT_V(4); PG8_BAR;
        PG8_STAGE(PG8_SB(1, 0), cB + kstep, voffB); PG8_STAGE(PG8_SA(1, 0), cA + kstep, voffA); PG8_STAGE(PG8_SB(1, 1), cB + hstepB + kstep, voffB);
        PG8_WAIT_V(6); PG8_BAR;
    }
    for (;;) {
        const bool has_next = S.next(ui + 1, nxt);
        const char* nA = has_next ? (const char*)g.A + (size_t)nxt.pm * tstepA : cA; const char* nB = has_next ? (const char*)g.Bt + (size_t)nxt.pn * tstepB : cB;
        for (int t = 0; t < nt; t += 2) {
            const bool last = (t == nt - 2);
            const char* a1 = cA + (size_t)(t + 1) * kstep;
            const char* a2 = last ? nA : cA + (size_t)(t + 2) * kstep; const char* b2 = last ? nB : cB + (size_t)(t + 2) * kstep;
            const char* a3 = a2 + kstep; const char* b3 = b2 + kstep;
            if (last && has_next) S.a_ready(nxt);
            if constexpr (SP2) {
            PG8_LDB(B0, 0, 0); PG8_LDB(B1, 0, 1); PG8_SCHED; PG8_LDA(At, 0, 0); PG8_STAGE(PG8_SA(1, 1), a1 + hstepA, voffA);
            PG8_WAIT_V(8); PG8_WAIT_L(0); PG8_BAR; PG8_MMA(0, 0, At, B0); PG8_MMA(0, 1, At, B1); PG8_BAR; PG8_SCHED;
            PG8_LDA(At, 0, 1); PG8_STAGE(PG8_SB(0, 0), b2, voffB); PG8_STAGE(PG8_SB(0, 1), b2 + hstepB, voffB); PG8_STAGE(PG8_SA(0, 0), a2, voffA);
            PG8_WAIT_V(8); PG8_WAIT_L(0); PG8_BAR; PG8_MMA(1, 0, At, B0); PG8_MMA(1, 1, At, B1); PG8_BAR; PG8_SCHED;
            PG8_LDB(B0, 1, 0); PG8_LDB(B1, 1, 1); PG8_SCHED; PG8_LDA(At, 1, 0); PG8_STAGE(PG8_SA(0, 1), a2 + hstepA, voffA);
            PG8_WAIT_V(8); PG8_WAIT_L(0); PG8_BAR; PG8_MMA(0, 0, At, B0); PG8_MMA(0, 1, At, B1); PG8_BAR; PG8_SCHED;
            PG8_LDA(At, 1, 1); PG8_STAGE(PG8_SB(1, 0), b3, voffB); PG8_STAGE(PG8_SB(1, 1), b3 + hstepB, voffB); PG8_STAGE(PG8_SA(1, 0), a3, voffA);
            PG8_WAIT_V(8); PG8_WAIT_L(0); PG8_BAR; PG8_MMA(1, 0, At, B0); PG8_MMA(1, 1, At, B1); PG8_BAR; PG8_SCHED;
            } else {
            PG8_LDB(B0, 0, 0); PG8_SCHED; PG8_LDA(At, 0, 0); PG8_STAGE(PG8_SA(1, 1), a1 + hstepA, voffA);
            PG8_WAIT_L(8); PG8_BAR; PG8_WAIT_L(0); PG8_MMA(0, 0, At, B0); PG8_BAR; PG8_SCHED;
            PG8_LDB(B1, 0, 1); PG8_STAGE(PG8_SB(0, 0), b2, voffB);
            PG8_BAR; PG8_WAIT_L(0); PG8_MMA(0, 1, At, B1); PG8_BAR;
            PG8_LDA(At, 0, 1); PG8_STAGE(PG8_SA(0, 0), a2, voffA);
            PG8_BAR; PG8_WAIT_L(0); PG8_MMA(1, 0, At, B0); PG8_BAR; PG8_SCHED;
            PG8_STAGE(PG8_SB(0, 1), b2 + hstepB, voffB);
            PG8_WAIT_V(6); PG8_BAR; PG8_MMA(1, 1, At, B1); PG8_BAR;
            PG8_LDB(B0, 1, 0); PG8_SCHED; PG8_LDA(At, 1, 0); PG8_STAGE(PG8_SA(0, 1), a2 + hstepA, voffA);
            PG8_WAIT_L(8); PG8_BAR; PG8_WAIT_L(0); PG8_MMA(0, 0, At, B0); PG8_BAR; PG8_SCHED;
            PG8_LDB(B1, 1, 1); PG8_STAGE(PG8_SB(1, 0), b3, voffB);
            PG8_BAR; PG8_WAIT_L(0); PG8_MMA(0, 1, At, B1); PG8_BAR;
            PG8_LDA(At, 1, 1); PG8_STAGE(PG8_SA(1, 0), a3, voffA);
            PG8_BAR; PG8_WAIT_L(0); PG8_MMA(1, 0, At, B0); PG8_BAR; PG8_SCHED;
            PG8_STAGE(PG8_SB(1, 1), b3 + hstepB, voffB);
            PG8_WAIT_V(6); PG8_BAR; PG8_MMA(1, 1, At, B1); PG8_BAR;
            }
        }
        if constexpr (ALIGN_EPI) { if (wr == 0) PG8_BAR; }
        if constexpr (!Epi::AFTER_DRAIN) { E(acc, cur, wr, wc, fr, fq); S.done(cur); }
        if (!has_next) break;
#pragma unroll
        for (int a = 0; a < 2; ++a)
#pragma unroll
            for (int b = 0; b < 2; ++b)
#pragma unroll
                for (int m = 0; m < 4; ++m)
#pragma unroll
                    for (int n = 0; n < 2; ++n) acc[a][b][m][n] = (f32x4){0.f, 0.f, 0.f, 0.f};
        cur = nxt; cA = nA; cB = nB; ++ui;
        if constexpr (ALIGN_EPI) { if (wr == 1) PG8_BAR; }
    }
    PG8_WAIT_V(0);
    if constexpr (!ALIGN_EPI) { if (wr == 0) PG8_BAR; }
    PG8_BAR;
    if constexpr (Epi::AFTER_DRAIN) { E.fused(acc, cur, wr, wc, fr, fq, lds, wid, lane); S.done(cur); }
#undef PG8_SA
#undef PG8_SB
#undef PG8_STAGE
#undef PG8_LDA
#undef PG8_LDB
#undef PG8_MMA
#undef PG8_WAIT_V
#undef PG8_WAIT_L
#undef PG8_BAR
#undef PG8_SCHED
}
}

#define LAS __attribute__((address_space(3)))
namespace att {
typedef short bf16x8 __attribute__((ext_vector_type(8)));
typedef float f32x16 __attribute__((ext_vector_type(16)));
typedef float f32x2_t __attribute__((ext_vector_type(2))); typedef __bf16 bf16x2_t __attribute__((ext_vector_type(2)));
__device__ __forceinline__ unsigned cvtpk(float lo, float hi) { f32x2_t v = {lo, hi}; bf16x2_t b = __builtin_convertvector(v, bf16x2_t); return __builtin_bit_cast(unsigned, b); }
constexpr int KP = 144;
constexpr float LOG2E = 1.4426950408889634f, CSC = 0.125f * LOG2E, THR = 6.0f;
__device__ __forceinline__ int crow(int r, int hi) { return (r & 3) + 8 * (r >> 2) + 4 * hi; }

template <int MODE>
__device__ __forceinline__ void attn_unit(LAS unsigned char* lds, int h, int qb, const bf16_t* __restrict__ QK, const bf16_t* __restrict__ VT, const unsigned* __restrict__ BMP,
                                          const float* __restrict__ BT, const float* __restrict__ subw, float lam, bf16_t* __restrict__ OAB) {
    constexpr int DV = MODE ? 128 : 64, QB = MODE ? 128 : 256, NDT = DV / 32, NKT = MODE ? 2 : 1;
    constexpr int KBYTES = 64 * KP, VBYTES = DV * KP, KRING = NKT * KBYTES, OFF_V = 3 * KRING;
    constexpr int OFF_BIAS = OFF_V + 2 * VBYTES;
    const int tid = threadIdx.x, lane = tid & 63, wave = __builtin_amdgcn_readfirstlane(tid >> 6), ql = lane & 31, hi = lane >> 5;
    const int qw = MODE ? (wave & 3) : wave, map = MODE ? (wave >> 2) : 0;
    const int q0 = qb * QB, qw0 = q0 + 32 * qw, t = qw0 + ql;
    const int qcol = MODE ? C_BQ + (2 * h + map) * 64 : C_AQ + h * 64;
    const int kcol0 = MODE ? C_BK + (2 * h) * 64 : C_AK + h * 64;
    const int vrow0 = MODE ? 512 + h * 128 : h * 64;
    const int hb = MODE ? 8 + h : h;
    LAS float* bias2 = (LAS float*)(lds + OFF_BIAS);
    if (tid < 128) bias2[tid] = BT[tid * 12 + hb] * LOG2E;
    bf16x8 qf[4];
#pragma unroll
    for (int ks = 0; ks < 4; ++ks) qf[ks] = *(const bf16x8*)(QK + (size_t)t * NTOK + qcol + 16 * ks + 8 * hi);
    const int pr = tid >> 3, pc = tid & 7;
    u32x4 sk[NKT], sv[NKT];
    const int NT = (q0 + QB) / 64;
#define AT_GLOADK(kt) do { _Pragma("unroll") for (int i_ = 0; i_ < NKT; ++i_) sk[i_] = *(const u32x4*)(QK + (size_t)((kt) * 64 + pr) * NTOK + kcol0 + i_ * 64 + pc * 8); } while (0)
#define AT_GLOADV(kt) do { _Pragma("unroll") for (int i_ = 0; i_ < NKT; ++i_) sv[i_] = *(const u32x4*)(VT + (size_t)(vrow0 + pr + 64 * i_) * L + (kt) * 64 + pc * 8); } while (0)
#define AT_LSTOREK(buf) do { _Pragma("unroll") for (int i_ = 0; i_ < NKT; ++i_) *(LAS u32x4*)(lds + (buf) * KRING + i_ * KBYTES + pr * KP + pc * 16) = sk[i_]; } while (0)
#define AT_LSTOREV(buf) do { _Pragma("unroll") for (int i_ = 0; i_ < NKT; ++i_) *(LAS u32x4*)(lds + OFF_V + (buf) * VBYTES + (pr + 64 * i_) * KP + pc * 16) = sv[i_]; } while (0)
#define AT_QK(Sx, buf, j) do { const LAS unsigned char* kb_ = lds + (buf) * KRING + (MODE ? map * KBYTES : 0); \
        _Pragma("unroll") for (int r = 0; r < 16; ++r) Sx[r] = 0.f; \
        _Pragma("unroll") for (int ks = 0; ks < 4; ++ks) { const bf16x8 kf = *(const LAS bf16x8*)(kb_ + (32 * (j) + kperm) * KP + (16 * ks + 8 * hi) * 2); \
            Sx = __builtin_amdgcn_mfma_f32_32x32x16_bf16(kf, qf[ks], Sx, 0, 0, 0); } } while (0)
    f32x16 O[NDT];
#pragma unroll
    for (int d = 0; d < NDT; ++d)
#pragma unroll
        for (int r = 0; r < 16; ++r) O[d][r] = 0.f;
    float m_run = -INFINITY, l_run = 0.f;
    const int kperm = (ql & 0x13) | ((ql & 4) << 1) | ((ql & 8) >> 1);
    AT_GLOADK(0); AT_GLOADV(0); AT_LSTOREK(0); AT_LSTOREV(0);
    if (NT > 1) { AT_GLOADK(1); AT_LSTOREK(1); }
    __syncthreads();
    const float b31 = bias2[127];
    u32x2 mw = {0u, 0u};
    if (MODE == 0) mw = *(const u32x2*)(BMP + (size_t)t * 512);
    f32x16 S, Sn;
    AT_QK(S, 0, 0);
    int k3 = 0, kt = 0;
    const int NF = (q0 >= 176) ? (((q0 - 176) >> 6) + 1 < NT - 2 ? ((q0 - 176) >> 6) + 1 : NT - 2) : 0;
#define AT_ROWMAX(Sx, mxv) do { float a_ = __builtin_fmaxf(Sx[0], Sx[1]), b_ = __builtin_fmaxf(Sx[2], Sx[3]); \
        _Pragma("unroll") for (int r = 4; r < 16; r += 4) { a_ = __builtin_fmaxf(__builtin_fmaxf(Sx[r], Sx[r + 1]), a_); b_ = __builtin_fmaxf(__builtin_fmaxf(Sx[r + 2], Sx[r + 3]), b_); } \
        float m_ = fmaf(__builtin_fmaxf(a_, b_), CSC, b31); \
        auto rr_ = __builtin_amdgcn_permlane32_swap(__float_as_uint(m_), __float_as_uint(m_), false, false); \
        mxv = __builtin_fmaxf(__uint_as_float(rr_[0]), __uint_as_float(rr_[1])); } while (0)
#define AT_RESCALE(mxv) do { const bool need_ = mxv > m_run + THR; \
        if (__any(need_)) { const float m_new = need_ ? mxv : m_run; const float alpha = (m_new == m_run) ? 1.f : __builtin_amdgcn_exp2f(m_run - m_new); l_run *= alpha; \
            _Pragma("unroll") for (int d = 0; d < NDT; ++d) _Pragma("unroll") for (int r = 0; r < 16; ++r) O[d][r] *= alpha; \
            m_run = m_new; } } while (0)
    if (NF > 0) { float mx0; AT_ROWMAX(S, mx0); AT_RESCALE(mx0); }
    for (; kt < NF; ++kt) {
        const int cur = kt & 1, k3n = (k3 == 2) ? 0 : k3 + 1, k3nn = (k3n == 2) ? 0 : k3n + 1;
        AT_GLOADK(kt + 2); AT_GLOADV(kt + 1);
        u32x2 mwn = {0u, 0u};
        if (MODE == 0) mwn = *(const u32x2*)(BMP + (size_t)t * 512 + 2 * (kt + 1));
        const LAS unsigned char* vb = lds + OFF_V + cur * VBYTES;
#pragma unroll
        for (int j = 0; j < 2; ++j) {
            if (j == 0) AT_QK(Sn, k3, 1); else AT_QK(Sn, k3n, 0);
            const float nb = b31 - m_run;
#pragma unroll
            for (int r = 0; r < 16; ++r) S[r] = __builtin_amdgcn_exp2f(fmaf(S[r], CSC, nb));
            if (MODE == 0) { const unsigned w = (j ? mw.y : mw.x) >> (8 * hi);
#pragma unroll
                for (int r = 0; r < 16; ++r) S[r] = __uint_as_float(__float_as_uint(S[r]) & (unsigned)__builtin_amdgcn_sbfe((int)w, 16 * (r >> 3) + (r & 7), 1)); }
            float ls0 = 0.f, ls1 = 0.f;
#pragma unroll
            for (int r = 0; r < 16; r += 2) { ls0 += S[r]; ls1 += S[r + 1]; }
            l_run += ls0 + ls1;
            bf16x8 pb[2];
#pragma unroll
            for (int s2 = 0; s2 < 2; ++s2) { const int o = 8 * s2; u32x4 w;
                w.x = cvtpk(S[o + 0], S[o + 1]); w.y = cvtpk(S[o + 2], S[o + 3]); w.z = cvtpk(S[o + 4], S[o + 5]); w.w = cvtpk(S[o + 6], S[o + 7]);
                pb[s2] = __builtin_bit_cast(bf16x8, w); }
#pragma unroll
            for (int d = 0; d < NDT; ++d)
#pragma unroll
                for (int s2 = 0; s2 < 2; ++s2) {
                    const bf16x8 vf = *(const LAS bf16x8*)(vb + (32 * d + ql) * KP + (32 * j + 16 * s2 + 8 * hi) * 2);
                    O[d] = __builtin_amdgcn_mfma_f32_32x32x16_bf16(vf, pb[s2], O[d], 0, 0, 0);
                }
            float mxn; AT_ROWMAX(Sn, mxn); AT_RESCALE(mxn);
            S = Sn;
        }
        AT_LSTOREK(k3nn); AT_LSTOREV(cur ^ 1);
        k3 = k3n; mw = mwn;
        __syncthreads();
    }
    for (; kt < NT; ++kt) {
        const int cur = kt & 1, k0 = kt * 64, k3n = (k3 == 2) ? 0 : k3 + 1, k3nn = (k3n == 2) ? 0 : k3n + 1;
        const bool more1 = kt + 1 < NT, more2 = kt + 2 < NT;
        if (more2) AT_GLOADK(kt + 2);
        if (more1) AT_GLOADV(kt + 1);
        u32x2 mwn = {0u, 0u};
        if (MODE == 0 && more1) mwn = *(const u32x2*)(BMP + (size_t)t * 512 + 2 * (kt + 1));
#pragma unroll
        for (int j = 0; j < 2; ++j) {
            const int kj = k0 + 32 * j;
            if (j == 0) { if (kj + 32 <= qw0 + 31) AT_QK(Sn, k3, 1); }
            else        { if (more1 && (kj + 32 <= qw0 + 31)) AT_QK(Sn, k3n, 0); }
            if (kj <= qw0 + 31) {
                const LAS unsigned char* vb = lds + OFF_V + cur * VBYTES;
                const bool nearb = (qw0 - (kj + 31)) < 113;
                float mx = -INFINITY;
                if (nearb) {
#pragma unroll
                    for (int r = 0; r < 16; ++r) {
                        const int key = kj + 16 * (r >> 3) + 8 * hi + (r & 7); const int dist = t - key;
                        const float bb = bias2[dist < 0 ? 0 : (dist > 127 ? 127 : dist)];
                        const float e = dist < 0 ? -INFINITY : fmaf(S[r], CSC, bb);
                        S[r] = e; mx = fmaxf(mx, e);
                    }
                } else {
#pragma unroll
                    for (int r = 0; r < 16; r += 2) mx = __builtin_fmaxf(__builtin_fmaxf(S[r], S[r + 1]), mx);
                    mx = fmaf(mx, CSC, b31);
                }
                mx = fmaxf(mx, __shfl_xor(mx, 32));
                const bool need = mx > m_run + THR;
                if (__any(need)) {
                    const float m_new = need ? mx : m_run;
                    const float alpha = (m_new == m_run) ? 1.f : __builtin_amdgcn_exp2f(m_run - m_new);
                    l_run *= alpha;
#pragma unroll
                    for (int d = 0; d < NDT; ++d)
#pragma unroll
                        for (int r = 0; r < 16; ++r) O[d][r] *= alpha;
                    m_run = m_new;
                }
                if (nearb) {
#pragma unroll
                    for (int r = 0; r < 16; ++r) S[r] = __builtin_amdgcn_exp2f(S[r] - m_run);
                } else {
                    const float nb = b31 - m_run;
#pragma unroll
                    for (int r = 0; r < 16; ++r) S[r] = __builtin_amdgcn_exp2f(fmaf(S[r], CSC, nb));
                }
                if (MODE == 0) {
                    const unsigned w = (j ? mw.y : mw.x) >> (8 * hi);
#pragma unroll
                    for (int r = 0; r < 16; ++r) S[r] = __uint_as_float(__float_as_uint(S[r]) & (unsigned)__builtin_amdgcn_sbfe((int)w, 16 * (r >> 3) + (r & 7), 1));
                }
                float ls0 = 0.f, ls1 = 0.f;
#pragma unroll
                for (int r = 0; r < 16; r += 2) { ls0 += S[r]; ls1 += S[r + 1]; }
                l_run += ls0 + ls1;
                bf16x8 pb[2];
#pragma unroll
                for (int s = 0; s < 2; ++s) { const int o = 8 * s; u32x4 w;
                    w.x = cvtpk(S[o + 0], S[o + 1]); w.y = cvtpk(S[o + 2], S[o + 3]); w.z = cvtpk(S[o + 4], S[o + 5]); w.w = cvtpk(S[o + 6], S[o + 7]);
                    pb[s] = __builtin_bit_cast(bf16x8, w); }
#pragma unroll
                for (int d = 0; d < NDT; ++d)
#pragma unroll
                    for (int s = 0; s < 2; ++s) {
                        const bf16x8 vf = *(const LAS bf16x8*)(vb + (32 * d + ql) * KP + (32 * j + 16 * s + 8 * hi) * 2);
                        O[d] = __builtin_amdgcn_mfma_f32_32x32x16_bf16(vf, pb[s], O[d], 0, 0, 0);
                    }
            }
            S = Sn;
        }
        if (more2) AT_LSTOREK(k3nn);
        if (more1) AT_LSTOREV(cur ^ 1);
        k3 = k3n;
        mw = mwn;
        __syncthreads();
    }
#undef AT_GLOADK
#undef AT_ROWMAX
#undef AT_RESCALE
#undef AT_GLOADV
#undef AT_LSTOREK
#undef AT_LSTOREV
#undef AT_QK
    const float l_tot = l_run + __shfl_xor(l_run, 32);
    const float inv = 1.f / l_tot;
    if (MODE == 0) {
#pragma unroll
        for (int d = 0; d < NDT; ++d)
#pragma unroll
            for (int g = 0; g < 4; ++g) { u32x2 w; w.x = cvtpk(O[d][4 * g] * inv, O[d][4 * g + 1] * inv); w.y = cvtpk(O[d][4 * g + 2] * inv, O[d][4 * g + 3] * inv);
                *(u32x2*)(OAB + (size_t)t * 1024 + h * 64 + 32 * d + 8 * g + 4 * hi) = w; }
    } else {
        LAS float* X = (LAS float*)lds;
        if (map == 1) {
#pragma unroll
            for (int d = 0; d < NDT; ++d)
#pragma unroll
                for (int r = 0; r < 16; ++r) X[(d * 16 + r) * 256 + qw * 64 + lane] = O[d][r] * inv;
        }
        __syncthreads();
        if (map == 0) {
            float ss = 0.f;
#pragma unroll
            for (int d = 0; d < NDT; ++d)
#pragma unroll
                for (int r = 0; r < 16; ++r) { const float v = O[d][r] * inv - lam * X[(d * 16 + r) * 256 + qw * 64 + lane]; O[d][r] = v; ss += v * v; }
            ss += __shfl_xor(ss, 32);
            const float rn = rsqrtf(ss * (1.f / 128.f) + 1e-5f) * (1.f - LAM_INIT);
#pragma unroll
            for (int d = 0; d < NDT; ++d)
#pragma unroll
                for (int g = 0; g < 4; ++g) { const int e0 = 32 * d + 8 * g + 4 * hi; const float4 sw = *(const float4*)(subw + e0);
                    u32x2 w; w.x = cvtpk(O[d][4 * g] * rn * sw.x, O[d][4 * g + 1] * rn * sw.y); w.y = cvtpk(O[d][4 * g + 2] * rn * sw.z, O[d][4 * g + 3] * rn * sw.w);
                    *(u32x2*)(OAB + (size_t)t * 1024 + 512 + h * 128 + e0) = w; }
        }
        __syncthreads();
    }
}
}

namespace idx {
typedef short bf16x8 __attribute__((ext_vector_type(8)));
typedef float f32x4 __attribute__((ext_vector_type(4)));
constexpr int NQ = 16, CAP = 1200, TRIG = CAP - 256, NSL = 19;
constexpr int OFF_CNT = NQ * CAP * 8, OFF_TAU = OFF_CNT + 128, OFF_DUMP = OFF_TAU + 128, IDX_LDS = OFF_DUMP + 8 * 512;
__device__ __forceinline__ unsigned fkey(float f) { const unsigned u = __float_as_uint(f); return (u & 0x80000000u) ? ~u : (u | 0x80000000u); }
__device__ __forceinline__ float keyf(unsigned k) { return __uint_as_float((k & 0x80000000u) ? (k & 0x7fffffffu) : ~k); }
__device__ __forceinline__ int wave_count_ge(const unsigned (&kv)[NSL], unsigned cand) {
    int tot = 0;
#pragma unroll
    for (int i = 0; i < NSL; ++i) tot += __popcll(__ballot(kv[i] >= cand));
    return tot;
}
template <int NB> __device__ __forceinline__ unsigned kth_prefix(const unsigned (&kv)[NSL], int rank = 256) {
    unsigned prefix = 0u;
#pragma unroll 1
    for (int b = 31; b >= 32 - NB; --b) { const unsigned cand = prefix | (1u << b); if (wave_count_ge(kv, cand) >= rank) prefix = cand; }
    return prefix;
}
__device__ __forceinline__ void load_pool(const LAS u32x2* pool, int c, int lane, unsigned (&kv)[NSL], unsigned (&sb)[NSL], unsigned (&kk)[NSL]) {
#pragma unroll
    for (int i = 0; i < NSL; ++i) { const int s = lane + 64 * i; u32x2 e = {0u, 0u}; if (s < c) e = pool[s]; sb[i] = e.x; kk[i] = e.y; kv[i] = (s < c) ? fkey(__uint_as_float(e.x)) : 0u; }
}
__device__ __forceinline__ void prune(LAS unsigned char* lds, int q, int lane) {
    LAS u32x2* pool = (LAS u32x2*)(lds + q * CAP * 8); LAS unsigned* cnt = (LAS unsigned*)(lds + OFF_CNT); LAS float* tau = (LAS float*)(lds + OFF_TAU);
    int c = (int)cnt[q]; c = c > CAP ? CAP : c;
    unsigned kv[NSL], sb[NSL], kk[NSL];
    load_pool(pool, c, lane, kv, sb, kk);
    const unsigned prefix = kth_prefix<17>(kv);
    int base = 0;
#pragma unroll
    for (int i = 0; i < NSL; ++i) { const bool keep = kv[i] >= prefix && prefix != 0u; const unsigned long long m = __ballot(keep);
        const int pos = base + __builtin_amdgcn_mbcnt_hi((unsigned)(m >> 32), __builtin_amdgcn_mbcnt_lo((unsigned)m, 0u));
        if (keep) pool[pos] = (u32x2){sb[i], kk[i]};
        base += __popcll(m); }
    if (lane == 0) { cnt[q] = (unsigned)base; tau[q] = keyf(prefix); }
}
template <int NS> __device__ __forceinline__ void finalize_impl(LAS u32x2* pool, int c, int lane, unsigned* __restrict__ bmp_row) {
    unsigned kv[NS], kk[NS];
#pragma unroll
    for (int i = 0; i < NS; ++i) { const int s = lane + 64 * i; u32x2 e = {0u, 0u}; if (s < c) e = pool[s]; kk[i] = e.y; kv[i] = (s < c) ? fkey(__uint_as_float(e.x)) : 0u; }
    unsigned prefix = 0u; int need = 1 << 20;
    if (c > 256) {
        bool exact = false;
#pragma unroll 1
        for (int b = 31; b >= 0 && !exact; --b) { const unsigned cand = prefix | (1u << b); int tot = 0;
#pragma unroll
            for (int i = 0; i < NS; ++i) tot += __popcll(__ballot(kv[i] >= cand));
            if (tot >= 256) { prefix = cand; exact = (tot == 256); } }
        if (exact) { need = 0; prefix -= 1u; }
        else { int gt = 0;
#pragma unroll
            for (int i = 0; i < NS; ++i) gt += __popcll(__ballot(kv[i] > prefix));
            need = 256 - gt; }
    }
    LAS unsigned* row = (LAS unsigned*)pool;
    *(LAS u32x4*)(row + 8 * lane) = (u32x4){0u, 0u, 0u, 0u}; *(LAS u32x4*)(row + 8 * lane + 4) = (u32x4){0u, 0u, 0u, 0u};
    int base = 0;
#pragma unroll
    for (int i = 0; i < NS; ++i) { const bool valid = (lane + 64 * i) < c; bool sel = valid && kv[i] > prefix; const bool tie = valid && kv[i] == prefix && need > 0;
        const unsigned long long m = __ballot(tie);
        const int rank = base + __builtin_amdgcn_mbcnt_hi((unsigned)(m >> 32), __builtin_amdgcn_mbcnt_lo((unsigned)m, 0u));
        if (tie && rank < need) sel = true;
        base += __popcll(m);
        if (sel) __hip_atomic_fetch_or(row + (kk[i] >> 5), 1u << (kk[i] & 31), __ATOMIC_RELAXED, __HIP_MEMORY_SCOPE_WORKGROUP); }
    const u32x4 w0 = *(LAS u32x4*)(row + 8 * lane), w1 = *(LAS u32x4*)(row + 8 * lane + 4);
    *(u32x4*)(bmp_row + 8 * lane) = w0; *(u32x4*)(bmp_row + 8 * lane + 4) = w1;
}
__device__ __forceinline__ void finalize(LAS unsigned char* lds, int q, int lane, unsigned* __restrict__ bmp_row) {
    LAS u32x2* pool = (LAS u32x2*)(lds + q * CAP * 8); LAS unsigned* cnt = (LAS unsigned*)(lds + OFF_CNT);
    int c = (int)cnt[q]; c = c > CAP ? CAP : c;
    if (c <= 768) finalize_impl<12>(pool, c, lane, bmp_row); else finalize_impl<NSL>(pool, c, lane, bmp_row);
}

__device__ __forceinline__ void index_unit_safe(LAS unsigned char* lds, int qblk, const bf16_t* __restrict__ QK, unsigned* __restrict__ BMP) {
    const int tid = threadIdx.x, lane = tid & 63, wave = __builtin_amdgcn_readfirstlane(tid >> 6), qc = lane & 15, g = lane >> 4;
    const int t = qblk * NQ + qc, NTL = (qblk + 2) >> 1;
    LAS unsigned* cnt = (LAS unsigned*)(lds + OFF_CNT); LAS float* tau = (LAS float*)(lds + OFF_TAU);
    if (tid < NQ) { cnt[tid] = 0u; tau[tid] = -INFINITY; }
    bf16x8 qf[8][2]; float wq[8];
#pragma unroll
    for (int h = 0; h < 8; ++h) {
        wq[h] = bf2f(QK[(size_t)t * NTOK + C_IW + h]) * (0.35355339059327373f * 0.125f);
#pragma unroll
        for (int ks = 0; ks < 2; ++ks) qf[h][ks] = *(const bf16x8*)(QK + (size_t)t * NTOK + C_IQ + h * 64 + 32 * ks + 8 * g);
    }
    const unsigned dump_a = (unsigned)(size_t)(lds + OFF_DUMP + wave * 512 + lane * 8), pool_a = (unsigned)(size_t)(lds + qc * CAP * 8);
    __syncthreads();
    const int nrounds = (NTL + 7) >> 3;
    bf16x8 kf[2][2];
    { const int kt0 = wave < NTL ? wave : 0;
#pragma unroll
      for (int i = 0; i < 2; ++i)
#pragma unroll
          for (int ks = 0; ks < 2; ++ks) kf[i][ks] = *(const bf16x8*)(QK + (size_t)(kt0 * 32 + 16 * i + qc) * NTOK + C_IK + 32 * ks + 8 * g); }
    for (int rd = 0; rd < nrounds; ++rd) {
        const int kt = rd * 8 + wave;
        if (kt < NTL) {
            const int k0 = kt * 32;
            const float tau_l = tau[qc];
            f32x4 sc[2];
#pragma unroll
            for (int i = 0; i < 2; ++i) {
                sc[i] = (f32x4){0.f, 0.f, 0.f, 0.f};
#pragma unroll
                for (int h = 0; h < 8; ++h) {
                    f32x4 acc = {0.f, 0.f, 0.f, 0.f};
                    acc = __builtin_amdgcn_mfma_f32_16x16x32_bf16(kf[i][0], qf[h][0], acc, 0, 0, 0);
                    acc = __builtin_amdgcn_mfma_f32_16x16x32_bf16(kf[i][1], qf[h][1], acc, 0, 0, 0);
#pragma unroll
                    for (int r = 0; r < 4; ++r) sc[i][r] = fmaf(wq[h], fmaxf(acc[r], 0.f), sc[i][r]);
                }
            }
            { const int ktn = (kt + 8 < NTL) ? kt + 8 : kt;
#pragma unroll
              for (int i = 0; i < 2; ++i)
#pragma unroll
                  for (int ks = 0; ks < 2; ++ks) kf[i][ks] = *(const bf16x8*)(QK + (size_t)(ktn * 32 + 16 * i + qc) * NTOK + C_IK + 32 * ks + 8 * g); }
            const int klim = (kt == NTL - 1) ? t : 0x7fffffff;
            int n = 0;
#pragma unroll
            for (int i = 0; i < 2; ++i)
#pragma unroll
                for (int r = 0; r < 4; ++r) { const int key = k0 + 16 * i + 4 * g + r; n += (sc[i][r] >= tau_l && key <= klim) ? 1 : 0; }
            int slot = 0;
            if (n > 0) slot = (int)__hip_atomic_fetch_add(cnt + qc, (unsigned)n, __ATOMIC_RELAXED, __HIP_MEMORY_SCOPE_WORKGROUP);
#pragma unroll
            for (int i = 0; i < 2; ++i)
#pragma unroll
                for (int r = 0; r < 4; ++r) { const int key = k0 + 16 * i + 4 * g + r; const bool pass = sc[i][r] >= tau_l && key <= klim; const bool ok = pass && slot < CAP;
                    const unsigned addr = ok ? pool_a + (unsigned)slot * 8u : dump_a;
                    *(LAS u32x2*)(size_t)addr = (u32x2){__float_as_uint(sc[i][r]), (unsigned)key};
                    slot += pass ? 1 : 0; }
        }
        __syncthreads();
        const bool over = cnt[qc] > (unsigned)TRIG;
        if (__any(over)) {
#pragma unroll 1
            for (int i = 0; i < 2; ++i) { const int q = wave * 2 + i; if (cnt[q] > (unsigned)TRIG) prune(lds, q, lane); }
            __syncthreads();
        }
    }
#pragma unroll 1
    for (int i = 0; i < 2; ++i) { const int q = wave * 2 + i; finalize(lds, q, lane, BMP + (size_t)(qblk * NQ + q) * 512); }
    __syncthreads();
}

constexpr int SRANK = 40, OFF_FLAG = OFF_DUMP - 16;
template <int NS> __device__ __forceinline__ unsigned sample_rank(const LAS u32x2* pool, int c, int lane) {
    unsigned kv[NS];
#pragma unroll
    for (int i = 0; i < NS; ++i) { const int s = lane + 64 * i; kv[i] = (s < c) ? fkey(__uint_as_float(pool[s < c ? s : 0].x)) : 0u; }
    unsigned prefix = 0u;
#pragma unroll 1
    for (int b = 31; b >= 15; --b) { const unsigned cand = prefix | (1u << b); int tot = 0;
#pragma unroll
        for (int i = 0; i < NS; ++i) tot += __popcll(__ballot(kv[i] >= cand));
        if (tot >= SRANK) prefix = cand; }
    return prefix;
}
__device__ __forceinline__ f32x4 score_tile(const bf16x8 (&kf)[2], const bf16x8 (&qf)[8][2], const bf16x8 (&qb)[2][2], const float (&wh)[8]) {
    f32x4 sc = {0.f, 0.f, 0.f, 0.f};
#pragma unroll
    for (int p = 0; p < 2; ++p) {
        sc = __builtin_amdgcn_mfma_f32_16x16x32_bf16(kf[0], qb[p][0], sc, 0, 0, 0);
        sc = __builtin_amdgcn_mfma_f32_16x16x32_bf16(kf[1], qb[p][1], sc, 0, 0, 0);
    }
#pragma unroll
    for (int h = 0; h < 8; ++h) {
        f32x4 acc = {0.f, 0.f, 0.f, 0.f};
        acc = __builtin_amdgcn_mfma_f32_16x16x32_bf16(kf[0], qf[h][0], acc, 0, 0, 0);
        acc = __builtin_amdgcn_mfma_f32_16x16x32_bf16(kf[1], qf[h][1], acc, 0, 0, 0);
#pragma unroll
        for (int r = 0; r < 4; ++r) sc[r] = fmaf(wh[h], __builtin_fabsf(acc[r]), sc[r]);
    }
    return sc;
}
__device__ __forceinline__ bool index_unit_fast(LAS unsigned char* lds, int qblk, const bf16_t* __restrict__ QK, unsigned* __restrict__ BMP) {
    const int tid = threadIdx.x, lane = tid & 63, wave = __builtin_amdgcn_readfirstlane(tid >> 6), qc = lane & 15, g = lane >> 4;
    const int t = qblk * NQ + qc, NTL = (qblk + 2) >> 1;
    LAS unsigned* cnt = (LAS unsigned*)(lds + OFF_CNT); LAS float* tau = (LAS float*)(lds + OFF_TAU); LAS unsigned* flag = (LAS unsigned*)(lds + OFF_FLAG);
    if (tid < NQ) { cnt[tid] = 0u; tau[tid] = -INFINITY; }
    if (tid == 0) flag[0] = 0u;
    bf16x8 qf[8][2], qb[2][2]; float wh[8];
    {   float qs[2][8];
#pragma unroll
        for (int ks = 0; ks < 2; ++ks)
#pragma unroll
            for (int e = 0; e < 8; ++e) qs[ks][e] = 0.f;
#pragma unroll
        for (int h = 0; h < 8; ++h) {
            wh[h] = bf2f(QK[(size_t)t * NTOK + C_IW + h]) * (0.5f * 0.35355339059327373f * 0.125f);
#pragma unroll
            for (int ks = 0; ks < 2; ++ks) { qf[h][ks] = *(const bf16x8*)(QK + (size_t)t * NTOK + C_IQ + h * 64 + 32 * ks + 8 * g);
#pragma unroll
                for (int e = 0; e < 8; ++e) qs[ks][e] = fmaf(wh[h], bf2f((bf16_t)qf[h][ks][e]), qs[ks][e]); }
        }
#pragma unroll
        for (int ks = 0; ks < 2; ++ks)
#pragma unroll
            for (int e = 0; e < 8; ++e) { const bf16_t hi16 = f2bf(qs[ks][e]); qb[0][ks][e] = (short)hi16; qb[1][ks][e] = (short)f2bf(qs[ks][e] - bf2f(hi16)); }
    }
    const unsigned dump_a = (unsigned)(size_t)(lds + OFF_DUMP + wave * 512 + lane * 8), pool_a = (unsigned)(size_t)(lds + qc * CAP * 8);
    __syncthreads();
    if (qblk >= 64) {
        const int nst = (qblk + 15) >> 4;
        for (int st = wave; st < nst; st += 8) {
            const int j = 16 * st + qc; const int srow = (j < qblk) ? 16 * j + 8 : 8;
            bf16x8 kf[2];
#pragma unroll
            for (int ks = 0; ks < 2; ++ks) kf[ks] = *(const bf16x8*)(QK + (size_t)srow * NTOK + C_IK + 32 * ks + 8 * g);
            const f32x4 sc = score_tile(kf, qf, qb, wh);
            int n = 0;
#pragma unroll
            for (int r = 0; r < 4; ++r) n += (16 * st + 4 * g + r < qblk) ? 1 : 0;
            int slot = 0;
            if (n > 0) slot = (int)__hip_atomic_fetch_add(cnt + qc, (unsigned)n, __ATOMIC_RELAXED, __HIP_MEMORY_SCOPE_WORKGROUP);
#pragma unroll
            for (int r = 0; r < 4; ++r) { const bool ok = (16 * st + 4 * g + r < qblk) && slot < CAP;
                const unsigned addr = ok ? pool_a + (unsigned)slot * 8u : dump_a;
                *(LAS u32x2*)(size_t)addr = (u32x2){__float_as_uint(sc[r]), 0u}; slot += ok ? 1 : 0; }
        }
        __syncthreads();
#pragma unroll 1
        for (int i = 0; i < 2; ++i) { const int q = wave * 2 + i; int c = (int)cnt[q]; c = c > CAP ? CAP : c;
            const LAS u32x2* pool = (const LAS u32x2*)(lds + q * CAP * 8);
            unsigned prefix;
            if (c <= 512) prefix = sample_rank<8>(pool, c, lane); else prefix = sample_rank<16>(pool, c, lane);
            if (lane == 0) { tau[q] = prefix ? keyf(prefix) : -INFINITY; cnt[q] = 0u; } }
        __syncthreads();
    }
    const float tau_l = tau[qc];
    bf16x8 kf[2][2];
    { const int kt0 = wave < NTL ? wave : 0;
#pragma unroll
      for (int i = 0; i < 2; ++i)
#pragma unroll
          for (int ks = 0; ks < 2; ++ks) kf[i][ks] = *(const bf16x8*)(QK + (size_t)(kt0 * 32 + 16 * i + qc) * NTOK + C_IK + 32 * ks + 8 * g); }
    for (int kt = wave; kt < NTL; kt += 8) {
        const int k0 = kt * 32;
        f32x4 sc[2];
#pragma unroll
        for (int i = 0; i < 2; ++i) sc[i] = score_tile(kf[i], qf, qb, wh);
        { const int ktn = (kt + 8 < NTL) ? kt + 8 : kt;
#pragma unroll
          for (int i = 0; i < 2; ++i)
#pragma unroll
              for (int ks = 0; ks < 2; ++ks) kf[i][ks] = *(const bf16x8*)(QK + (size_t)(ktn * 32 + 16 * i + qc) * NTOK + C_IK + 32 * ks + 8 * g); }
        const int klim = (kt == NTL - 1) ? t : 0x7fffffff;
        int n = 0;
#pragma unroll
        for (int i = 0; i < 2; ++i)
#pragma unroll
            for (int r = 0; r < 4; ++r) { const int key = k0 + 16 * i + 4 * g + r; n += (sc[i][r] >= tau_l && key <= klim) ? 1 : 0; }
        if (__any(n > 0)) {
            int slot = 0;
            if (n > 0) slot = (int)__hip_atomic_fetch_add(cnt + qc, (unsigned)n, __ATOMIC_RELAXED, __HIP_MEMORY_SCOPE_WORKGROUP);
#pragma unroll
            for (int i = 0; i < 2; ++i)
#pragma unroll
                for (int r = 0; r < 4; ++r) { const int key = k0 + 16 * i + 4 * g + r; const bool pass = sc[i][r] >= tau_l && key <= klim; const bool ok = pass && slot < CAP;
                    const unsigned addr = ok ? pool_a + (unsigned)slot * 8u : dump_a;
                    *(LAS u32x2*)(size_t)addr = (u32x2){__float_as_uint(sc[i][r]), (unsigned)key};
                    slot += pass ? 1 : 0; }
        }
    }
    __syncthreads();
    {
        const unsigned c = cnt[qc]; const unsigned want = (unsigned)(t + 1 < 256 ? t + 1 : 256);
        const bool bad = (c < want) || (c > (unsigned)CAP);
        if (__any(bad)) { if (lane == 0) flag[0] = 1u; }
    }
    __syncthreads();
    const bool redo = flag[0] != 0u;
    if (!redo) {
#pragma unroll 1
        for (int i = 0; i < 2; ++i) { const int q = wave * 2 + i; finalize(lds, q, lane, BMP + (size_t)(qblk * NQ + q) * 512); }
    }
    __syncthreads();
    return redo;
}
__device__ __forceinline__ void index_unit(LAS unsigned char* lds, int qblk, const bf16_t* __restrict__ QK, unsigned* __restrict__ BMP) {
    if (index_unit_fast(lds, qblk, QK, BMP)) index_unit_safe(lds, qblk, QK, BMP);
}
}

typedef __attribute__((address_space(1))) unsigned gu32;
#define XB_TMO      128
#define XB_XCNT(j)  (256  + 64 * (j))
#define XB_XSUB(j)  (1280 + 64 * (j))
#define XB_XGEN(j)  (2304 + 64 * (j))
#define XB_TOP      3328
#define XB_TOPGEN   3392
#define XCD_BAR_WORDS 3456
#define XB_SPIN_CAP (1u << 23)

__device__ __forceinline__ unsigned xb_ld(unsigned* p)              { return __hip_atomic_load(p, __ATOMIC_RELAXED, __HIP_MEMORY_SCOPE_AGENT); }
__device__ __forceinline__ unsigned xb_add(unsigned* p, unsigned v) { return __hip_atomic_fetch_add(p, v, __ATOMIC_RELAXED, __HIP_MEMORY_SCOPE_AGENT); }
__device__ __forceinline__ unsigned xb_xcc_id() { return (unsigned)__builtin_amdgcn_s_getreg((3 << 11) | 20) & 0xFu; }
#define XB_SPIN(cond, bar) do { unsigned _sp = 0; while (cond) { __builtin_amdgcn_s_sleep(1); \
    if ((++_sp & 255u) == 0u) { if (xb_ld(&(bar)[XB_TMO])) break; if (_sp > XB_SPIN_CAP) { atomicAdd(&(bar)[XB_TMO], 1u); break; } } } } while (0)

struct XcdBarrier {
    unsigned* bar; unsigned x;
    volatile LAS unsigned* st;
};

__device__ __forceinline__ XcdBarrier xcd_barrier_post(unsigned* bar, volatile LAS unsigned* st) {
    XcdBarrier b; b.bar = bar; b.x = xb_xcc_id(); b.st = st;
    if (threadIdx.x == 0) (void)xb_add(&bar[XB_XCNT(b.x)], 1u);
    return b;
}
__device__ __forceinline__ void xcd_barrier_complete(unsigned* bar, unsigned x, unsigned& nloc, unsigned& nx) {
    const unsigned G = gridDim.x * gridDim.y * gridDim.z;
    unsigned sum, cnt, mine, sp = 0u;
    for (;;) {
        sum = 0u; cnt = 0u; mine = 0u;
#pragma unroll
        for (unsigned j = 0; j < 16; ++j) { const unsigned c = xb_ld(&bar[XB_XCNT(j)]); sum += c; cnt += (c > 0u) ? 1u : 0u; mine = (j == x) ? c : mine; }
        if (sum == G) break;
        __builtin_amdgcn_s_sleep(1);
        if ((++sp & 255u) == 0u) { if (xb_ld(&bar[XB_TMO])) break; if (sp > XB_SPIN_CAP) { atomicAdd(&bar[XB_TMO], 1u); break; } }
    }
    nloc = mine > 0u ? mine : 1u; nx = cnt > 0u ? cnt : 1u;
}

__device__ __forceinline__ void xcd_barrier(const XcdBarrier& b) {
    asm volatile("s_waitcnt vmcnt(0)" ::: "memory");
    __syncthreads();
    if (threadIdx.x == 0) {
        unsigned* bar = b.bar;
        __builtin_amdgcn_s_waitcnt(0);
        unsigned nloc = b.st[0], nx = b.st[1];
        if (nloc == 0u) { xcd_barrier_complete(bar, b.x, nloc, nx); b.st[0] = nloc; b.st[1] = nx; }
        const unsigned old = xb_add(&bar[XB_XSUB(b.x)], 1u);
        const unsigned gen = old / nloc;
        if (old + 1u == (gen + 1u) * nloc) {
            __builtin_amdgcn_fence(__ATOMIC_RELEASE, "agent");
            asm volatile("s_waitcnt vmcnt(0)" ::: "memory");
            const unsigned og = xb_add(&bar[XB_TOP], 1u);
            const unsigned tg = og / nx;
            if (og + 1u == (tg + 1u) * nx) xb_add(&bar[XB_TOPGEN], 1u);
            else XB_SPIN(xb_ld(&bar[XB_TOPGEN]) == tg, bar);
            __builtin_amdgcn_fence(__ATOMIC_ACQUIRE, "agent");
            xb_add(&bar[XB_XGEN(b.x)], 1u);
            asm volatile("s_waitcnt vmcnt(0)" ::: "memory");
        } else {
            XB_SPIN(xb_ld(&bar[XB_XGEN(b.x)]) == gen, bar);
            __builtin_amdgcn_fence(__ATOMIC_ACQUIRE, "agent");
            asm volatile("s_waitcnt vmcnt(0)" ::: "memory");
        }
    }
    __syncthreads();
}

constexpr int NWAVES = 8, NTHREADS = 512;
constexpr int LDS_BYTES = 163840;
enum Phase { PH_PRO = 0, PH_G1 = 1, PH_IDX = 2, PH_ATB = 3, PH_ATA = 4, PH_T1 = 5, PH_T2 = 6, PH_T3 = 7, PH_T4 = 8, PH_T5 = 9, PH_N = 10 };

struct Args {
    const float* x; const float* p; const float* w_in; const float* w_pa; const float* w_pb; const float* w_o; const float* lqk; const float* subw;
    const float* ln_g; const float* ln_b; const float* w_ple; const float* w_gate; const float* rel_bias;
    float* out; unsigned char* ws; int ph_lo, ph_hi;
};

template <int MODE>
__device__ __forceinline__ void p0_transpose_item(const float* __restrict__ W, int K, int ld, int N, bf16_t* __restrict__ WT, LAS float* scr, int item, int lane) {
    const int nblk = N / 32, kb = item / nblk, nb = item % nblk, k0 = 64 * kb, n0 = 32 * nb;
    const int n = n0 + (lane & 31); const int c = MODE == 0 ? n : win_src_col(n);
#pragma unroll 8
    for (int i = 0; i < 32; ++i) { const int kk = 2 * i + (lane >> 5); scr[kk * 33 + (lane & 31)] = (c >= 0) ? W[(size_t)(k0 + kk) * ld + c] : 0.f; }
    asm volatile("s_waitcnt lgkmcnt(0)" ::: "memory");
    const int cc = lane & 7;
#pragma unroll
    for (int j = 0; j < 4; ++j) { const int nn = (lane >> 3) + 8 * j; const LAS float* s = scr + (8 * cc) * 33 + nn;
        u32x4 o; o.x = f2bf(s[0 * 33]) | ((unsigned)f2bf(s[1 * 33]) << 16); o.y = f2bf(s[2 * 33]) | ((unsigned)f2bf(s[3 * 33]) << 16);
        o.z = f2bf(s[4 * 33]) | ((unsigned)f2bf(s[5 * 33]) << 16); o.w = f2bf(s[6 * 33]) | ((unsigned)f2bf(s[7 * 33]) << 16);
        *(u32x4*)(WT + (size_t)(n0 + nn) * K + k0 + 8 * cc) = o; }
    asm volatile("s_waitcnt lgkmcnt(0)" ::: "memory");
}
__device__ __forceinline__ void cvt_rows(const float* __restrict__ src, bf16_t* __restrict__ dst, size_t n4, size_t gtid, size_t gthreads) {
    for (size_t i = gtid; i < n4; i += gthreads) { const float4 v = ((const float4*)src)[i]; u32x2 o; o.x = f2bf(v.x) | ((unsigned)f2bf(v.y) << 16); o.y = f2bf(v.z) | ((unsigned)f2bf(v.w) << 16); ((u32x2*)dst)[i] = o; }
}
__device__ __forceinline__ void ln_row(float* __restrict__ io, const float* __restrict__ g, const float* __restrict__ b, bf16_t* __restrict__ xln, int lane) {
    float4* r = (float4*)io + lane; float4 v[4]; float s = 0.f;
#pragma unroll
    for (int j = 0; j < 4; ++j) { v[j] = r[64 * j]; s += (v[j].x + v[j].y) + (v[j].z + v[j].w); }
#pragma unroll
    for (int o = 1; o < 64; o <<= 1) s += __shfl_xor(s, o);
    const float mean = s * (1.f / 1024.f); float q = 0.f;
#pragma unroll
    for (int j = 0; j < 4; ++j) { v[j].x -= mean; v[j].y -= mean; v[j].z -= mean; v[j].w -= mean; q += (v[j].x * v[j].x + v[j].y * v[j].y) + (v[j].z * v[j].z + v[j].w * v[j].w); }
#pragma unroll
    for (int o = 1; o < 64; o <<= 1) q += __shfl_xor(q, o);
    const float rstd = rsqrtf(q * (1.f / 1024.f) + 1e-5f);
#pragma unroll
    for (int j = 0; j < 4; ++j) {
        const float4 gg = ((const float4*)g)[lane + 64 * j], bb = ((const float4*)b)[lane + 64 * j];
        float4 o; o.x = v[j].x * rstd * gg.x + bb.x; o.y = v[j].y * rstd * gg.y + bb.y; o.z = v[j].z * rstd * gg.z + bb.z; o.w = v[j].w * rstd * gg.w + bb.w;
        r[64 * j] = o; u32x2 w; w.x = f2bf(o.x) | ((unsigned)f2bf(o.y) << 16); w.y = f2bf(o.z) | ((unsigned)f2bf(o.w) << 16);
        ((u32x2*)xln)[lane + 64 * j] = w;
    }
}

__global__ void __launch_bounds__(NTHREADS, 2) mega(Args a) {
    extern __shared__ __attribute__((aligned(16))) unsigned char lds_raw[];
    LAS unsigned char* lds = (LAS unsigned char*)lds_raw;
    const int tid = threadIdx.x, lane = tid & 63, wave = __builtin_amdgcn_readfirstlane(tid >> 6);
    const int G = gridDim.x, bx = blockIdx.x;
    unsigned char* ws = a.ws;
    bf16_t* WIN = (bf16_t*)(ws + WS_WIN); bf16_t* WPA = (bf16_t*)(ws + WS_WPA); bf16_t* WPB = (bf16_t*)(ws + WS_WPB); bf16_t* WO = (bf16_t*)(ws + WS_WO);
    bf16_t* WGT = (bf16_t*)(ws + WS_WGT); bf16_t* WPLE = (bf16_t*)(ws + WS_WPLE); bf16_t* XBF = (bf16_t*)(ws + WS_XBF); bf16_t* PBF = (bf16_t*)(ws + WS_PBF);
    bf16_t* QK = (bf16_t*)(ws + WS_QK); bf16_t* VT = (bf16_t*)(ws + WS_VT); bf16_t* OAB = (bf16_t*)(ws + WS_OAB);
    bf16_t* PLEO = (bf16_t*)(ws + WS_PLEO); bf16_t* Gb = (bf16_t*)(ws + WS_G); bf16_t* MRG = (bf16_t*)(ws + WS_MRG); bf16_t* XLN = (bf16_t*)(ws + WS_XLN);
    float* BT = (float*)(ws + WS_BT);
    const int lo = a.ph_lo, hi = a.ph_hi;
    volatile LAS unsigned* bst = (volatile LAS unsigned*)(lds + LDS_BYTES - 16);
    if (tid < 4) bst[tid] = 0u;
    __syncthreads();
    XcdBarrier bar = xcd_barrier_post((unsigned*)(ws + WS_CTL), bst);
#define IN(k) (lo <= (k) && (k) < hi)
#define SEAM(k) do { if (IN(k) && IN((k) + 1)) { if ((k) == PH_PRO) cooperative_groups::this_grid().sync(); else xcd_barrier(bar); } } while (0)

    if (IN(PH_PRO)) {
        LAS float* scr = (LAS float*)(lds + wave * 16384);
        const int gw = bx * NWAVES + wave, NGW = G * NWAVES;
        constexpr int I_IN = (WT_ROWS / 32) * (1024 / 64), I_PA = 32 * 8, I_O = 32 * 16, I_PLE = 32 * 4;
        constexpr int NITEMS = I_IN + 2 * I_PA + 2 * I_O + I_PLE;
        for (int it = gw; it < NITEMS; it += NGW) {
            int r = it;
            if (r < I_IN) { p0_transpose_item<1>(a.w_in, 1024, IN_COLS, WT_ROWS, WIN, scr, r, lane); continue; } r -= I_IN;
            if (r < I_PA) { p0_transpose_item<0>(a.w_pa, 512, 1024, 1024, WPA, scr, r, lane); continue; } r -= I_PA;
            if (r < I_PA) { p0_transpose_item<0>(a.w_pb, 512, 1024, 1024, WPB, scr, r, lane); continue; } r -= I_PA;
            if (r < I_O) { p0_transpose_item<0>(a.w_o, 1024, 1024, 1024, WO, scr, r, lane); continue; } r -= I_O;
            if (r < I_O) { p0_transpose_item<0>(a.w_gate, 1024, 1024, 1024, WGT, scr, r, lane); continue; } r -= I_O;
            p0_transpose_item<0>(a.w_ple, 256, 1024, 1024, WPLE, scr, r, lane);
        }
        const size_t gtid = (size_t)bx * NTHREADS + tid, gth = (size_t)G * NTHREADS;
        cvt_rows(a.x, XBF, (size_t)L * 1024 / 4, gtid, gth);
        cvt_rows(a.p, PBF, (size_t)L * 256 / 4, gtid, gth);
        if (gtid < 128 * 12) { const int n = (int)gtid / 12, h = (int)gtid % 12; BT[gtid] = a.rel_bias[rel_bucket(n) * 12 + h]; }
    }
    SEAM(PH_PRO);
    if (IN(PH_G1)) {
        { pg8::Gemm g{XBF, WIN + (size_t)WT_TOK * 1024, L, NTOK, 1024, 1024, 1024}; pg8::StaticOrder S; S.init(L, NTOK, G, bx);
          pg8::EpiStoreBf E{QK, NTOK, 0}; pg8::gemm_phase<pg8::EpiStoreBf, pg8::StaticOrder, true, true>(lds, g, S, E); }
        { pg8::Gemm g{WIN + (size_t)WT_VT * 1024, XBF, 1024, L, 1024, 1024, 1024}; pg8::StaticOrder S; S.init(1024, L, G, bx);
          pg8::EpiStoreBf E{VT, L, 0}; pg8::gemm_phase<pg8::EpiStoreBf, pg8::StaticOrder, true, true>(lds, g, S, E); }
    }
    SEAM(PH_G1);
    if (IN(PH_IDX)) {
        unsigned* BMPw = (unsigned*)(ws + WS_BMP);
        for (int p = bx; p < 512; p += G) { idx::index_unit(lds, 1023 - p, QK, BMPw); idx::index_unit(lds, p, QK, BMPw); }
    }
    if (IN(PH_ATB) || IN(PH_ATA)) {
        const int vcu = (G % 8 == 0) ? (bx % 8) * (G / 8) + bx / 8 : bx;
        const unsigned* BMP = (const unsigned*)(ws + WS_BMP);
        if (IN(PH_ATB)) {
            float la = a.lqk[lane] * a.lqk[64 + lane], lb = a.lqk[128 + lane] * a.lqk[192 + lane];
#pragma unroll
            for (int o = 1; o < 64; o <<= 1) { la += __shfl_xor(la, o); lb += __shfl_xor(lb, o); }
            const float lam = __expf(la) - __expf(lb) + LAM_INIT;
            for (int p = vcu; p < 256; p += G) { const int h = p >> 6, xq = p & 63;
                att::attn_unit<1>(lds, h, 127 - xq, QK, VT, BMP, BT, a.subw, lam, OAB);
                att::attn_unit<1>(lds, h, xq, QK, VT, BMP, BT, a.subw, lam, OAB); }
        }
        SEAM(PH_ATB);
        if (IN(PH_ATA)) {
            for (int p = vcu; p < 256; p += G) { const int h = p >> 5, xq = p & 31;
                att::attn_unit<0>(lds, h, 63 - xq, QK, VT, BMP, BT, a.subw, 0.f, OAB);
                att::attn_unit<0>(lds, h, xq, QK, VT, BMP, BT, a.subw, 0.f, OAB); }
        }
    }
    SEAM(PH_ATA);
    if (IN(PH_T1)) {
        { pg8::Gemm g{XBF, WIN + (size_t)WT_Z * 1024, L, 1024, 1024, 1024, 1024}; pg8::StaticOrder S; S.init(L, 1024, G, bx);
          pg8::EpiZ E{OAB}; pg8::gemm_phase<pg8::EpiZ, pg8::StaticOrder, true, true>(lds, g, S, E); }
        { pg8::Gemm g{XBF, WIN + (size_t)WT_G * 1024, L, 2048, 1024, 1024, 1024}; pg8::StaticOrder S; S.init(L, 2048, G, bx);
          pg8::EpiG E{Gb}; pg8::gemm_phase<pg8::EpiG, pg8::StaticOrder, true, true>(lds, g, S, E); }
    }
    SEAM(PH_T1);
    if (IN(PH_T2)) {
        { pg8::Gemm g{OAB, WPA, L, 1024, 512, 1024, 512}; pg8::StaticOrder S; S.init(L, 1024, G, bx);
          pg8::EpiPA E{Gb, MRG}; pg8::gemm_phase<pg8::EpiPA, pg8::StaticOrder, true, true>(lds, g, S, E); }
        { pg8::Gemm g{OAB + 512, WPB, L, 1024, 512, 1024, 512}; pg8::StaticOrder S; S.init(L, 1024, G, bx);
          pg8::EpiPB E{Gb, MRG}; pg8::gemm_phase<pg8::EpiPB, pg8::StaticOrder, true, true>(lds, g, S, E); }
        { pg8::Gemm g{PBF, WPLE, L, 1024, 256, 256, 256}; pg8::StaticOrder S; S.init(L, 1024, G, bx);
          pg8::EpiStoreBf E{PLEO, 1024, 0}; pg8::gemm_phase<pg8::EpiStoreBf, pg8::StaticOrder, true, true>(lds, g, S, E); }
    }
    SEAM(PH_T2);
    if (IN(PH_T3)) {
        pg8::Gemm g{MRG, WO, L, 1024, 1024, 1024, 1024}; pg8::StaticOrder S; S.init(L, 1024, G, bx);
        pg8::EpiO E{a.x, a.out}; pg8::gemm_phase<pg8::EpiO, pg8::StaticOrder, true, true>(lds, g, S, E);
    }
    SEAM(PH_T3);
    if (IN(PH_T4)) {
        const int gw = bx * NWAVES + wave, NGW = G * NWAVES;
        for (int m = gw; m < L; m += NGW) ln_row(a.out + (size_t)m * 1024, a.ln_g, a.ln_b, XLN + (size_t)m * 1024, lane);
    }
    SEAM(PH_T4);
    if (IN(PH_T5)) {
        pg8::Gemm g{XLN, WGT, L, 1024, 1024, 1024, 1024}; pg8::StaticOrder S; S.init(L, 1024, G, bx);
        pg8::EpiGate E{a.out, PLEO}; pg8::gemm_phase<pg8::EpiGate, pg8::StaticOrder, true, true>(lds, g, S, E);
    }
#undef IN
#undef SEAM
}

extern "C" void kernel_launch(void* const* d_in, const int* in_sizes, int n_in, void* d_out, int out_size, void* d_ws, size_t ws_size, hipStream_t stream) {
    static int grid = 0;
    if (grid == 0) {
        if (ws_size < WS_END) { fprintf(stderr, "workspace too small: %zu\n", ws_size); grid = -1; return; }
        (void)hipFuncSetAttribute((const void*)mega, hipFuncAttributeMaxDynamicSharedMemorySize, LDS_BYTES);
        int dev = 0, cus = 0, per_cu = 0; (void)hipGetDevice(&dev); (void)hipDeviceGetAttribute(&cus, hipDeviceAttributeMultiprocessorCount, dev);
        (void)hipOccupancyMaxActiveBlocksPerMultiprocessor(&per_cu, (const void*)mega, NTHREADS, LDS_BYTES);
        if (per_cu < 1) fprintf(stderr, "kernel_launch: occupancy query reports %d workgroups per CU\n", per_cu);
        grid = cus > 0 ? cus : 256;
    }
    if (grid < 0) return;
    (void)hipMemsetAsync(d_ws, 0, 16384, stream);
    Args a{};
    a.x = (const float*)d_in[0]; a.p = (const float*)d_in[1]; a.w_in = (const float*)d_in[2]; a.w_pa = (const float*)d_in[3]; a.w_pb = (const float*)d_in[4]; a.w_o = (const float*)d_in[5];
    a.lqk = (const float*)d_in[6]; a.subw = (const float*)d_in[7]; a.ln_g = (const float*)d_in[8]; a.ln_b = (const float*)d_in[9];
    a.w_ple = (const float*)d_in[10]; a.w_gate = (const float*)d_in[11]; a.rel_bias = (const float*)d_in[12];
    a.out = (float*)d_out; a.ws = (unsigned char*)d_ws; a.ph_lo = 0; a.ph_hi = PH_N;
    void* args[] = {&a};
    const hipError_t e = hipLaunchCooperativeKernel((const void*)mega, dim3(grid), dim3(NTHREADS), args, LDS_BYTES, stream);
    if (e != hipSuccess) fprintf(stderr, "cooperative launch failed: %s (grid %d)\n", hipGetErrorString(e), grid);
}
```

```cpp
#include <hip/hip_runtime.h>
#include <hip/hip_cooperative_groups.h>
#include <cstdint>
#include <cstdio>

typedef unsigned short bf16_t;
typedef unsigned u32x4 __attribute__((ext_vector_type(4)));
typedef unsigned u32x2 __attribute__((ext_vector_type(2)));

constexpr int L = 16384, DM = 1024, PLE = 256;
constexpr int IN_COLS = 6728;
constexpr int NTOK = 2816;
constexpr int C_AQ = 0, C_AK = 512, C_BQ = 1024, C_BK = 1536, C_IQ = 2048, C_IK = 2560, C_IW = 2624;
constexpr int WT_TOK = 0, WT_VT = 2816, WT_Z = 3840, WT_G = 4864, WT_ROWS = 6912;
constexpr float ALPHA = 1.18920711500272f;
constexpr float LAM_INIT = 0.2f;

constexpr size_t MiB = 1u << 20;
constexpr size_t WS_CTL = 0;
constexpr size_t WS_BT = 512 * 1024;
constexpr size_t WS_WIN = 1 * MiB;
constexpr size_t WS_WPA = 15 * MiB;
constexpr size_t WS_WPB = 16 * MiB;
constexpr size_t WS_WO = 17 * MiB;
constexpr size_t WS_WGT = 19 * MiB;
constexpr size_t WS_WPLE = 21 * MiB;
constexpr size_t WS_XBF = 22 * MiB;
constexpr size_t WS_PBF = 54 * MiB;
constexpr size_t WS_QK = 62 * MiB;
constexpr size_t WS_VT = 154 * MiB;
constexpr size_t WS_BMP = 186 * MiB;
constexpr size_t WS_OAB = 218 * MiB;
constexpr size_t WS_END = 250 * MiB;
constexpr size_t WS_PLEO = WS_XBF, WS_G = WS_QK, WS_MRG = WS_VT, WS_XLN = WS_BMP;

__device__ __forceinline__ float bf2f(bf16_t v) { return __uint_as_float(((unsigned)v) << 16); }
__device__ __forceinline__ bf16_t f2bf(float f) { unsigned u = __float_as_uint(f); return (bf16_t)((u + 0x7fffu + ((u >> 16) & 1u)) >> 16); }
__device__ __forceinline__ float sigmoidf_(float v) { return 1.f / (1.f + __expf(-v)); }
__device__ __forceinline__ float siluf_(float v) { return v / (1.f + __expf(-v)); }

__host__ __device__ __forceinline__ int win_src_col(int n) {
    if (n < WT_VT) {
        if (n < 512) return n;
        if (n < 1024) return n;
        if (n < 1536) return 2632 + (n - 1024);
        if (n < 2048) return 3144 + (n - 1536);
        if (n < 2560) return 2048 + (n - 2048);
        if (n < 2624) return 2560 + (n - 2560);
        if (n < 2632) return 2624 + (n - 2624);
        return -1;
    }
    if (n < WT_Z) { int r = n - WT_VT; return r < 512 ? 1024 + r : 3656 + (r - 512); }
    if (n < WT_G) { int r = n - WT_Z; return r < 512 ? 1536 + r : 4168 + (r - 512); }
    return 4680 + (n - WT_G);
}

__device__ __forceinline__ int rel_bucket(int n) {
    if (n < 16) return n;
    int b = 16 + (int)(logf((float)n / 16.f) / logf(8.f) * 16.f);
    return b > 31 ? 31 : b;
}
namespace pg8 {
#define PG8_LAS __attribute__((address_space(3)))
typedef unsigned short bf16_t;
typedef short bf16x8 __attribute__((ext_vector_type(8)));
typedef float f32x4 __attribute__((ext_vector_type(4)));
typedef unsigned u32x4 __attribute__((ext_vector_type(4)));
constexpr int BM = 256, BK = 64, HALF = 128, HTB = HALF * BK * 2  , STAGE_BYTES = 8 * HTB, NXCD = 8, WGM = 8;

__host__ __device__ __forceinline__ int lds_byte(int r, int c) { const int st = (r >> 4) * 2 + (c >> 5), rr = r & 15, cc = c & 31, ob = rr * 64 + cc * 2; return st * 1024 + (ob ^ (((ob >> 9) & 1) << 5)); }
__host__ __device__ __forceinline__ void stage_rc(int b, int& R, int& C) { const int st = b / 1024, sb = b % 1024, swz = sb ^ (((sb >> 9) & 1) << 5); R = (st >> 1) * 16 + swz / 64; C = (st & 1) * 32 + (swz % 64) / 2; }
__host__ __device__ __forceinline__ int perm32(int rho) { const int n = rho >> 4, i = rho & 15; return 8 * (i >> 2) + 4 * n + (i & 3); }

struct Unit { int pm, pn; };
struct Gemm { const bf16_t* A; const bf16_t* Bt; int M, N, K, lda, ldb; };

struct StaticOrder {
    int nM, nN, nwg, G, c;
    __host__ __device__ void init(int M, int N, int G_, int c_) { nM = M / BM; nN = N / BM; nwg = nM * nN; G = G_; c = c_; }
    __host__ __device__ bool next(int i, Unit& u) const {
        const long L = (long)i * G + c; if (L >= nwg) return false;
        int wgid = (int)L; { const int q = nwg / NXCD, r = nwg % NXCD, xcd = wgid % NXCD, off = wgid / NXCD; wgid = (xcd < r ? xcd * (q + 1) : r * (q + 1) + (xcd - r) * q) + off; }
        const int nig = WGM * nN, gid = wgid / nig, fm = gid * WGM, gsz = (nM - fm) < WGM ? (nM - fm) : WGM;
        u.pm = fm + ((wgid % nig) % gsz); u.pn = (wgid % nig) / gsz; return true;
    }
    __device__ __forceinline__ void a_ready(const Unit&) const {}
    __device__ __forceinline__ void done(const Unit&) const {}
};


typedef float f32x2_t __attribute__((ext_vector_type(2))); typedef __bf16 bf16x2_t __attribute__((ext_vector_type(2)));
__device__ __forceinline__ unsigned cvt_pk_bf16(float lo, float hi) { f32x2_t v = {lo, hi}; bf16x2_t b = __builtin_convertvector(v, bf16x2_t); return __builtin_bit_cast(unsigned, b); }
__device__ __forceinline__ u32x4 pack8(const f32x4 a, const f32x4 b) { u32x4 w; w.x = cvt_pk_bf16(a[0], a[1]); w.y = cvt_pk_bf16(a[2], a[3]); w.z = cvt_pk_bf16(b[0], b[1]); w.w = cvt_pk_bf16(b[2], b[3]); return w; }
__device__ __forceinline__ void unpack8(const u32x4 w, f32x4& a, f32x4& b) {
    a[0] = __uint_as_float(w.x << 16); a[1] = __uint_as_float(w.x & 0xffff0000u); a[2] = __uint_as_float(w.y << 16); a[3] = __uint_as_float(w.y & 0xffff0000u);
    b[0] = __uint_as_float(w.z << 16); b[1] = __uint_as_float(w.z & 0xffff0000u); b[2] = __uint_as_float(w.w << 16); b[3] = __uint_as_float(w.w & 0xffff0000u); }
__device__ __forceinline__ float fsig(float v) { return __builtin_amdgcn_rcpf(1.f + __expf(-v)); }
__device__ __forceinline__ f32x4 sig4(const f32x4 v) { f32x4 r; r[0] = fsig(v[0]); r[1] = fsig(v[1]); r[2] = fsig(v[2]); r[3] = fsig(v[3]); return r; }
#define PG8_EPI_LOOP(...) \
    _Pragma("unroll") for (int ai = 0; ai < 2; ++ai) _Pragma("unroll") for (int m = 0; m < 4; ++m) { const size_t row = (size_t)(u.pm * BM + ai * HALF + wr * 64 + m * 16 + fr); \
    _Pragma("unroll") for (int bj = 0; bj < 2; ++bj) { const int col = u.pn * BM + bj * HALF + wc * 32 + 8 * fq; f32x4 v0 = acc[ai][bj][m][0], v1 = acc[ai][bj][m][1]; __VA_ARGS__ } }
#define PG8_EPI_SIG const f32x4 (&acc)[2][2][4][2], const Unit& u, int wr, int wc, int fr, int fq
struct EpiStoreBf { static constexpr bool PERM = true, AFTER_DRAIN = false; bf16_t* O; int ldc, pad;
    __device__ __forceinline__ void operator()(PG8_EPI_SIG) const { PG8_EPI_LOOP( *(u32x4*)(O + row * ldc + col) = pack8(v0, v1); ) } };
struct EpiTok { static constexpr bool PERM = true, AFTER_DRAIN = false; bf16_t* O; int ldc, pad;
    __device__ __forceinline__ void operator()(PG8_EPI_SIG) const { PG8_EPI_LOOP( const float sc = (col < 512 || (col >= 1024 && col < 1536)) ? 0.18033688011112042f : 1.f;
        *(u32x4*)(O + row * ldc + col) = pack8(v0 * sc, v1 * sc); ) } };
struct EpiVTdual { static constexpr bool PERM = true, AFTER_DRAIN = false; bf16_t* VT; bf16_t* VTOK;
    __device__ __forceinline__ void operator()(PG8_EPI_SIG) const { PG8_EPI_LOOP( const u32x4 w = pack8(v0, v1); *(u32x4*)(VT + row * 16384 + col) = w;
        if (VTOK) { VTOK[(size_t)(col + 0) * 1024 + row] = (bf16_t)(w.x & 0xffff); VTOK[(size_t)(col + 1) * 1024 + row] = (bf16_t)(w.x >> 16); VTOK[(size_t)(col + 2) * 1024 + row] = (bf16_t)(w.y & 0xffff); VTOK[(size_t)(col + 3) * 1024 + row] = (bf16_t)(w.y >> 16);
                    VTOK[(size_t)(col + 4) * 1024 + row] = (bf16_t)(w.z & 0xffff); VTOK[(size_t)(col + 5) * 1024 + row] = (bf16_t)(w.z >> 16); VTOK[(size_t)(col + 6) * 1024 + row] = (bf16_t)(w.w & 0xffff); VTOK[(size_t)(col + 7) * 1024 + row] = (bf16_t)(w.w >> 16); } ) } };
struct EpiZ { static constexpr bool PERM = true, AFTER_DRAIN = false; bf16_t* OAB;
    __device__ __forceinline__ void operator()(PG8_EPI_SIG) const { PG8_EPI_LOOP( u32x4* p = (u32x4*)(OAB + row * 1024 + col); f32x4 o0, o1; unpack8(*p, o0, o1);
        *p = pack8(v0 * sig4(v0) * o0, v1 * sig4(v1) * o1); ) } };
struct EpiG { static constexpr bool PERM = true, AFTER_DRAIN = false; bf16_t* G;
    __device__ __forceinline__ void operator()(PG8_EPI_SIG) const { PG8_EPI_LOOP( *(u32x4*)(G + row * 2048 + col) = pack8(sig4(v0), sig4(v1)); ) } };
struct EpiPA { static constexpr bool PERM = true, AFTER_DRAIN = false; const bf16_t* G; bf16_t* MRG;
    __device__ __forceinline__ void operator()(PG8_EPI_SIG) const { PG8_EPI_LOOP( f32x4 g0, g1; unpack8(*(const u32x4*)(G + row * 2048 + col), g0, g1);
        *(u32x4*)(MRG + row * 1024 + col) = pack8(g0 * v0, g1 * v1); ) } };
struct EpiPB { static constexpr bool PERM = true, AFTER_DRAIN = false; const bf16_t* G; bf16_t* MRG;
    __device__ __forceinline__ void operator()(PG8_EPI_SIG) const { PG8_EPI_LOOP( f32x4 g0, g1, m0, m1; unpack8(*(const u32x4*)(G + row * 2048 + 1024 + col), g0, g1);
        u32x4* p = (u32x4*)(MRG + row * 1024 + col); unpack8(*p, m0, m1); *p = pack8(m0 + g0 * v0, m1 + g1 * v1); ) } };
struct EpiO { static constexpr bool PERM = true, AFTER_DRAIN = false; const float* x; float* PRE;
    __device__ __forceinline__ void operator()(PG8_EPI_SIG) const { PG8_EPI_LOOP( const f32x4 x0 = *(const f32x4*)(x + row * 1024 + col), x1 = *(const f32x4*)(x + row * 1024 + col + 4);
        *(f32x4*)(PRE + row * 1024 + col) = x0 * 1.18920711500272f + v0; *(f32x4*)(PRE + row * 1024 + col + 4) = x1 * 1.18920711500272f + v1; ) } };
struct EpiGate { static constexpr bool PERM = true, AFTER_DRAIN = false; float* out; const bf16_t* PLEO;
    __device__ __forceinline__ void operator()(PG8_EPI_SIG) const { PG8_EPI_LOOP( f32x4 p0, p1; unpack8(*(const u32x4*)(PLEO + row * 1024 + col), p0, p1);
        f32x4* o = (f32x4*)(out + row * 1024 + col); const f32x4 a0 = o[0], a1 = o[1]; o[0] = a0 + sig4(v0) * p0; o[1] = a1 + sig4(v1) * p1; ) } };

template <class Epi, class Sched, bool ALIGN_EPI = false, bool SP2 = false>
__device__ __forceinline__ void gemm_phase(PG8_LAS unsigned char* lds, const Gemm g, const Sched& S, const Epi& E) {
    const int tid = threadIdx.x, wid = __builtin_amdgcn_readfirstlane(tid >> 6), lane = tid & 63, wr = wid >> 2, wc = wid & 3, fr = lane & 15, fq = lane >> 4;
    const int K = g.K, nt = K / BK;
    unsigned voffA[2], voffB[2];
#pragma unroll
    for (int i = 0; i < 2; ++i) { int R, C; stage_rc(tid * 16 + i * 8192, R, C); const int Rb = Epi::PERM ? ((R & ~31) + perm32(R & 31)) : R;
        voffA[i] = (unsigned)(R * g.lda + C) * 2u; voffB[i] = (unsigned)(Rb * g.ldb + C) * 2u; }
    const size_t kstep = (size_t)(BK * 2);
    const size_t hstepA = (size_t)HALF * g.lda * 2, hstepB = (size_t)HALF * g.ldb * 2;
    const size_t tstepA = 2 * hstepA, tstepB = 2 * hstepB;
    const unsigned ldsw = (unsigned)wid * 1024u;
    const int aoff = lds_byte(wr * 64 + fr, fq * 8), boff = lds_byte(wc * 32 + fr, fq * 8);
#define PG8_SA(b, h) (((b) * 2 + (h)) * HTB)
#define PG8_SB(b, h) ((4 + (b) * 2 + (h)) * HTB)
#define PG8_STAGE(bufoff, gbase, voff) do { _Pragma("unroll") for (int _i = 0; _i < 2; ++_i) \
        __builtin_amdgcn_global_load_lds((const unsigned*)((const char*)(gbase) + (voff)[_i]), (PG8_LAS unsigned*)(lds + (bufoff) + ldsw + _i * 8192), 16, 0, 0); } while (0)
#define PG8_LDA(dst, b, h) do { _Pragma("unroll") for (int m = 0; m < 4; ++m) _Pragma("unroll") for (int k = 0; k < 2; ++k) dst[m][k] = *(const PG8_LAS bf16x8*)(lds + PG8_SA(b, h) + aoff + m * 2048 + k * 1024); } while (0)
#define PG8_LDB(dst, b, h) do { _Pragma("unroll") for (int n = 0; n < 2; ++n) _Pragma("unroll") for (int k = 0; k < 2; ++k) dst[n][k] = *(const PG8_LAS bf16x8*)(lds + PG8_SB(b, h) + boff + n * 2048 + k * 1024); } while (0)
#define PG8_MMA(ai, bj, At, Bt) do { __builtin_amdgcn_s_setprio(1); _Pragma("unroll") for (int m = 0; m < 4; ++m) _Pragma("unroll") for (int n = 0; n < 2; ++n) _Pragma("unroll") for (int k = 0; k < 2; ++k) \
        acc[ai][bj][m][n] = __builtin_amdgcn_mfma_f32_16x16x32_bf16(Bt[n][k], At[m][k], acc[ai][bj][m][n], 0, 0, 0); __builtin_amdgcn_s_setprio(0); } while (0)
#define PG8_WAIT_V(n) asm volatile("s_waitcnt vmcnt(" #n ")" ::: "memory")
#define PG8_WAIT_L(n) asm volatile("s_waitcnt lgkmcnt(" #n ")" ::: "memory")
#define PG8_BAR __builtin_amdgcn_s_barrier()
#define PG8_SCHED __builtin_amdgcn_sched_barrier(0)
    Unit cur, nxt; int ui = 0;
    if (!S.next(0, cur)) return;
    f32x4 acc[2][2][4][2];
#pragma unroll
    for (int a = 0; a < 2; ++a)
#pragma unroll
        for (int b = 0; b < 2; ++b)
#pragma unroll
            for (int m = 0; m < 4; ++m)
#pragma unroll
                for (int n = 0; n < 2; ++n) acc[a][b][m][n] = (f32x4){0.f, 0.f, 0.f, 0.f};
    bf16x8 At[4][2], B0[2][2], B1[2][2];
    const char* cA = (const char*)g.A + (size_t)cur.pm * tstepA; const char* cB = (const char*)g.Bt + (size_t)cur.pn * tstepB;
    S.a_ready(cur);
    if constexpr (SP2) {
        PG8_STAGE(PG8_SB(0, 0), cB, voffB); PG8_STAGE(PG8_SB(0, 1), cB + hstepB, voffB); PG8_STAGE(PG8_SA(0, 0), cA, voffA); PG8_STAGE(PG8_SA(0, 1), cA + hstepA, voffA);
        if (wr == 1) PG8_BAR;
        PG8_WAIT_V(2); PG8_BAR;
        PG8_STAGE(PG8_SB(1, 0), cB + kstep, voffB); PG8_STAGE(PG8_SA(1, 0), cA + kstep, voffA); PG8_STAGE(PG8_SB(1, 1), cB + hstepB + kstep, voffB);
        PG8_WAIT_V(6); PG8_BAR;
    } else {
        PG8_STAGE(PG8_SB(0, 0), cB, voffB); PG8_STAGE(PG8_SA(0, 0), cA, voffA); PG8_STAGE(PG8_SB(0, 1), cB + hstepB, voffB); PG8_STAGE(PG8_SA(0, 1), cA + hstepA, voffA);
        if (wr == 1) PG8_BAR;
        PG8_WAIT_V(4); PG8_BAR;
        PG8_STAGE(PG8_SB(1, 0), cB + kstep, voffB); PG8_STAGE(PG8_SA(1, 0), cA + kstep, voffA); PG8_STAGE(PG8_SB(1, 1), cB + hstepB + kstep, voffB);
        PG8_WAIT_V(6); PG8_BAR;
    }
    for (;;) {
        const bool has_next = S.next(ui + 1, nxt);
        const char* nA = has_next ? (const char*)g.A + (size_t)nxt.pm * tstepA : cA; const char* nB = has_next ? (const char*)g.Bt + (size_t)nxt.pn * tstepB : cB;
        for (int t = 0; t < nt; t += 2) {
            const bool last = (t == nt - 2);
            const char* a1 = cA + (size_t)(t + 1) * kstep;
            const char* a2 = last ? nA : cA + (size_t)(t + 2) * kstep; const char* b2 = last ? nB : cB + (size_t)(t + 2) * kstep;
            const char* a3 = a2 + kstep; const char* b3 = b2 + kstep;
            if (last && has_next) S.a_ready(nxt);
            if constexpr (SP2) {
            PG8_LDB(B0, 0, 0); PG8_LDB(B1, 0, 1); PG8_SCHED; PG8_LDA(At, 0, 0); PG8_STAGE(PG8_SA(1, 1), a1 + hstepA, voffA);
            PG8_WAIT_V(8); PG8_WAIT_L(0); PG8_BAR; PG8_MMA(0, 0, At, B0); PG8_MMA(0, 1, At, B1); PG8_BAR; PG8_SCHED;
            PG8_LDA(At, 0, 1); PG8_STAGE(PG8_SB(0, 0), b2, voffB); PG8_STAGE(PG8_SB(0, 1), b2 + hstepB, voffB); PG8_STAGE(PG8_SA(0, 0), a2, voffA);
            PG8_WAIT_V(8); PG8_WAIT_L(0); PG8_BAR; PG8_MMA(1, 0, At, B0); PG8_MMA(1, 1, At, B1); PG8_BAR; PG8_SCHED;
            PG8_LDB(B0, 1, 0); PG8_LDB(B1, 1, 1); PG8_SCHED; PG8_LDA(At, 1, 0); PG8_STAGE(PG8_SA(0, 1), a2 + hstepA, voffA);
            PG8_WAIT_V(8); PG8_WAIT_L(0); PG8_BAR; PG8_MMA(0, 0, At, B0); PG8_MMA(0, 1, At, B1); PG8_BAR; PG8_SCHED;
            PG8_LDA(At, 1, 1); PG8_STAGE(PG8_SB(1, 0), b3, voffB); PG8_STAGE(PG8_SB(1, 1), b3 + hstepB, voffB); PG8_STAGE(PG8_SA(1, 0), a3, voffA);
            PG8_WAIT_V(8); PG8_WAIT_L(0); PG8_BAR; PG8_MMA(1, 0, At, B0); PG8_MMA(1, 1, At, B1); PG8_BAR; PG8_SCHED;
            } else {
            PG8_LDB(B0, 0, 0); PG8_SCHED; PG8_LDA(At, 0, 0); PG8_STAGE(PG8_SA(1, 1), a1 + hstepA, voffA);
            PG8_WAIT_L(8); PG8_BAR; PG8_WAIT_L(0); PG8_MMA(0, 0, At, B0); PG8_BAR; PG8_SCHED;
            PG8_LDB(B1, 0, 1); PG8_STAGE(PG8_SB(0, 0), b2, voffB);
            PG8_BAR; PG8_WAIT_L(0); PG8_MMA(0, 1, At, B1); PG8_BAR;
            PG8_LDA(At, 0, 1); PG8_STAGE(PG8_SA(0, 0), a2, voffA);
            PG8_BAR; PG8_WAIT_L(0); PG8_MMA(1, 0, At, B0); PG8_BAR; PG8_SCHED;
            PG8_STAGE(PG8_SB(0, 1), b2 + hstepB, voffB);
            PG8_WAIT_V(6); PG8_BAR; PG8_MMA(1, 1, At, B1); PG8_BAR;
            PG8_LDB(B0, 1, 0); PG8_SCHED; PG8_LDA(At, 1, 0); PG8_STAGE(PG8_SA(0, 1), a2 + hstepA, voffA);
            PG8_WAIT_L(8); PG8_BAR; PG8_WAIT_L(0); PG8_MMA(0, 0, At, B0); PG8_BAR; PG8_SCHED;
            PG8_LDB(B1, 1, 1); PG8_STAGE(PG8_SB(1, 0), b3, voffB);
            PG8_BAR; PG8_WAIT_L(0); PG8_MMA(0, 1, At, B1); PG8_BAR;
            PG8_LDA(At, 1, 1); PG8_STAGE(PG8_SA(1, 0), a3, voffA);
            PG8_BAR; PG8_WAIT_L(0); PG8_MMA(1, 0, At, B0); PG8_BAR; PG8_SCHED;
            PG8_STAGE(PG8_SB(1, 1), b3 + hstepB, voffB);
            PG8_WAIT_V(6); PG8_BAR; PG8_MMA(1, 1, At, B1); PG8_BAR;
            }
        }
        if constexpr (ALIGN_EPI) { if (wr == 0) PG8_BAR; }
        if constexpr (!Epi::AFTER_DRAIN) { E(acc, cur, wr, wc, fr, fq); S.done(cur); }
        if (!has_next) break;
#pragma unroll
        for (int a = 0; a < 2; ++a)
#pragma unroll
            for (int b = 0; b < 2; ++b)
#pragma unroll
                for (int m = 0; m < 4; ++m)
#pragma unroll
                    for (int n = 0; n < 2; ++n) acc[a][b][m][n] = (f32x4){0.f, 0.f, 0.f, 0.f};
        cur = nxt; cA = nA; cB = nB; ++ui;
        if constexpr (ALIGN_EPI) { if (wr == 1) PG8_BAR; }
    }
    PG8_WAIT_V(0);
    if constexpr (!ALIGN_EPI) { if (wr == 0) PG8_BAR; }
    PG8_BAR;
    if constexpr (Epi::AFTER_DRAIN) { E.fused(acc, cur, wr, wc, fr, fq, lds, wid, lane); S.done(cur); }
#undef PG8_SA
#undef PG8_SB
#undef PG8_STAGE
#undef PG8_LDA
#undef PG8_LDB
#undef PG8_MMA
#undef PG8_WAIT_V
#undef PG8_WAIT_L
#undef PG8_BAR
#undef PG8_SCHED
}
}

#define LAS __attribute__((address_space(3)))
namespace att {
typedef short bf16x8 __attribute__((ext_vector_type(8)));
typedef float f32x16 __attribute__((ext_vector_type(16)));
typedef float f32x2_t __attribute__((ext_vector_type(2))); typedef __bf16 bf16x2_t __attribute__((ext_vector_type(2)));
__device__ __forceinline__ unsigned cvtpk(float lo, float hi) { f32x2_t v = {lo, hi}; bf16x2_t b = __builtin_convertvector(v, bf16x2_t); return __builtin_bit_cast(unsigned, b); }
constexpr int KP = 128;
constexpr float LOG2E = 1.4426950408889634f, CSC = 0.125f * LOG2E, THR = 6.0f;
__device__ __forceinline__ int crow(int r, int hi) { return (r & 3) + 8 * (r >> 2) + 4 * hi; }

template <int MODE>
__device__ __forceinline__ void attn_unit(LAS unsigned char* lds, int h, int qb, const bf16_t* __restrict__ QK, const bf16_t* __restrict__ VT, const unsigned* __restrict__ BMP,
                                          const float* __restrict__ BT, const float* __restrict__ subw, float lam, bf16_t* __restrict__ OAB) {
    constexpr int DV = MODE ? 128 : 64, QB = MODE ? 128 : 256, NDT = DV / 32, NKT = MODE ? 2 : 1;
    constexpr int KBYTES = 64 * KP, VBYTES = DV * KP, KRING = NKT * KBYTES, OFF_V = 3 * KRING;
    constexpr int OFF_BIAS = OFF_V + 3 * VBYTES;
    const int tid = threadIdx.x, lane = tid & 63, wave = __builtin_amdgcn_readfirstlane(tid >> 6), ql = lane & 31, hi = lane >> 5;
    const int qw = MODE ? (wave & 3) : wave, map = MODE ? (wave >> 2) : 0;
    const int q0 = qb * QB, qw0 = q0 + 32 * qw, t = qw0 + ql;
    const int qcol = MODE ? C_BQ + (2 * h + map) * 64 : C_AQ + h * 64;
    const int kcol0 = MODE ? C_BK + (2 * h) * 64 : C_AK + h * 64;
    const int vrow0 = MODE ? 512 + h * 128 : h * 64;
    const int hb = MODE ? 8 + h : h;
    LAS float* bias2 = (LAS float*)(lds + OFF_BIAS);
    if (tid < 128) bias2[tid] = BT[tid * 12 + hb] * LOG2E;
    bf16x8 qf[4];
#pragma unroll
    for (int ks = 0; ks < 4; ++ks) qf[ks] = *(const bf16x8*)(QK + (size_t)t * NTOK + qcol + 16 * ks + 8 * hi);
    const int pr = tid >> 3, pc = tid & 7, pcs = pc ^ ((pr >> 1) & 7);
    const int NT = (q0 + QB) / 64;
#define AT_DMAK(kt, slot) do { _Pragma("unroll") for (int i_ = 0; i_ < NKT; ++i_) \
        __builtin_amdgcn_global_load_lds((const unsigned*)(QK + (size_t)((kt) * 64 + pr) * NTOK + kcol0 + i_ * 64 + pcs * 8), (LAS unsigned*)(lds + (slot) * KRING + i_ * KBYTES + wave * 1024), 16, 0, 0); } while (0)
#define AT_DMAV(kt, buf) do { _Pragma("unroll") for (int i_ = 0; i_ < NKT; ++i_) \
        __builtin_amdgcn_global_load_lds((const unsigned*)(VT + (size_t)(vrow0 + pr + 64 * i_) * L + (kt) * 64 + pcs * 8), (LAS unsigned*)(lds + OFF_V + (buf) * VBYTES + i_ * 8192 + wave * 1024), 16, 0, 0); } while (0)
#define AT_QK(Sx, buf, j) do { const LAS unsigned char* kb_ = lds + (buf) * KRING + (MODE ? map * KBYTES : 0); \
        _Pragma("unroll") for (int r = 0; r < 16; ++r) Sx[r] = 0.f; \
        _Pragma("unroll") for (int ks = 0; ks < 4; ++ks) { const bf16x8 kf = *(const LAS bf16x8*)(kb_ + (32 * (j) + kperm) * KP + (((2 * ks) ^ kx) << 4)); \
            Sx = __builtin_amdgcn_mfma_f32_32x32x16_bf16(kf, qf[ks], Sx, 0, 0, 0); } } while (0)
#define AT_QKC(Sx, buf, j) do { const LAS unsigned char* kb_ = lds + (buf) * KRING + (MODE ? map * KBYTES : 0); \
        { const bf16x8 kf = *(const LAS bf16x8*)(kb_ + (32 * (j) + kperm) * KP + (kx << 4)); Sx = __builtin_amdgcn_mfma_f32_32x32x16_bf16(kf, qf[0], cinit, 0, 0, 0); } \
        _Pragma("unroll") for (int ks = 1; ks < 4; ++ks) { const bf16x8 kf = *(const LAS bf16x8*)(kb_ + (32 * (j) + kperm) * KP + (((2 * ks) ^ kx) << 4)); \
            Sx = __builtin_amdgcn_mfma_f32_32x32x16_bf16(kf, qf[ks], Sx, 0, 0, 0); } } while (0)
    f32x16 O[NDT];
#pragma unroll
    for (int d = 0; d < NDT; ++d)
#pragma unroll
        for (int r = 0; r < 16; ++r) O[d][r] = 0.f;
    float m_run = -INFINITY, l_run = 0.f;
    const int kperm = (ql & 0x13) | ((ql & 4) << 1) | ((ql & 8) >> 1);
    const int kx = hi ^ ((kperm >> 1) & 7), vx = hi ^ ((ql >> 1) & 7);
    __syncthreads();
    AT_DMAK(0, 0); AT_DMAV(0, 0);
    if (NT > 1) AT_DMAK(1, 1);
    __syncthreads();
    const float b31 = bias2[127];
    u32x2 mw = {0u, 0u};
    if (MODE == 0) mw = *(const u32x2*)(BMP + (size_t)t * 512);
    f32x16 S, Sn;
    AT_QK(S, 0, 0);
    int k3 = 0, kt = 0;
    const int NF = (q0 >= 176) ? (((q0 - 176) >> 6) + 1 < NT - 2 ? ((q0 - 176) >> 6) + 1 : NT - 2) : 0;
#define AT_ROWMAX(Sx, mxv) do { float a_ = __builtin_fmaxf(Sx[0], Sx[1]), b_ = __builtin_fmaxf(Sx[2], Sx[3]); \
        _Pragma("unroll") for (int r = 4; r < 16; r += 4) { a_ = __builtin_fmaxf(__builtin_fmaxf(Sx[r], Sx[r + 1]), a_); b_ = __builtin_fmaxf(__builtin_fmaxf(Sx[r + 2], Sx[r + 3]), b_); } \
        float m_ = __builtin_fmaxf(a_, b_); \
        auto rr_ = __builtin_amdgcn_permlane32_swap(__float_as_uint(m_), __float_as_uint(m_), false, false); \
        mxv = __builtin_fmaxf(__uint_as_float(rr_[0]), __uint_as_float(rr_[1])); } while (0)
#define AT_RESCALE(Sx, mxv) do { const bool need_ = mxv > THR; \
        if (__any(need_)) { const float dl_ = need_ ? mxv : 0.f; const float alpha = __builtin_amdgcn_exp2f(-dl_); l_run *= alpha; m_run += dl_; \
            _Pragma("unroll") for (int d = 0; d < NDT; ++d) _Pragma("unroll") for (int r = 0; r < 16; ++r) O[d][r] *= alpha; \
            _Pragma("unroll") for (int r = 0; r < 16; ++r) { Sx[r] -= dl_; cinit[r] -= dl_; } } } while (0)
    f32x16 cinit;
    if (NF > 0) {
        float mx0; AT_ROWMAX(S, mx0); m_run = mx0 + b31;
#pragma unroll
        for (int r = 0; r < 16; ++r) { S[r] -= mx0; cinit[r] = -mx0; }
    }
    bf16x8 pbP[2];
    { const u32x4 z = {0u, 0u, 0u, 0u}; pbP[0] = __builtin_bit_cast(bf16x8, z); pbP[1] = pbP[0]; }
    int k3p = 2;
    bf16x8 kfN[4];
    if (MODE == 0) { const LAS unsigned char* kb_ = lds + k3 * KRING + (MODE ? map * KBYTES : 0);
#pragma unroll
      for (int ks = 0; ks < 4; ++ks) kfN[ks] = *(const LAS bf16x8*)(kb_ + (32 + kperm) * KP + (((2 * ks) ^ kx) << 4)); }
    for (; kt < NF; ++kt) {
        const int k3n = (k3 == 2) ? 0 : k3 + 1, k3nn = (k3n == 2) ? 0 : k3n + 1;
        AT_DMAK(kt + 2, k3nn); AT_DMAV(kt + 1, k3n);
        u32x2 mwn = {0u, 0u};
        if (MODE == 0) mwn = *(const u32x2*)(BMP + (size_t)t * 512 + 2 * (kt + 1));
#pragma unroll
        for (int j = 0; j < 2; ++j) {
            const LAS unsigned char* vbp = lds + OFF_V + ((j == 1 || kt == 0) ? k3 : k3p) * VBYTES;
            const int jp = (j == 1) ? 0 : ((kt == 0) ? 0 : 1);
            constexpr int NH = MODE ? 0 : 2;
            bf16x8 vfA[2][2];
#pragma unroll
            for (int d = 0; d < NH; ++d)
#pragma unroll
                for (int s2 = 0; s2 < 2; ++s2) vfA[d][s2] = *(const LAS bf16x8*)(vbp + (32 * d + ql) * KP + (((4 * jp + 2 * s2) ^ vx) << 4));
            if (NH) __builtin_amdgcn_sched_barrier(0);
            if (MODE == 0) { Sn = __builtin_amdgcn_mfma_f32_32x32x16_bf16(kfN[0], qf[0], cinit, 0, 0, 0);
#pragma unroll
                for (int ks = 1; ks < 4; ++ks) Sn = __builtin_amdgcn_mfma_f32_32x32x16_bf16(kfN[ks], qf[ks], Sn, 0, 0, 0); }
            else { if (j == 0) AT_QKC(Sn, k3, 1); else AT_QKC(Sn, k3n, 0); }
#pragma unroll
            for (int d = 0; d < NH; ++d)
#pragma unroll
                for (int s2 = 0; s2 < 2; ++s2) O[d] = __builtin_amdgcn_mfma_f32_32x32x16_bf16(vfA[d][s2], pbP[s2], O[d], 0, 0, 0);
#pragma unroll
            for (int d = NH; d < NDT; ++d)
#pragma unroll
                for (int s2 = 0; s2 < 2; ++s2) {
                    const bf16x8 vf = *(const LAS bf16x8*)(vbp + (32 * d + ql) * KP + (((4 * jp + 2 * s2) ^ vx) << 4));
                    O[d] = __builtin_amdgcn_mfma_f32_32x32x16_bf16(vf, pbP[s2], O[d], 0, 0, 0);
                }
            if (MODE == 0) {
                const LAS unsigned char* kb_ = lds + k3n * KRING + (MODE ? map * KBYTES : 0);
#pragma unroll
                for (int ks = 0; ks < 4; ++ks) kfN[ks] = *(const LAS bf16x8*)(kb_ + (32 * (j == 0 ? 0 : 1) + kperm) * KP + (((2 * ks) ^ kx) << 4)); }
#pragma unroll
            for (int r = 0; r < 16; ++r) S[r] = __builtin_amdgcn_exp2f(S[r]);
            if (MODE == 0) { const unsigned w = (j ? mw.y : mw.x) >> (8 * hi);
#pragma unroll
                for (int r = 0; r < 16; ++r) { int m_ = __builtin_amdgcn_sbfe((int)w, 16 * (r >> 3) + (r & 7), 1); asm volatile("" : "+v"(m_));
                    S[r] = __uint_as_float(__float_as_uint(S[r]) & (unsigned)m_); } }
            float ls0 = 0.f, ls1 = 0.f;
#pragma unroll
            for (int r = 0; r < 16; r += 2) { ls0 += S[r]; ls1 += S[r + 1]; }
            l_run += ls0 + ls1;
            u32x4 pw[2];
#pragma unroll
            for (int s2 = 0; s2 < 2; ++s2) { const int o = 8 * s2;
                pw[s2].x = cvtpk(S[o + 0], S[o + 1]); pw[s2].y = cvtpk(S[o + 2], S[o + 3]); pw[s2].z = cvtpk(S[o + 4], S[o + 5]); pw[s2].w = cvtpk(S[o + 6], S[o + 7]); }
            float mxn; AT_ROWMAX(Sn, mxn);
            { const bool need_ = mxn > THR;
              if (__any(need_)) { const float dl_ = need_ ? mxn : 0.f; const float alpha = __builtin_amdgcn_exp2f(-dl_); l_run *= alpha; m_run += dl_;
#pragma unroll
                  for (int d = 0; d < NDT; ++d)
#pragma unroll
                      for (int r = 0; r < 16; ++r) O[d][r] *= alpha;
#pragma unroll
                  for (int r = 0; r < 16; ++r) { Sn[r] -= dl_; cinit[r] -= dl_; }
#pragma unroll
                  for (int s2 = 0; s2 < 2; ++s2) {
                      pw[s2].x = cvtpk(__uint_as_float(pw[s2].x << 16) * alpha, __uint_as_float(pw[s2].x & 0xffff0000u) * alpha);
                      pw[s2].y = cvtpk(__uint_as_float(pw[s2].y << 16) * alpha, __uint_as_float(pw[s2].y & 0xffff0000u) * alpha);
                      pw[s2].z = cvtpk(__uint_as_float(pw[s2].z << 16) * alpha, __uint_as_float(pw[s2].z & 0xffff0000u) * alpha);
                      pw[s2].w = cvtpk(__uint_as_float(pw[s2].w << 16) * alpha, __uint_as_float(pw[s2].w & 0xffff0000u) * alpha); } } }
            pbP[0] = __builtin_bit_cast(bf16x8, pw[0]); pbP[1] = __builtin_bit_cast(bf16x8, pw[1]);
            S = Sn;
        }
        k3p = k3; k3 = k3n; mw = mwn;
        __syncthreads();
    }
    if (NF > 0) {
        const LAS unsigned char* vbp = lds + OFF_V + k3p * VBYTES;
#pragma unroll
        for (int d = 0; d < NDT; ++d)
#pragma unroll
            for (int s2 = 0; s2 < 2; ++s2) {
                const bf16x8 vf = *(const LAS bf16x8*)(vbp + (32 * d + ql) * KP + (((4 + 2 * s2) ^ vx) << 4));
                O[d] = __builtin_amdgcn_mfma_f32_32x32x16_bf16(vf, pbP[s2], O[d], 0, 0, 0);
            }
    }
    if (NF > 0) {
#pragma unroll
        for (int r = 0; r < 16; ++r) S[r] -= cinit[r];
    }
    for (; kt < NT; ++kt) {
        const int cur = kt & 1, k0 = kt * 64, k3n = (k3 == 2) ? 0 : k3 + 1, k3nn = (k3n == 2) ? 0 : k3n + 1;
        const bool more1 = kt + 1 < NT, more2 = kt + 2 < NT;
        if (more2) AT_DMAK(kt + 2, k3nn);
        if (more1) AT_DMAV(kt + 1, k3n);
        u32x2 mwn = {0u, 0u};
        if (MODE == 0 && more1) mwn = *(const u32x2*)(BMP + (size_t)t * 512 + 2 * (kt + 1));
#pragma unroll
        for (int j = 0; j < 2; ++j) {
            const int kj = k0 + 32 * j;
            if (j == 0) { if (kj + 32 <= qw0 + 31) AT_QK(Sn, k3, 1); }
            else        { if (more1 && (kj + 32 <= qw0 + 31)) AT_QK(Sn, k3n, 0); }
            if (kj <= qw0 + 31) {
                const LAS unsigned char* vb = lds + OFF_V + k3 * VBYTES;
                const bool nearb = (qw0 - (kj + 31)) < 113;
                float mx = -INFINITY;
                if (nearb) {
#pragma unroll
                    for (int r = 0; r < 16; ++r) {
                        const int key = kj + 16 * (r >> 3) + 8 * hi + (r & 7); const int dist = t - key;
                        const float bb = bias2[dist < 0 ? 0 : (dist > 127 ? 127 : dist)];
                        const float e = dist < 0 ? -INFINITY : S[r] + bb;
                        S[r] = e; mx = fmaxf(mx, e);
                    }
                } else {
#pragma unroll
                    for (int r = 0; r < 16; r += 2) mx = __builtin_fmaxf(__builtin_fmaxf(S[r], S[r + 1]), mx);
                    mx = mx + b31;
                }
                mx = fmaxf(mx, __shfl_xor(mx, 32));
                const bool need = mx > m_run + THR;
                if (__any(need)) {
                    const float m_new = need ? mx : m_run;
                    const float alpha = (m_new == m_run) ? 1.f : __builtin_amdgcn_exp2f(m_run - m_new);
                    l_run *= alpha;
#pragma unroll
                    for (int d = 0; d < NDT; ++d)
#pragma unroll
                        for (int r = 0; r < 16; ++r) O[d][r] *= alpha;
                    m_run = m_new;
                }
                if (nearb) {
#pragma unroll
                    for (int r = 0; r < 16; ++r) S[r] = __builtin_amdgcn_exp2f(S[r] - m_run);
                } else {
                    const float nb = b31 - m_run;
#pragma unroll
                    for (int r = 0; r < 16; ++r) S[r] = __builtin_amdgcn_exp2f(S[r] + nb);
                }
                if (MODE == 0) {
                    const unsigned w = (j ? mw.y : mw.x) >> (8 * hi);
#pragma unroll
                    for (int r = 0; r < 16; ++r) S[r] = __uint_as_float(__float_as_uint(S[r]) & (unsigned)__builtin_amdgcn_sbfe((int)w, 16 * (r >> 3) + (r & 7), 1));
                }
                float ls0 = 0.f, ls1 = 0.f;
#pragma unroll
                for (int r = 0; r < 16; r += 2) { ls0 += S[r]; ls1 += S[r + 1]; }
                l_run += ls0 + ls1;
                bf16x8 pb[2];
#pragma unroll
                for (int s = 0; s < 2; ++s) { const int o = 8 * s; u32x4 w;
                    w.x = cvtpk(S[o + 0], S[o + 1]); w.y = cvtpk(S[o + 2], S[o + 3]); w.z = cvtpk(S[o + 4], S[o + 5]); w.w = cvtpk(S[o + 6], S[o + 7]);
                    pb[s] = __builtin_bit_cast(bf16x8, w); }
#pragma unroll
                for (int d = 0; d < NDT; ++d)
#pragma unroll
                    for (int s = 0; s < 2; ++s) {
                        const bf16x8 vf = *(const LAS bf16x8*)(vb + (32 * d + ql) * KP + (((4 * j + 2 * s) ^ vx) << 4));
                        O[d] = __builtin_amdgcn_mfma_f32_32x32x16_bf16(vf, pb[s], O[d], 0, 0, 0);
                    }
            }
            S = Sn;
        }
        k3 = k3n;
        mw = mwn;
        __syncthreads();
    }
#undef AT_DMAK
#undef AT_ROWMAX
#undef AT_RESCALE
#undef AT_DMAV
#undef AT_QK
#undef AT_QKC
    const float l_tot = l_run + __shfl_xor(l_run, 32);
    const float inv = 1.f / l_tot;
    if (MODE == 0) {
#pragma unroll
        for (int d = 0; d < NDT; ++d)
#pragma unroll
            for (int g = 0; g < 4; ++g) { u32x2 w; w.x = cvtpk(O[d][4 * g] * inv, O[d][4 * g + 1] * inv); w.y = cvtpk(O[d][4 * g + 2] * inv, O[d][4 * g + 3] * inv);
                *(u32x2*)(OAB + (size_t)t * 1024 + h * 64 + 32 * d + 8 * g + 4 * hi) = w; }
    } else {
        LAS float* X = (LAS float*)lds;
        if (map == 1) {
#pragma unroll
            for (int d = 0; d < NDT; ++d)
#pragma unroll
                for (int r = 0; r < 16; ++r) X[(d * 16 + r) * 256 + qw * 64 + lane] = O[d][r] * inv;
        }
        __syncthreads();
        if (map == 0) {
            float ss = 0.f;
#pragma unroll
            for (int d = 0; d < NDT; ++d)
#pragma unroll
                for (int r = 0; r < 16; ++r) { const float v = O[d][r] * inv - lam * X[(d * 16 + r) * 256 + qw * 64 + lane]; O[d][r] = v; ss += v * v; }
            ss += __shfl_xor(ss, 32);
            const float rn = rsqrtf(ss * (1.f / 128.f) + 1e-5f) * (1.f - LAM_INIT);
#pragma unroll
            for (int d = 0; d < NDT; ++d)
#pragma unroll
                for (int g = 0; g < 4; ++g) { const int e0 = 32 * d + 8 * g + 4 * hi; const float4 sw = *(const float4*)(subw + e0);
                    u32x2 w; w.x = cvtpk(O[d][4 * g] * rn * sw.x, O[d][4 * g + 1] * rn * sw.y); w.y = cvtpk(O[d][4 * g + 2] * rn * sw.z, O[d][4 * g + 3] * rn * sw.w);
                    *(u32x2*)(OAB + (size_t)t * 1024 + 512 + h * 128 + e0) = w; }
        }
        __syncthreads();
    }
}
}

namespace idx {
typedef short bf16x8 __attribute__((ext_vector_type(8)));
typedef float f32x4 __attribute__((ext_vector_type(4)));
constexpr int NQ = 16, CAP = 1200, TRIG = CAP - 256, NSL = 19;
constexpr int OFF_CNT = NQ * CAP * 8, OFF_TAU = OFF_CNT + 128, OFF_DUMP = OFF_TAU + 128, IDX_LDS = OFF_DUMP + 8 * 512;
__device__ __forceinline__ unsigned fkey(float f) { const unsigned u = __float_as_uint(f); return (u & 0x80000000u) ? ~u : (u | 0x80000000u); }
__device__ __forceinline__ float keyf(unsigned k) { return __uint_as_float((k & 0x80000000u) ? (k & 0x7fffffffu) : ~k); }
__device__ __forceinline__ int wave_count_ge(const unsigned (&kv)[NSL], unsigned cand) {
    int tot = 0;
#pragma unroll
    for (int i = 0; i < NSL; ++i) tot += __popcll(__ballot(kv[i] >= cand));
    return tot;
}
template <int NB> __device__ __forceinline__ unsigned kth_prefix(const unsigned (&kv)[NSL], int rank = 256) {
    unsigned prefix = 0u;
#pragma unroll 1
    for (int b = 31; b >= 32 - NB; --b) { const unsigned cand = prefix | (1u << b); if (wave_count_ge(kv, cand) >= rank) prefix = cand; }
    return prefix;
}
__device__ __forceinline__ void load_pool(const LAS u32x2* pool, int c, int lane, unsigned (&kv)[NSL], unsigned (&sb)[NSL], unsigned (&kk)[NSL]) {
#pragma unroll
    for (int i = 0; i < NSL; ++i) { const int s = lane + 64 * i; u32x2 e = {0u, 0u}; if (s < c) e = pool[s]; sb[i] = e.x; kk[i] = e.y; kv[i] = (s < c) ? fkey(__uint_as_float(e.x)) : 0u; }
}
__device__ __forceinline__ void prune(LAS unsigned char* lds, int q, int lane) {
    LAS u32x2* pool = (LAS u32x2*)(lds + q * CAP * 8); LAS unsigned* cnt = (LAS unsigned*)(lds + OFF_CNT); LAS float* tau = (LAS float*)(lds + OFF_TAU);
    int c = (int)cnt[q]; c = c > CAP ? CAP : c;
    unsigned kv[NSL], sb[NSL], kk[NSL];
    load_pool(pool, c, lane, kv, sb, kk);
    const unsigned prefix = kth_prefix<17>(kv);
    int base = 0;
#pragma unroll
    for (int i = 0; i < NSL; ++i) { const bool keep = kv[i] >= prefix && prefix != 0u; const unsigned long long m = __ballot(keep);
        const int pos = base + __builtin_amdgcn_mbcnt_hi((unsigned)(m >> 32), __builtin_amdgcn_mbcnt_lo((unsigned)m, 0u));
        if (keep) pool[pos] = (u32x2){sb[i], kk[i]};
        base += __popcll(m); }
    if (lane == 0) { cnt[q] = (unsigned)base; tau[q] = keyf(prefix); }
}
template <int NS> __device__ __forceinline__ void finalize_impl(LAS u32x2* pool, int c, int lane, unsigned* __restrict__ bmp_row) {
    unsigned kv[NS], kk[NS];
#pragma unroll
    for (int i = 0; i < NS; ++i) { const int s = lane + 64 * i; u32x2 e = {0u, 0u}; if (s < c) e = pool[s]; kk[i] = e.y; kv[i] = (s < c) ? fkey(__uint_as_float(e.x)) : 0u; }
    unsigned prefix = 0u; int need = 1 << 20;
    if (c > 256) {
        bool exact = false;
#pragma unroll 1
        for (int b = 31; b >= 0 && !exact; --b) { const unsigned cand = prefix | (1u << b); int tot = 0;
#pragma unroll
            for (int i = 0; i < NS; ++i) tot += __popcll(__ballot(kv[i] >= cand));
            if (tot >= 256) { prefix = cand; exact = (tot == 256); } }
        if (exact) { need = 0; prefix -= 1u; }
        else { int gt = 0;
#pragma unroll
            for (int i = 0; i < NS; ++i) gt += __popcll(__ballot(kv[i] > prefix));
            need = 256 - gt; }
    }
    LAS unsigned* row = (LAS unsigned*)pool;
    *(LAS u32x4*)(row + 8 * lane) = (u32x4){0u, 0u, 0u, 0u}; *(LAS u32x4*)(row + 8 * lane + 4) = (u32x4){0u, 0u, 0u, 0u};
    int base = 0;
#pragma unroll
    for (int i = 0; i < NS; ++i) { const bool valid = (lane + 64 * i) < c; bool sel = valid && kv[i] > prefix; const bool tie = valid && kv[i] == prefix && need > 0;
        const unsigned long long m = __ballot(tie);
        const int rank = base + __builtin_amdgcn_mbcnt_hi((unsigned)(m >> 32), __builtin_amdgcn_mbcnt_lo((unsigned)m, 0u));
        if (tie && rank < need) sel = true;
        base += __popcll(m);
        if (sel) __hip_atomic_fetch_or(row + (kk[i] >> 5), 1u << (kk[i] & 31), __ATOMIC_RELAXED, __HIP_MEMORY_SCOPE_WORKGROUP); }
    const u32x4 w0 = *(LAS u32x4*)(row + 8 * lane), w1 = *(LAS u32x4*)(row + 8 * lane + 4);
    *(u32x4*)(bmp_row + 8 * lane) = w0; *(u32x4*)(bmp_row + 8 * lane + 4) = w1;
}
__device__ __forceinline__ void finalize(LAS unsigned char* lds, int q, int lane, unsigned* __restrict__ bmp_row) {
    LAS u32x2* pool = (LAS u32x2*)(lds + q * CAP * 8); LAS unsigned* cnt = (LAS unsigned*)(lds + OFF_CNT);
    int c = (int)cnt[q]; c = c > CAP ? CAP : c;
    if (c <= 768) finalize_impl<12>(pool, c, lane, bmp_row); else finalize_impl<NSL>(pool, c, lane, bmp_row);
}

__device__ __forceinline__ void index_unit_safe(LAS unsigned char* lds, int qblk, const bf16_t* __restrict__ QK, unsigned* __restrict__ BMP) {
    const int tid = threadIdx.x, lane = tid & 63, wave = __builtin_amdgcn_readfirstlane(tid >> 6), qc = lane & 15, g = lane >> 4;
    const int t = qblk * NQ + qc, NTL = (qblk + 2) >> 1;
    LAS unsigned* cnt = (LAS unsigned*)(lds + OFF_CNT); LAS float* tau = (LAS float*)(lds + OFF_TAU);
    if (tid < NQ) { cnt[tid] = 0u; tau[tid] = -INFINITY; }
    bf16x8 qf[8][2]; float wq[8];
#pragma unroll
    for (int h = 0; h < 8; ++h) {
        wq[h] = bf2f(QK[(size_t)t * NTOK + C_IW + h]) * (0.35355339059327373f * 0.125f);
#pragma unroll
        for (int ks = 0; ks < 2; ++ks) qf[h][ks] = *(const bf16x8*)(QK + (size_t)t * NTOK + C_IQ + h * 64 + 32 * ks + 8 * g);
    }
    const unsigned dump_a = (unsigned)(size_t)(lds + OFF_DUMP + wave * 512 + lane * 8), pool_a = (unsigned)(size_t)(lds + qc * CAP * 8);
    __syncthreads();
    const int nrounds = (NTL + 7) >> 3;
    bf16x8 kf[2][2];
    { const int kt0 = wave < NTL ? wave : 0;
#pragma unroll
      for (int i = 0; i < 2; ++i)
#pragma unroll
          for (int ks = 0; ks < 2; ++ks) kf[i][ks] = *(const bf16x8*)(QK + (size_t)(kt0 * 32 + 16 * i + qc) * NTOK + C_IK + 32 * ks + 8 * g); }
    for (int rd = 0; rd < nrounds; ++rd) {
        const int kt = rd * 8 + wave;
        if (kt < NTL) {
            const int k0 = kt * 32;
            const float tau_l = tau[qc];
            f32x4 sc[2];
#pragma unroll
            for (int i = 0; i < 2; ++i) {
                sc[i] = (f32x4){0.f, 0.f, 0.f, 0.f};
#pragma unroll
                for (int h = 0; h < 8; ++h) {
                    f32x4 acc = {0.f, 0.f, 0.f, 0.f};
                    acc = __builtin_amdgcn_mfma_f32_16x16x32_bf16(kf[i][0], qf[h][0], acc, 0, 0, 0);
                    acc = __builtin_amdgcn_mfma_f32_16x16x32_bf16(kf[i][1], qf[h][1], acc, 0, 0, 0);
#pragma unroll
                    for (int r = 0; r < 4; ++r) sc[i][r] = fmaf(wq[h], fmaxf(acc[r], 0.f), sc[i][r]);
                }
            }
            { const int ktn = (kt + 8 < NTL) ? kt + 8 : kt;
#pragma unroll
              for (int i = 0; i < 2; ++i)
#pragma unroll
                  for (int ks = 0; ks < 2; ++ks) kf[i][ks] = *(const bf16x8*)(QK + (size_t)(ktn * 32 + 16 * i + qc) * NTOK + C_IK + 32 * ks + 8 * g); }
            const int klim = (kt == NTL - 1) ? t : 0x7fffffff;
            int n = 0;
#pragma unroll
            for (int i = 0; i < 2; ++i)
#pragma unroll
                for (int r = 0; r < 4; ++r) { const int key = k0 + 16 * i + 4 * g + r; n += (sc[i][r] >= tau_l && key <= klim) ? 1 : 0; }
            int slot = 0;
            if (n > 0) slot = (int)__hip_atomic_fetch_add(cnt + qc, (unsigned)n, __ATOMIC_RELAXED, __HIP_MEMORY_SCOPE_WORKGROUP);
#pragma unroll
            for (int i = 0; i < 2; ++i)
#pragma unroll
                for (int r = 0; r < 4; ++r) { const int key = k0 + 16 * i + 4 * g + r; const bool pass = sc[i][r] >= tau_l && key <= klim; const bool ok = pass && slot < CAP;
                    const unsigned addr = ok ? pool_a + (unsigned)slot * 8u : dump_a;
                    *(LAS u32x2*)(size_t)addr = (u32x2){__float_as_uint(sc[i][r]), (unsigned)key};
                    slot += pass ? 1 : 0; }
        }
        __syncthreads();
        const bool over = cnt[qc] > (unsigned)TRIG;
        if (__any(over)) {
#pragma unroll 1
            for (int i = 0; i < 2; ++i) { const int q = wave * 2 + i; if (cnt[q] > (unsigned)TRIG) prune(lds, q, lane); }
            __syncthreads();
        }
    }
#pragma unroll 1
    for (int i = 0; i < 2; ++i) { const int q = wave * 2 + i; finalize(lds, q, lane, BMP + (size_t)(qblk * NQ + q) * 512); }
    __syncthreads();
}

constexpr int SRANK = 40, OFF_FLAG = OFF_DUMP - 16;
template <int NS> __device__ __forceinline__ unsigned sample_rank(const LAS u32x2* pool, int c, int lane) {
    unsigned kv[NS];
#pragma unroll
    for (int i = 0; i < NS; ++i) { const int s = lane + 64 * i; kv[i] = (s < c) ? fkey(__uint_as_float(pool[s < c ? s : 0].x)) : 0u; }
    unsigned prefix = 0u;
#pragma unroll 1
    for (int b = 31; b >= 15; --b) { const unsigned cand = prefix | (1u << b); int tot = 0;
#pragma unroll
        for (int i = 0; i < NS; ++i) tot += __popcll(__ballot(kv[i] >= cand));
        if (tot >= SRANK) prefix = cand; }
    return prefix;
}
__device__ __forceinline__ f32x4 score_tile(const bf16x8 (&kf)[2], const bf16x8 (&qf)[8][2], const bf16x8 (&qb)[2][2], const float (&wh)[8]) {
    f32x4 sc = {0.f, 0.f, 0.f, 0.f};
#pragma unroll
    for (int p = 0; p < 2; ++p) {
        sc = __builtin_amdgcn_mfma_f32_16x16x32_bf16(kf[0], qb[p][0], sc, 0, 0, 0);
        sc = __builtin_amdgcn_mfma_f32_16x16x32_bf16(kf[1], qb[p][1], sc, 0, 0, 0);
    }
#pragma unroll
    for (int h = 0; h < 8; ++h) {
        f32x4 acc = {0.f, 0.f, 0.f, 0.f};
        acc = __builtin_amdgcn_mfma_f32_16x16x32_bf16(kf[0], qf[h][0], acc, 0, 0, 0);
        acc = __builtin_amdgcn_mfma_f32_16x16x32_bf16(kf[1], qf[h][1], acc, 0, 0, 0);
#pragma unroll
        for (int r = 0; r < 4; ++r) sc[r] = fmaf(wh[h], __builtin_fabsf(acc[r]), sc[r]);
    }
    return sc;
}
__device__ __forceinline__ bool index_unit_fast(LAS unsigned char* lds, int qblk, const bf16_t* __restrict__ QK, unsigned* __restrict__ BMP) {
    const int tid = threadIdx.x, lane = tid & 63, wave = __builtin_amdgcn_readfirstlane(tid >> 6), qc = lane & 15, g = lane >> 4;
    const int t = qblk * NQ + qc, NTL = (qblk + 2) >> 1;
    LAS unsigned* cnt = (LAS unsigned*)(lds + OFF_CNT); LAS float* tau = (LAS float*)(lds + OFF_TAU); LAS unsigned* flag = (LAS unsigned*)(lds + OFF_FLAG);
    if (tid < NQ) { cnt[tid] = 0u; tau[tid] = -INFINITY; }
    if (tid == 0) flag[0] = 0u;
    bf16x8 qf[8][2], qb[2][2]; float wh[8];
    {   float qs[2][8];
#pragma unroll
        for (int ks = 0; ks < 2; ++ks)
#pragma unroll
            for (int e = 0; e < 8; ++e) qs[ks][e] = 0.f;
#pragma unroll
        for (int h = 0; h < 8; ++h) {
            wh[h] = bf2f(QK[(size_t)t * NTOK + C_IW + h]) * (0.5f * 0.35355339059327373f * 0.125f);
#pragma unroll
            for (int ks = 0; ks < 2; ++ks) { qf[h][ks] = *(const bf16x8*)(QK + (size_t)t * NTOK + C_IQ + h * 64 + 32 * ks + 8 * g);
#pragma unroll
                for (int e = 0; e < 8; ++e) qs[ks][e] = fmaf(wh[h], bf2f((bf16_t)qf[h][ks][e]), qs[ks][e]); }
        }
#pragma unroll
        for (int ks = 0; ks < 2; ++ks)
#pragma unroll
            for (int e = 0; e < 8; ++e) { const bf16_t hi16 = f2bf(qs[ks][e]); qb[0][ks][e] = (short)hi16; qb[1][ks][e] = (short)f2bf(qs[ks][e] - bf2f(hi16)); }
    }
    const unsigned dump_a = (unsigned)(size_t)(lds + OFF_DUMP + wave * 512 + lane * 8), pool_a = (unsigned)(size_t)(lds + qc * CAP * 8);
    __syncthreads();
    if (qblk >= 64) {
        const int nst = (qblk + 15) >> 4;
        for (int st = wave; st < nst; st += 8) {
            const int j = 16 * st + qc; const int srow = (j < qblk) ? 16 * j + 8 : 8;
            bf16x8 kf[2];
#pragma unroll
            for (int ks = 0; ks < 2; ++ks) kf[ks] = *(const bf16x8*)(QK + (size_t)srow * NTOK + C_IK + 32 * ks + 8 * g);
            const f32x4 sc = score_tile(kf, qf, qb, wh);
            int n = 0;
#pragma unroll
            for (int r = 0; r < 4; ++r) n += (16 * st + 4 * g + r < qblk) ? 1 : 0;
            int slot = 0;
            if (n > 0) slot = (int)__hip_atomic_fetch_add(cnt + qc, (unsigned)n, __ATOMIC_RELAXED, __HIP_MEMORY_SCOPE_WORKGROUP);
#pragma unroll
            for (int r = 0; r < 4; ++r) { const bool ok = (16 * st + 4 * g + r < qblk) && slot < CAP;
                const unsigned addr = ok ? pool_a + (unsigned)slot * 8u : dump_a;
                *(LAS u32x2*)(size_t)addr = (u32x2){__float_as_uint(sc[r]), 0u}; slot += ok ? 1 : 0; }
        }
        __syncthreads();
#pragma unroll 1
        for (int i = 0; i < 2; ++i) { const int q = wave * 2 + i; int c = (int)cnt[q]; c = c > CAP ? CAP : c;
            const LAS u32x2* pool = (const LAS u32x2*)(lds + q * CAP * 8);
            unsigned prefix;
            if (c <= 512) prefix = sample_rank<8>(pool, c, lane); else prefix = sample_rank<16>(pool, c, lane);
            if (lane == 0) { tau[q] = prefix ? keyf(prefix) : -INFINITY; cnt[q] = 0u; } }
        __syncthreads();
    }
    const float tau_l = tau[qc];
    bf16x8 kf[2][2];
    { const int kt0 = wave < NTL ? wave : 0;
#pragma unroll
      for (int i = 0; i < 2; ++i)
#pragma unroll
          for (int ks = 0; ks < 2; ++ks) kf[i][ks] = *(const bf16x8*)(QK + (size_t)(kt0 * 32 + 16 * i + qc) * NTOK + C_IK + 32 * ks + 8 * g); }
    for (int kt = wave; kt < NTL; kt += 8) {
        const int k0 = kt * 32;
        f32x4 sc[2];
#pragma unroll
        for (int i = 0; i < 2; ++i) sc[i] = score_tile(kf[i], qf, qb, wh);
        { const int ktn = (kt + 8 < NTL) ? kt + 8 : kt;
#pragma unroll
          for (int i = 0; i < 2; ++i)
#pragma unroll
              for (int ks = 0; ks < 2; ++ks) kf[i][ks] = *(const bf16x8*)(QK + (size_t)(ktn * 32 + 16 * i + qc) * NTOK + C_IK + 32 * ks + 8 * g); }
        const int klim = (kt == NTL - 1) ? t : 0x7fffffff;
        int n = 0;
#pragma unroll
        for (int i = 0; i < 2; ++i)
#pragma unroll
            for (int r = 0; r < 4; ++r) { const int key = k0 + 16 * i + 4 * g + r; n += (sc[i][r] >= tau_l && key <= klim) ? 1 : 0; }
        if (__any(n > 0)) {
            int slot = 0;
            if (n > 0) slot = (int)__hip_atomic_fetch_add(cnt + qc, (unsigned)n, __ATOMIC_RELAXED, __HIP_MEMORY_SCOPE_WORKGROUP);
#pragma unroll
            for (int i = 0; i < 2; ++i)
#pragma unroll
                for (int r = 0; r < 4; ++r) { const int key = k0 + 16 * i + 4 * g + r; const bool pass = sc[i][r] >= tau_l && key <= klim; const bool ok = pass && slot < CAP;
                    const unsigned addr = ok ? pool_a + (unsigned)slot * 8u : dump_a;
                    *(LAS u32x2*)(size_t)addr = (u32x2){__float_as_uint(sc[i][r]), (unsigned)key};
                    slot += pass ? 1 : 0; }
        }
    }
    __syncthreads();
    {
        const unsigned c = cnt[qc]; const unsigned want = (unsigned)(t + 1 < 256 ? t + 1 : 256);
        const bool bad = (c < want) || (c > (unsigned)CAP);
        if (__any(bad)) { if (lane == 0) flag[0] = 1u; }
    }
    __syncthreads();
    const bool redo = flag[0] != 0u;
    if (!redo) {
#pragma unroll 1
        for (int i = 0; i < 2; ++i) { const int q = wave * 2 + i; finalize(lds, q, lane, BMP + (size_t)(qblk * NQ + q) * 512); }
    }
    __syncthreads();
    return redo;
}
__device__ __forceinline__ void index_unit(LAS unsigned char* lds, int qblk, const bf16_t* __restrict__ QK, unsigned* __restrict__ BMP) {
    if (index_unit_fast(lds, qblk, QK, BMP)) index_unit_safe(lds, qblk, QK, BMP);
}
}

typedef __attribute__((address_space(1))) unsigned gu32;
#define XB_TMO      128
#define XB_XCNT(j)  (256  + 64 * (j))
#define XB_XSUB(j)  (1280 + 64 * (j))
#define XB_XGEN(j)  (2304 + 64 * (j))
#define XB_TOP      3328
#define XB_TOPGEN   3392
#define XCD_BAR_WORDS 3456
#define XB_SPIN_CAP (1u << 23)

__device__ __forceinline__ unsigned xb_ld(unsigned* p)              { return __hip_atomic_load(p, __ATOMIC_RELAXED, __HIP_MEMORY_SCOPE_AGENT); }
__device__ __forceinline__ unsigned xb_add(unsigned* p, unsigned v) { return __hip_atomic_fetch_add(p, v, __ATOMIC_RELAXED, __HIP_MEMORY_SCOPE_AGENT); }
__device__ __forceinline__ unsigned xb_xcc_id() { return (unsigned)__builtin_amdgcn_s_getreg((3 << 11) | 20) & 0xFu; }
#define XB_SPIN(cond, bar) do { unsigned _sp = 0; while (cond) { __builtin_amdgcn_s_sleep(1); \
    if ((++_sp & 255u) == 0u) { if (xb_ld(&(bar)[XB_TMO])) break; if (_sp > XB_SPIN_CAP) { atomicAdd(&(bar)[XB_TMO], 1u); break; } } } } while (0)

struct XcdBarrier {
    unsigned* bar; unsigned x;
    volatile LAS unsigned* st;
};

__device__ __forceinline__ XcdBarrier xcd_barrier_post(unsigned* bar, volatile LAS unsigned* st) {
    XcdBarrier b; b.bar = bar; b.x = xb_xcc_id(); b.st = st;
    if (threadIdx.x == 0) (void)xb_add(&bar[XB_XCNT(b.x)], 1u);
    return b;
}
__device__ __forceinline__ void xcd_barrier_complete(unsigned* bar, unsigned x, unsigned& nloc, unsigned& nx) {
    const unsigned G = gridDim.x * gridDim.y * gridDim.z;
    unsigned sum, cnt, mine, sp = 0u;
    for (;;) {
        sum = 0u; cnt = 0u; mine = 0u;
#pragma unroll
        for (unsigned j = 0; j < 16; ++j) { const unsigned c = xb_ld(&bar[XB_XCNT(j)]); sum += c; cnt += (c > 0u) ? 1u : 0u; mine = (j == x) ? c : mine; }
        if (sum == G) break;
        __builtin_amdgcn_s_sleep(1);
        if ((++sp & 255u) == 0u) { if (xb_ld(&bar[XB_TMO])) break; if (sp > XB_SPIN_CAP) { atomicAdd(&bar[XB_TMO], 1u); break; } }
    }
    nloc = mine > 0u ? mine : 1u; nx = cnt > 0u ? cnt : 1u;
}

__device__ __forceinline__ void xcd_barrier(const XcdBarrier& b) {
    asm volatile("s_waitcnt vmcnt(0)" ::: "memory");
    __syncthreads();
    if (threadIdx.x == 0) {
        unsigned* bar = b.bar;
        __builtin_amdgcn_s_waitcnt(0);
        unsigned nloc = b.st[0], nx = b.st[1];
        if (nloc == 0u) { xcd_barrier_complete(bar, b.x, nloc, nx); b.st[0] = nloc; b.st[1] = nx; }
        const unsigned old = xb_add(&bar[XB_XSUB(b.x)], 1u);
        const unsigned gen = old / nloc;
        if (old + 1u == (gen + 1u) * nloc) {
            __builtin_amdgcn_fence(__ATOMIC_RELEASE, "agent");
            asm volatile("s_waitcnt vmcnt(0)" ::: "memory");
            const unsigned og = xb_add(&bar[XB_TOP], 1u);
            const unsigned tg = og / nx;
            if (og + 1u == (tg + 1u) * nx) xb_add(&bar[XB_TOPGEN], 1u);
            else XB_SPIN(xb_ld(&bar[XB_TOPGEN]) == tg, bar);
            __builtin_amdgcn_fence(__ATOMIC_ACQUIRE, "agent");
            xb_add(&bar[XB_XGEN(b.x)], 1u);
            asm volatile("s_waitcnt vmcnt(0)" ::: "memory");
        } else {
            XB_SPIN(xb_ld(&bar[XB_XGEN(b.x)]) == gen, bar);
            __builtin_amdgcn_fence(__ATOMIC_ACQUIRE, "agent");
            asm volatile("s_waitcnt vmcnt(0)" ::: "memory");
        }
    }
    __syncthreads();
}

constexpr int NWAVES = 8, NTHREADS = 512;
constexpr int LDS_BYTES = 163840;
enum Phase { PH_PRO = 0, PH_G1 = 1, PH_IDX = 2, PH_ATB = 3, PH_ATA = 4, PH_T1 = 5, PH_T2 = 6, PH_T3 = 7, PH_T4 = 8, PH_T5 = 9, PH_N = 10 };

struct Args {
    const float* x; const float* p; const float* w_in; const float* w_pa; const float* w_pb; const float* w_o; const float* lqk; const float* subw;
    const float* ln_g; const float* ln_b; const float* w_ple; const float* w_gate; const float* rel_bias;
    float* out; unsigned char* ws; int ph_lo, ph_hi;
};

template <int MODE>
__device__ __forceinline__ void p0_transpose_item(const float* __restrict__ W, int K, int ld, int N, bf16_t* __restrict__ WT, LAS float* scr, int item, int lane) {
    const int nblk = N / 32, kb = item / nblk, nb = item % nblk, k0 = 64 * kb, n0 = 32 * nb;
    const int n = n0 + (lane & 31); const int c = MODE == 0 ? n : win_src_col(n);
#pragma unroll 8
    for (int i = 0; i < 32; ++i) { const int kk = 2 * i + (lane >> 5); scr[kk * 33 + (lane & 31)] = (c >= 0) ? W[(size_t)(k0 + kk) * ld + c] : 0.f; }
    asm volatile("s_waitcnt lgkmcnt(0)" ::: "memory");
    const int cc = lane & 7;
#pragma unroll
    for (int j = 0; j < 4; ++j) { const int nn = (lane >> 3) + 8 * j; const LAS float* s = scr + (8 * cc) * 33 + nn;
        u32x4 o; o.x = f2bf(s[0 * 33]) | ((unsigned)f2bf(s[1 * 33]) << 16); o.y = f2bf(s[2 * 33]) | ((unsigned)f2bf(s[3 * 33]) << 16);
        o.z = f2bf(s[4 * 33]) | ((unsigned)f2bf(s[5 * 33]) << 16); o.w = f2bf(s[6 * 33]) | ((unsigned)f2bf(s[7 * 33]) << 16);
        *(u32x4*)(WT + (size_t)(n0 + nn) * K + k0 + 8 * cc) = o; }
    asm volatile("s_waitcnt lgkmcnt(0)" ::: "memory");
}
__device__ __forceinline__ void cvt_rows(const float* __restrict__ src, bf16_t* __restrict__ dst, size_t n4, size_t gtid, size_t gthreads) {
    for (size_t i = gtid; i < n4; i += gthreads) { const float4 v = ((const float4*)src)[i]; u32x2 o; o.x = f2bf(v.x) | ((unsigned)f2bf(v.y) << 16); o.y = f2bf(v.z) | ((unsigned)f2bf(v.w) << 16); ((u32x2*)dst)[i] = o; }
}
__device__ __forceinline__ void ln_row(float* __restrict__ io, const float* __restrict__ g, const float* __restrict__ b, bf16_t* __restrict__ xln, int lane) {
    float4* r = (float4*)io + lane; float4 v[4]; float s = 0.f;
#pragma unroll
    for (int j = 0; j < 4; ++j) { v[j] = r[64 * j]; s += (v[j].x + v[j].y) + (v[j].z + v[j].w); }
#pragma unroll
    for (int o = 1; o < 64; o <<= 1) s += __shfl_xor(s, o);
    const float mean = s * (1.f / 1024.f); float q = 0.f;
#pragma unroll
    for (int j = 0; j < 4; ++j) { v[j].x -= mean; v[j].y -= mean; v[j].z -= mean; v[j].w -= mean; q += (v[j].x * v[j].x + v[j].y * v[j].y) + (v[j].z * v[j].z + v[j].w * v[j].w); }
#pragma unroll
    for (int o = 1; o < 64; o <<= 1) q += __shfl_xor(q, o);
    const float rstd = rsqrtf(q * (1.f / 1024.f) + 1e-5f);
#pragma unroll
    for (int j = 0; j < 4; ++j) {
        const float4 gg = ((const float4*)g)[lane + 64 * j], bb = ((const float4*)b)[lane + 64 * j];
        float4 o; o.x = v[j].x * rstd * gg.x + bb.x; o.y = v[j].y * rstd * gg.y + bb.y; o.z = v[j].z * rstd * gg.z + bb.z; o.w = v[j].w * rstd * gg.w + bb.w;
        r[64 * j] = o; u32x2 w; w.x = f2bf(o.x) | ((unsigned)f2bf(o.y) << 16); w.y = f2bf(o.z) | ((unsigned)f2bf(o.w) << 16);
        ((u32x2*)xln)[lane + 64 * j] = w;
    }
}

__global__ void __launch_bounds__(NTHREADS, 2) mega(Args a) {
    extern __shared__ __attribute__((aligned(16))) unsigned char lds_raw[];
    LAS unsigned char* lds = (LAS unsigned char*)lds_raw;
    const int tid = threadIdx.x, lane = tid & 63, wave = __builtin_amdgcn_readfirstlane(tid >> 6);
    const int G = gridDim.x, bx = blockIdx.x;
    unsigned char* ws = a.ws;
    bf16_t* WIN = (bf16_t*)(ws + WS_WIN); bf16_t* WPA = (bf16_t*)(ws + WS_WPA); bf16_t* WPB = (bf16_t*)(ws + WS_WPB); bf16_t* WO = (bf16_t*)(ws + WS_WO);
    bf16_t* WGT = (bf16_t*)(ws + WS_WGT); bf16_t* WPLE = (bf16_t*)(ws + WS_WPLE); bf16_t* XBF = (bf16_t*)(ws + WS_XBF); bf16_t* PBF = (bf16_t*)(ws + WS_PBF);
    bf16_t* QK = (bf16_t*)(ws + WS_QK); bf16_t* VT = (bf16_t*)(ws + WS_VT); bf16_t* OAB = (bf16_t*)(ws + WS_OAB);
    bf16_t* PLEO = (bf16_t*)(ws + WS_PLEO); bf16_t* Gb = (bf16_t*)(ws + WS_G); bf16_t* MRG = (bf16_t*)(ws + WS_MRG); bf16_t* XLN = (bf16_t*)(ws + WS_XLN);
    float* BT = (float*)(ws + WS_BT);
    const int lo = a.ph_lo, hi = a.ph_hi;
    volatile LAS unsigned* bst = (volatile LAS unsigned*)(lds + LDS_BYTES - 16);
    if (tid < 4) bst[tid] = 0u;
    __syncthreads();
    XcdBarrier bar = xcd_barrier_post((unsigned*)(ws + WS_CTL), bst);
#define IN(k) (lo <= (k) && (k) < hi)
#define SEAM(k) do { if (IN(k) && IN((k) + 1)) { if ((k) == PH_PRO) cooperative_groups::this_grid().sync(); else xcd_barrier(bar); } } while (0)

    if (IN(PH_PRO)) {
        LAS float* scr = (LAS float*)(lds + wave * 16384);
        const int gw = bx * NWAVES + wave, NGW = G * NWAVES;
        constexpr int I_IN = (WT_ROWS / 32) * (1024 / 64), I_PA = 32 * 8, I_O = 32 * 16, I_PLE = 32 * 4;
        constexpr int NITEMS = I_IN + 2 * I_PA + 2 * I_O + I_PLE;
        for (int it = gw; it < NITEMS; it += NGW) {
            int r = it;
            if (r < I_IN) { p0_transpose_item<1>(a.w_in, 1024, IN_COLS, WT_ROWS, WIN, scr, r, lane); continue; } r -= I_IN;
            if (r < I_PA) { p0_transpose_item<0>(a.w_pa, 512, 1024, 1024, WPA, scr, r, lane); continue; } r -= I_PA;
            if (r < I_PA) { p0_transpose_item<0>(a.w_pb, 512, 1024, 1024, WPB, scr, r, lane); continue; } r -= I_PA;
            if (r < I_O) { p0_transpose_item<0>(a.w_o, 1024, 1024, 1024, WO, scr, r, lane); continue; } r -= I_O;
            if (r < I_O) { p0_transpose_item<0>(a.w_gate, 1024, 1024, 1024, WGT, scr, r, lane); continue; } r -= I_O;
            p0_transpose_item<0>(a.w_ple, 256, 1024, 1024, WPLE, scr, r, lane);
        }
        const size_t gtid = (size_t)bx * NTHREADS + tid, gth = (size_t)G * NTHREADS;
        cvt_rows(a.x, XBF, (size_t)L * 1024 / 4, gtid, gth);
        cvt_rows(a.p, PBF, (size_t)L * 256 / 4, gtid, gth);
        if (gtid < 128 * 12) { const int n = (int)gtid / 12, h = (int)gtid % 12; BT[gtid] = a.rel_bias[rel_bucket(n) * 12 + h]; }
    }
    SEAM(PH_PRO);
    if (IN(PH_G1)) {
        { pg8::Gemm g{XBF, WIN + (size_t)WT_TOK * 1024, L, NTOK, 1024, 1024, 1024}; pg8::StaticOrder S; S.init(L, NTOK, G, bx);
          pg8::EpiTok E{QK, NTOK, 0}; pg8::gemm_phase<pg8::EpiTok, pg8::StaticOrder, true, true>(lds, g, S, E); }
        { pg8::Gemm g{WIN + (size_t)WT_VT * 1024, XBF, 1024, L, 1024, 1024, 1024}; pg8::StaticOrder S; S.init(1024, L, G, bx);
          pg8::EpiStoreBf E{VT, L, 0}; pg8::gemm_phase<pg8::EpiStoreBf, pg8::StaticOrder, true, true>(lds, g, S, E); }
    }
    SEAM(PH_G1);
    if (IN(PH_IDX)) {
        unsigned* BMPw = (unsigned*)(ws + WS_BMP);
        for (int p = bx; p < 512; p += G) { idx::index_unit(lds, 1023 - p, QK, BMPw); idx::index_unit(lds, p, QK, BMPw); }
    }
    if (IN(PH_ATB) || IN(PH_ATA)) {
        const int vcu = (G % 8 == 0) ? (bx % 8) * (G / 8) + bx / 8 : bx;
        const unsigned* BMP = (const unsigned*)(ws + WS_BMP);
        if (IN(PH_ATB)) {
            float la = a.lqk[lane] * a.lqk[64 + lane], lb = a.lqk[128 + lane] * a.lqk[192 + lane];
#pragma unroll
            for (int o = 1; o < 64; o <<= 1) { la += __shfl_xor(la, o); lb += __shfl_xor(lb, o); }
            const float lam = __expf(la) - __expf(lb) + LAM_INIT;
            for (int p = vcu; p < 256; p += G) { const int h = p >> 6, xq = p & 63;
                att::attn_unit<1>(lds, h, 127 - xq, QK, VT, BMP, BT, a.subw, lam, OAB);
                att::attn_unit<1>(lds, h, xq, QK, VT, BMP, BT, a.subw, lam, OAB); }
        }
        SEAM(PH_ATB);
        if (IN(PH_ATA)) {
            for (int p = vcu; p < 256; p += G) { const int h = p >> 5, xq = p & 31;
                att::attn_unit<0>(lds, h, 63 - xq, QK, VT, BMP, BT, a.subw, 0.f, OAB);
                att::attn_unit<0>(lds, h, xq, QK, VT, BMP, BT, a.subw, 0.f, OAB); }
        }
    }
    SEAM(PH_ATA);
    if (IN(PH_T1)) {
        { pg8::Gemm g{XBF, WIN + (size_t)WT_Z * 1024, L, 1024, 1024, 1024, 1024}; pg8::StaticOrder S; S.init(L, 1024, G, bx);
          pg8::EpiZ E{OAB}; pg8::gemm_phase<pg8::EpiZ, pg8::StaticOrder, true, true>(lds, g, S, E); }
        { pg8::Gemm g{XBF, WIN + (size_t)WT_G * 1024, L, 2048, 1024, 1024, 1024}; pg8::StaticOrder S; S.init(L, 2048, G, bx);
          pg8::EpiG E{Gb}; pg8::gemm_phase<pg8::EpiG, pg8::StaticOrder, true, true>(lds, g, S, E); }
    }
    SEAM(PH_T1);
    if (IN(PH_T2)) {
        { pg8::Gemm g{OAB, WPA, L, 1024, 512, 1024, 512}; pg8::StaticOrder S; S.init(L, 1024, G, bx);
          pg8::EpiPA E{Gb, MRG}; pg8::gemm_phase<pg8::EpiPA, pg8::StaticOrder, true, true>(lds, g, S, E); }
        { pg8::Gemm g{OAB + 512, WPB, L, 1024, 512, 1024, 512}; pg8::StaticOrder S; S.init(L, 1024, G, bx);
          pg8::EpiPB E{Gb, MRG}; pg8::gemm_phase<pg8::EpiPB, pg8::StaticOrder, true, true>(lds, g, S, E); }
        { pg8::Gemm g{PBF, WPLE, L, 1024, 256, 256, 256}; pg8::StaticOrder S; S.init(L, 1024, G, bx);
          pg8::EpiStoreBf E{PLEO, 1024, 0}; pg8::gemm_phase<pg8::EpiStoreBf, pg8::StaticOrder, true, true>(lds, g, S, E); }
    }
    SEAM(PH_T2);
    if (IN(PH_T3)) {
        pg8::Gemm g{MRG, WO, L, 1024, 1024, 1024, 1024}; pg8::StaticOrder S; S.init(L, 1024, G, bx);
        pg8::EpiO E{a.x, a.out}; pg8::gemm_phase<pg8::EpiO, pg8::StaticOrder, true, true>(lds, g, S, E);
    }
    SEAM(PH_T3);
    if (IN(PH_T4)) {
        const int gw = bx * NWAVES + wave, NGW = G * NWAVES;
        for (int m = gw; m < L; m += NGW) ln_row(a.out + (size_t)m * 1024, a.ln_g, a.ln_b, XLN + (size_t)m * 1024, lane);
    }
    SEAM(PH_T4);
    if (IN(PH_T5)) {
        pg8::Gemm g{XLN, WGT, L, 1024, 1024, 1024, 1024}; pg8::StaticOrder S; S.init(L, 1024, G, bx);
        pg8::EpiGate E{a.out, PLEO}; pg8::gemm_phase<pg8::EpiGate, pg8::StaticOrder, true, true>(lds, g, S, E);
    }
#undef IN
#undef SEAM
}

extern "C" void kernel_launch(void* const* d_in, const int* in_sizes, int n_in, void* d_out, int out_size, void* d_ws, size_t ws_size, hipStream_t stream) {
    static int grid = 0;
    if (grid == 0) {
        if (ws_size < WS_END) { fprintf(stderr, "workspace too small: %zu\n", ws_size); grid = -1; return; }
        (void)hipFuncSetAttribute((const void*)mega, hipFuncAttributeMaxDynamicSharedMemorySize, LDS_BYTES);
        int dev = 0, cus = 0, per_cu = 0; (void)hipGetDevice(&dev); (void)hipDeviceGetAttribute(&cus, hipDeviceAttributeMultiprocessorCount, dev);
        (void)hipOccupancyMaxActiveBlocksPerMultiprocessor(&per_cu, (const void*)mega, NTHREADS, LDS_BYTES);
        if (per_cu < 1) fprintf(stderr, "kernel_launch: occupancy query reports %d workgroups per CU\n", per_cu);
        grid = cus > 0 ? cus : 256;
    }
    if (grid < 0) return;
    (void)hipMemsetAsync(d_ws, 0, 16384, stream);
    Args a{};
    a.x = (const float*)d_in[0]; a.p = (const float*)d_in[1]; a.w_in = (const float*)d_in[2]; a.w_pa = (const float*)d_in[3]; a.w_pb = (const float*)d_in[4]; a.w_o = (const float*)d_in[5];
    a.lqk = (const float*)d_in[6]; a.subw = (const float*)d_in[7]; a.ln_g = (const float*)d_in[8]; a.ln_b = (const float*)d_in[9];
    a.w_ple = (const float*)d_in[10]; a.w_gate = (const float*)d_in[11]; a.rel_bias = (const float*)d_in[12];
    a.out = (float*)d_out; a.ws = (unsigned char*)d_ws; a.ph_lo = 0; a.ph_hi = PH_N;
    void* args[] = {&a};
    const hipError_t e = hipLaunchCooperativeKernel((const void*)mega, dim3(grid), dim3(NTHREADS), args, LDS_BYTES, stream);
    if (e != hipSuccess) fprintf(stderr, "cooperative launch failed: %s (grid %d)\n", hipGetErrorString(e), grid);
}
```
